# Optimizing an MI355X kernel written in HIP

```python
import math
import jax, jax.numpy as jnp
from jax import lax
import numpy as np

D_MODEL = 1024
BATCH = 4
SEQ = 4096
DEPTH = 1

HG_HEADS = 8
HG_DK = 128
HG_DV = 128
HG_WIDTH = HG_HEADS * HG_DK
HG_CHUNK = 64
AT_HEADS = 8
AT_DH = 128
AT_WIDTH = AT_HEADS * AT_DH
MOBA_BLOCK = 256
MOBA_TOPK = 3
Q_CHUNK = 16
REL_BUCKETS = 32
REL_MAX_DIST = 128
D_FF = -(-8 * D_MODEL // (3 * 256)) * 256
N_BRANCH = 2
NORM_EPS = 1e-6
IN_SIZES = [HG_WIDTH, HG_WIDTH, HG_HEADS * HG_DV, HG_HEADS * HG_DV,
            AT_WIDTH, AT_WIDTH, AT_WIDTH, N_BRANCH * D_MODEL]
IN_COLS = sum(IN_SIZES)
IN_SPLITS = [int(s) for s in np.cumsum(IN_SIZES)[:-1]]

kernel_name = "hgrn2_moba_gated_hybrid"


def rmsnorm(x, g):
    xf = x.astype(jnp.float32)
    y = xf * lax.rsqrt(jnp.mean(xf * xf, axis=-1, keepdims=True) + NORM_EPS)
    return (y * g.astype(jnp.float32)).astype(x.dtype)


def t5_bucket(dist):
    n = jnp.maximum(dist, 0)
    max_exact = REL_BUCKETS // 2
    nf = jnp.maximum(n, 1).astype(jnp.float32)
    large = max_exact + (jnp.log(nf / max_exact) / math.log(REL_MAX_DIST / max_exact)
                         * (REL_BUCKETS - max_exact)).astype(jnp.int32)
    large = jnp.minimum(large, REL_BUCKETS - 1)
    return jnp.where(n < max_exact, n, large)


def hgrn2_mix(q, f_logit, i, g, lb, out_gain):
    B, S, _ = q.shape
    f32 = jnp.float32
    C = HG_CHUNK
    N = S // C
    z = f_logit.astype(f32)
    f = lb + (1.0 - lb) * jax.nn.sigmoid(z)
    log_f = jnp.log(f)
    k = (1.0 - lb) * jax.nn.sigmoid(-z)
    qs = q.astype(f32) * HG_DK ** -0.5

    def to_chunks(t, d):
        return t.reshape(B, N, C, HG_HEADS, d).transpose(1, 0, 3, 2, 4)

    qc = to_chunks(qs, HG_DK)
    kc = to_chunks(k, HG_DK)
    lfc = to_chunks(log_f, HG_DK)
    vc = to_chunks(i.astype(f32), HG_DV)
    causal = jnp.tril(jnp.ones((C, C), dtype=bool))

    def step(state, inp):
        q_, k_, v_, lf_ = inp
        b = jnp.cumsum(lf_, axis=2)
        o_inter = jnp.einsum('bhtk,bhkv->bhtv', q_ * jnp.exp(b), state)
        diff = b[:, :, :, None, :] - b[:, :, None, :, :]
        decay = jnp.exp(jnp.where(causal[:, :, None], diff, -jnp.inf))
        attn = jnp.einsum('bhtk,bhsk,bhtsk->bhts', q_, k_, decay)
        o = o_inter + jnp.einsum('bhts,bhsv->bhtv', attn, v_)
        b_last = b[:, :, -1:, :]
        k_dec = k_ * jnp.exp(b_last - b)
        new_state = (jnp.exp(b_last[:, :, 0, :])[..., None] * state
                     + jnp.einsum('bhsk,bhsv->bhkv', k_dec, v_))
        return new_state, o

    s0 = jnp.zeros((B, HG_HEADS, HG_DK, HG_DV), f32)
    _, o = lax.scan(step, s0, (qc, kc, vc, lfc))
    o = o.transpose(1, 0, 3, 2, 4).reshape(B, S, HG_HEADS, HG_DV)
    o = rmsnorm(o, out_gain) * jax.nn.silu(g.astype(f32).reshape(B, S, HG_HEADS, HG_DV))
    return o.reshape(B, S, HG_HEADS * HG_DV).astype(q.dtype)


def moba_attention(q, k, v, rel_table):
    B, H, S, Dh = q.shape
    f32 = jnp.float32
    BLK = MOBA_BLOCK
    NB = -(-S // BLK)
    pad = NB * BLK - S
    kp = jnp.pad(k, ((0, 0), (0, 0), (0, pad), (0, 0)))
    vp = jnp.pad(v, ((0, 0), (0, 0), (0, pad), (0, 0)))
    kb = kp.reshape(B, H, NB, BLK, Dh)
    vb = vp.reshape(B, H, NB, BLK, Dh)
    kmean = jnp.mean(kb.astype(f32), axis=3)
    topk = min(MOBA_TOPK, NB)
    scale = Dh ** -0.5
    table_h = rel_table.astype(f32).T
    b_idx = jnp.arange(B)[:, None, None, None]
    h_idx = jnp.arange(H)[None, :, None, None]
    h_idx5 = jnp.arange(H)[None, :, None, None, None]
    n_chunks = S // Q_CHUNK

    def one_chunk(c):
        t0 = c * Q_CHUNK
        qc = lax.dynamic_slice_in_dim(q, t0, Q_CHUNK, axis=2)
        tpos = t0 + jnp.arange(Q_CHUNK)
        cur = t0 // BLK
        gate = jnp.einsum('bhqd,bhnd->bhqn', qc.astype(f32), kmean)
        gate = jnp.where(jnp.arange(NB) < cur, gate, -jnp.inf)
        _, sel = lax.top_k(gate, topk)
        sel_valid = sel < cur
        ks = kb[b_idx, h_idx, sel]
        vs = vb[b_idx, h_idx, sel]
        lp = jnp.einsum('bhqd,bhqjsd->bhqjs', qc, ks).astype(f32) * scale
        kpos = sel[..., None] * BLK + jnp.arange(BLK)
        bias_p = table_h[h_idx5, t5_bucket(tpos[:, None, None] - kpos)]
        lp = jnp.where(sel_valid[..., None], lp + bias_p, -jnp.inf)
        ko = lax.dynamic_slice_in_dim(kp, cur * BLK, BLK, axis=2)
        vo = lax.dynamic_slice_in_dim(vp, cur * BLK, BLK, axis=2)
        lo = jnp.einsum('bhqd,bhsd->bhqs', qc, ko).astype(f32) * scale
        dist_o = tpos[:, None] - (cur * BLK + jnp.arange(BLK))[None, :]
        lo = jnp.where(dist_o >= 0, lo + table_h[:, t5_bucket(dist_o)], -jnp.inf)
        logits = jnp.concatenate([lo, lp.reshape(B, H, Q_CHUNK, topk * BLK)], axis=-1)
        p = jax.nn.softmax(logits, axis=-1)
        p_own = p[..., :BLK].astype(v.dtype)
        p_past = p[..., BLK:].reshape(B, H, Q_CHUNK, topk, BLK).astype(v.dtype)
        return (jnp.einsum('bhqs,bhsd->bhqd', p_own, vo)
                + jnp.einsum('bhqjs,bhqjsd->bhqd', p_past, vs))

    out = lax.map(one_chunk, jnp.arange(n_chunks))
    return out.transpose(1, 2, 0, 3, 4).reshape(B, H, S, Dh)


def setup_inputs(seed: int = 0) -> dict:
    key = jax.random.key(seed)
    ks = jax.random.split(key, 16)
    f32 = jnp.float32
    nrm = lambda k, shape, s: jax.random.normal(k, shape, f32) * s
    return {
        "x": jax.random.normal(ks[0], (BATCH, SEQ, D_MODEL), f32),
        "attn_norm_g": 1.0 + nrm(ks[1], (DEPTH, D_MODEL), 0.02),
        "w_in": nrm(ks[2], (DEPTH, D_MODEL, IN_COLS), D_MODEL ** -0.5),
        "hg_lb_gamma": nrm(ks[3], (DEPTH + 1, HG_WIDTH), 0.5),
        "hg_out_norm_g": 1.0 + nrm(ks[4], (DEPTH, HG_DV), 0.02),
        "q_norm_g": 1.0 + nrm(ks[5], (DEPTH, AT_DH), 0.02),
        "k_norm_g": 1.0 + nrm(ks[6], (DEPTH, AT_DH), 0.02),
        "rel_bias_table": nrm(ks[7], (REL_BUCKETS, AT_HEADS), 0.2),
        "w_branch_hg": nrm(ks[8], (DEPTH, HG_HEADS * HG_DV, D_MODEL), (HG_HEADS * HG_DV) ** -0.5),
        "w_branch_attn": nrm(ks[9], (DEPTH, AT_WIDTH, D_MODEL), AT_WIDTH ** -0.5),
        "w_out": nrm(ks[10], (DEPTH, D_MODEL, D_MODEL), D_MODEL ** -0.5),
        "ffn_norm_g": 1.0 + nrm(ks[11], (DEPTH, D_MODEL), 0.02),
        "w_ffn_gate": nrm(ks[12], (DEPTH, D_MODEL, D_FF), D_MODEL ** -0.5),
        "w_ffn_up": nrm(ks[13], (DEPTH, D_MODEL, D_FF), D_MODEL ** -0.5),
        "w_ffn_down": nrm(ks[14], (DEPTH, D_FF, D_MODEL), D_FF ** -0.5),
    }


def reference(x, attn_norm_g, w_in, hg_lb_gamma, hg_out_norm_g, q_norm_g, k_norm_g,
              rel_bias_table, w_branch_hg, w_branch_attn, w_out, ffn_norm_g,
              w_ffn_gate, w_ffn_up, w_ffn_down):
    B, S, D = x.shape
    lb_all = jnp.cumsum(jax.nn.softmax(hg_lb_gamma.astype(jnp.float32), axis=0), axis=0)[:DEPTH]
    for l in range(DEPTH):
        h = rmsnorm(x, attn_norm_g[l])
        proj = h @ w_in[l]
        hq, hf, hi, hg, aq, ak, av, gl = jnp.split(proj, IN_SPLITS, axis=-1)
        y_hg = hgrn2_mix(hq, hf, hi, hg, lb_all[l], hg_out_norm_g[l]) @ w_branch_hg[l]
        qh = rmsnorm(aq.reshape(B, S, AT_HEADS, AT_DH), q_norm_g[l]).transpose(0, 2, 1, 3)
        kh = rmsnorm(ak.reshape(B, S, AT_HEADS, AT_DH), k_norm_g[l]).transpose(0, 2, 1, 3)
        vh = av.reshape(B, S, AT_HEADS, AT_DH).transpose(0, 2, 1, 3)
        att = moba_attention(qh, kh, vh, rel_bias_table)
        y_at = att.transpose(0, 2, 1, 3).reshape(B, S, AT_WIDTH) @ w_branch_attn[l]
        gates = jax.nn.sigmoid(gl.reshape(B, S, N_BRANCH, D))
        merged = gates[:, :, 0, :] * y_hg + gates[:, :, 1, :] * y_at
        x = x + merged @ w_out[l]
        h2 = rmsnorm(x, ffn_norm_g[l])
        x = x + (jax.nn.silu(h2 @ w_ffn_gate[l]) * (h2 @ w_ffn_up[l])) @ w_ffn_down[l]
    return x
```

```cpp
#include <hip/hip_runtime.h>
#include <cstdio>
#include <cstdint>

constexpr int BATCH = 4, SEQ = 4096, DM = 1024, MTOK = BATCH * SEQ;
constexpr int NH = 8, HD = 128;
constexpr int DFF = 2816, INCOLS = 9216;
constexpr int MBLK = 256, NBLK = SEQ / MBLK, TOPK = 3;
constexpr float NORM_EPS = 1e-6f;
constexpr float ATT_SCALE = 0.08838834764831845f;
constexpr float LOG2E = 1.4426950408889634f;


namespace pg8 {
#define PG8_LAS __attribute__((address_space(3)))
typedef unsigned short bf16_t;
typedef short bf16x8 __attribute__((ext_vector_type(8)));
typedef float f32x4 __attribute__((ext_vector_type(4)));
typedef unsigned u32x4 __attribute__((ext_vector_type(4)));
constexpr int BM = 256, BK = 64, HALF = 128, HTB = HALF * BK * 2  , STAGE_BYTES = 8 * HTB, NXCD = 8, WGM = 8;

__host__ __device__ __forceinline__ int lds_byte(int r, int c) { const int st = (r >> 4) * 2 + (c >> 5), rr = r & 15, cc = c & 31, ob = rr * 64 + cc * 2; return st * 1024 + (ob ^ (((ob >> 9) & 1) << 5)); }
__host__ __device__ __forceinline__ void stage_rc(int b, int& R, int& C) { const int st = b / 1024, sb = b % 1024, swz = sb ^ (((sb >> 9) & 1) << 5); R = (st >> 1) * 16 + swz / 64; C = (st & 1) * 32 + (swz % 64) / 2; }
__host__ __device__ __forceinline__ int perm32(int rho) { const int n = rho >> 4, i = rho & 15; return 8 * (i >> 2) + 4 * n + (i & 3); }

struct Unit { int pm, pn; };
struct Gemm { const bf16_t* A; const bf16_t* Bt; int M, N, K; };

struct StaticOrder {
    int nM, nN, nwg, G, c;
    __host__ __device__ void init(int M, int N, int G_, int c_) { nM = M / BM; nN = N / BM; nwg = nM * nN; G = G_; c = c_; }
    __host__ __device__ bool next(int i, Unit& u) const {
        const long L = (long)i * G + c; if (L >= nwg) return false;
        int wgid = (int)L; { const int q = nwg / NXCD, r = nwg % NXCD, xcd = wgid % NXCD, off = wgid / NXCD; wgid = (xcd < r ? xcd * (q + 1) : r * (q + 1) + (xcd - r) * q) + off; }
        const int nig = WGM * nN, gid = wgid / nig, fm = gid * WGM, gsz = (nM - fm) < WGM ? (nM - fm) : WGM;
        u.pm = fm + ((wgid % nig) % gsz); u.pn = (wgid % nig) / gsz; return true;
    }
    __device__ __forceinline__ void a_ready(const Unit&) const {}
    __device__ __forceinline__ void done(const Unit&) const {}
};

__device__ __forceinline__ unsigned cvt_pk_bf16(float lo, float hi) { unsigned r; asm volatile("v_cvt_pk_bf16_f32 %0, %1, %2" : "=v"(r) : "v"(lo), "v"(hi)); return r; }
typedef float f32x2 __attribute__((ext_vector_type(2)));

typedef unsigned u32x2 __attribute__((ext_vector_type(2)));
typedef _Float16 f16x8 __attribute__((ext_vector_type(8)));
__device__ __forceinline__ float bf2f(unsigned short b) { return __uint_as_float((unsigned)b << 16); }
__device__ __forceinline__ u32x4 pack8bf(f32x4 a, f32x4 b) { u32x4 w; w.x = cvt_pk_bf16(a[0], a[1]); w.y = cvt_pk_bf16(a[2], a[3]); w.z = cvt_pk_bf16(b[0], b[1]); w.w = cvt_pk_bf16(b[2], b[3]); return w; }
__device__ __forceinline__ void unpack8bf(u32x4 w, f32x4& a, f32x4& b) {
    a[0] = __uint_as_float(w.x << 16); a[1] = __uint_as_float(w.x & 0xffff0000u); a[2] = __uint_as_float(w.y << 16); a[3] = __uint_as_float(w.y & 0xffff0000u);
    b[0] = __uint_as_float(w.z << 16); b[1] = __uint_as_float(w.z & 0xffff0000u); b[2] = __uint_as_float(w.w << 16); b[3] = __uint_as_float(w.w & 0xffff0000u); }
__device__ __forceinline__ float fsigmoid(float x) { return __builtin_amdgcn_rcpf(1.f + __builtin_amdgcn_exp2f(-x * 1.4426950408889634f)); }
#define PG8_EPI_BAR() do { asm volatile("s_waitcnt lgkmcnt(0)" ::: "memory"); __builtin_amdgcn_s_barrier(); asm volatile("" ::: "memory"); } while (0)

struct EpiProj {
    static constexpr bool PERM = true, AFTER_DRAIN = false, MIDK = false;
    int mode;
    bf16_t* QQ; bf16_t* AK; bf16_t* AV; unsigned short* HLF; bf16_t* HSG; bf16_t* GATES; float* KMEAN; bf16_t* KMEANB;
    const float* lb; const float* qg; const float* kg;
    PG8_LAS unsigned char* scr;
    __device__ __forceinline__ void midk(f32x4 (&)[2][2][4][2], const Unit&, int, int, int, int) const {}
    __device__ __forceinline__ void operator()(const f32x4 (&acc)[2][2][4][2], const Unit& u, int wr, int wc, int fr, int fq) const {
        const int row0 = u.pm * BM + wr * 64 + fr;
        const int cw = wc * 32 + 8 * fq;
        int kind, c0;
        if (mode == 0) { kind = u.pn >> 2; c0 = (u.pn & 3) * 256; }
        else if (u.pn < 16) { kind = 3 + (u.pn >> 2); c0 = (u.pn & 3) * 256; }
        else { kind = 7; c0 = (u.pn - 16) * 256; }
        if (kind <= 1) {
            PG8_LAS float* P = (PG8_LAS float*)scr; PG8_LAS float* CS = (PG8_LAS float*)(scr + 8192);
#pragma unroll
            for (int ai = 0; ai < 2; ++ai)
#pragma unroll
                for (int m = 0; m < 4; ++m)
#pragma unroll
                    for (int bj = 0; bj < 2; ++bj) { const f32x4 a = acc[ai][bj][m][0], b = acc[ai][bj][m][1];
                        float s = (a[0] * a[0] + a[1] * a[1]) + (a[2] * a[2] + a[3] * a[3]) + (b[0] * b[0] + b[1] * b[1]) + (b[2] * b[2] + b[3] * b[3]);
                        s += __shfl_xor(s, 16); s += __shfl_xor(s, 32);
                        if (fq == 0) P[((ai * 128 + wr * 64 + m * 16 + fr) * 2 + bj) * 4 + wc] = s; }
            PG8_EPI_BAR();
            const float* gp = (kind == 0 ? qg : kg) + cw;
            const f32x4 g0 = *(const f32x4*)gp, g1 = *(const f32x4*)(gp + 4);
            f32x4 cs[2][2];
#pragma unroll
            for (int bj = 0; bj < 2; ++bj) { cs[bj][0] = (f32x4){0.f, 0.f, 0.f, 0.f}; cs[bj][1] = (f32x4){0.f, 0.f, 0.f, 0.f}; }
            bf16_t* dst = (kind == 0) ? (QQ + 1024 + c0 + cw) : (AK + c0 + cw); const int ld = (kind == 0) ? 2048 : 1024;
#pragma unroll
            for (int ai = 0; ai < 2; ++ai)
#pragma unroll
                for (int m = 0; m < 4; ++m) { const int row = row0 + ai * 128 + m * 16;
#pragma unroll
                    for (int bj = 0; bj < 2; ++bj) { const f32x4 p4 = *(const PG8_LAS f32x4*)&P[((ai * 128 + wr * 64 + m * 16 + fr) * 2 + bj) * 4];
                        const float rstd = __builtin_amdgcn_rsqf(((p4[0] + p4[1]) + (p4[2] + p4[3])) * (1.f / 128.f) + NORM_EPS);
                        const f32x4 y0 = acc[ai][bj][m][0] * rstd * g0, y1 = acc[ai][bj][m][1] * rstd * g1;
                        cs[bj][0] += y0; cs[bj][1] += y1;
                        *(u32x4*)(dst + (size_t)row * ld + bj * 128) = pack8bf(y0, y1); } }
            if (kind == 1) {
#pragma unroll
                for (int bj = 0; bj < 2; ++bj)
#pragma unroll
                    for (int n = 0; n < 2; ++n)
#pragma unroll
                        for (int j = 0; j < 4; ++j) { float v = cs[bj][n][j]; v += __shfl_xor(v, 1); v += __shfl_xor(v, 2); v += __shfl_xor(v, 4); v += __shfl_xor(v, 8);
                            if (fr == 0) CS[wr * 256 + bj * 128 + cw + 4 * n + j] = v; }
                PG8_EPI_BAR();
                const int t = threadIdx.x;
                if (t < 256) { const float km = (CS[t] + CS[256 + t]) * (1.f / 256.f);
                    const int bb = u.pm >> 4, nb = u.pm & 15, head = (c0 + t) >> 7, d = t & 127;
                    const size_t o = ((size_t)((bb * NH + head) * NBLK + nb)) * HD + d;
                    KMEAN[o] = km; KMEANB[o] = (bf16_t)(cvt_pk_bf16(km, 0.f) & 0xffffu); }
            }
            return;
        }
        if (kind == 4) {
#pragma unroll
            for (int bj = 0; bj < 2; ++bj) { const int col = c0 + bj * 128 + cw;
                const f32x4 l0 = *(const f32x4*)(lb + col), l1 = *(const f32x4*)(lb + col + 4);
#pragma unroll
                for (int ai = 0; ai < 2; ++ai)
#pragma unroll
                    for (int m = 0; m < 4; ++m) { const int row = row0 + ai * 128 + m * 16;
                        f32x4 k0, k1; f16x8 lf;
#pragma unroll
                        for (int j = 0; j < 4; ++j) { const float ka = (1.f - l0[j]) * fsigmoid(-acc[ai][bj][m][0][j]), kb = (1.f - l1[j]) * fsigmoid(-acc[ai][bj][m][1][j]);
                            k0[j] = ka; k1[j] = kb; lf[j] = (_Float16)__builtin_amdgcn_logf(1.f - ka); lf[4 + j] = (_Float16)__builtin_amdgcn_logf(1.f - kb); }
                        *(u32x4*)(AK + (size_t)row * 1024 + col) = pack8bf(k0, k1);
                        *(f16x8*)(HLF + (size_t)row * 1024 + col) = lf; } }
            return;
        }
        bf16_t* dst; int ld;
        if (kind == 2) { dst = AV; ld = 1024; } else if (kind == 3) { dst = QQ; ld = 2048; } else if (kind == 5) { dst = AV; ld = 1024; } else if (kind == 6) { dst = HSG; ld = 1024; } else { dst = GATES; ld = 2048; }
        dst += c0 + cw;
#pragma unroll
        for (int ai = 0; ai < 2; ++ai)
#pragma unroll
            for (int m = 0; m < 4; ++m) { const int row = row0 + ai * 128 + m * 16;
#pragma unroll
                for (int bj = 0; bj < 2; ++bj) { f32x4 v0 = acc[ai][bj][m][0], v1 = acc[ai][bj][m][1];
                    if (kind == 3) { v0 = v0 * ATT_SCALE; v1 = v1 * ATT_SCALE; }
                    else if (kind == 6) {
#pragma unroll
                        for (int j = 0; j < 4; ++j) { v0[j] = v0[j] * fsigmoid(v0[j]); v1[j] = v1[j] * fsigmoid(v1[j]); } }
                    else if (kind == 7) {
#pragma unroll
                        for (int j = 0; j < 4; ++j) { v0[j] = fsigmoid(v0[j]); v1[j] = fsigmoid(v1[j]); } }
                    *(u32x4*)(dst + (size_t)row * ld + bj * 128) = pack8bf(v0, v1); } }
    }
};

struct EpiMerge {
    static constexpr bool PERM = true, AFTER_DRAIN = false, MIDK = true;
    const bf16_t* G; bf16_t* O;
    __device__ __forceinline__ void midk(f32x4 (&acc)[2][2][4][2], const Unit& u, int wr, int wc, int fr, int fq) const {
        int row0 = u.pm * BM + wr * 64 + fr, col0 = u.pn * BM + wc * 32 + 8 * fq;
        asm volatile("" : "+v"(row0), "+v"(col0));
#pragma unroll
        for (int ai = 0; ai < 2; ++ai)
#pragma unroll
            for (int m = 0; m < 4; ++m) { const bf16_t* gp = G + (size_t)(row0 + ai * 128 + m * 16) * 2048 + col0;
#pragma unroll
                for (int bj = 0; bj < 2; ++bj) { const u32x4 w0 = *(const u32x4*)(gp + bj * 128), w1 = *(const u32x4*)(gp + 1024 + bj * 128);
                    f32x4 a0, a1, b0, b1; unpack8bf(w0, a0, a1); unpack8bf(w1, b0, b1);
#pragma unroll
                    for (int j = 0; j < 4; ++j) { acc[ai][bj][m][0][j] *= a0[j] * __builtin_amdgcn_rcpf(b0[j]); acc[ai][bj][m][1][j] *= a1[j] * __builtin_amdgcn_rcpf(b1[j]); } }
                asm volatile("" ::: "memory"); }
    }
    __device__ __forceinline__ void operator()(const f32x4 (&acc)[2][2][4][2], const Unit& u, int wr, int wc, int fr, int fq) const {
        const int row0 = u.pm * BM + wr * 64 + fr, col0 = u.pn * BM + wc * 32 + 8 * fq;
#pragma unroll
        for (int ai = 0; ai < 2; ++ai)
#pragma unroll
            for (int m = 0; m < 4; ++m) { const int row = row0 + ai * 128 + m * 16; const bf16_t* gp = G + (size_t)row * 2048 + 1024 + col0;
#pragma unroll
                for (int bj = 0; bj < 2; ++bj) { const u32x4 w1 = *(const u32x4*)(gp + bj * 128); f32x4 b0, b1; unpack8bf(w1, b0, b1);
                    *(u32x4*)(O + (size_t)row * 1024 + col0 + bj * 128) = pack8bf(acc[ai][bj][m][0] * b0, acc[ai][bj][m][1] * b1); }
                asm volatile("" ::: "memory"); }
    }
};

struct EpiOut {
    static constexpr bool PERM = true, AFTER_DRAIN = false, MIDK = false;
    const float* X; float* X1; bf16_t* A2; const float* g2; float* SSQ;
    __device__ __forceinline__ void midk(f32x4 (&)[2][2][4][2], const Unit&, int, int, int, int) const {}
    __device__ __forceinline__ void operator()(const f32x4 (&acc)[2][2][4][2], const Unit& u, int wr, int wc, int fr, int fq) const {
        const int row0 = u.pm * BM + wr * 64 + fr, col0 = u.pn * BM + wc * 32 + 8 * fq;
        f32x4 gg[2][2];
#pragma unroll
        for (int bj = 0; bj < 2; ++bj) { gg[bj][0] = *(const f32x4*)(g2 + col0 + bj * 128); gg[bj][1] = *(const f32x4*)(g2 + col0 + bj * 128 + 4); }
#pragma unroll
        for (int ai = 0; ai < 2; ++ai)
#pragma unroll
            for (int m = 0; m < 4; ++m) { const int row = row0 + ai * 128 + m * 16; const size_t off = (size_t)row * 1024 + col0; float s = 0.f;
#pragma unroll
                for (int bj = 0; bj < 2; ++bj) { const f32x4 v0 = acc[ai][bj][m][0] + *(const f32x4*)(X + off + bj * 128), v1 = acc[ai][bj][m][1] + *(const f32x4*)(X + off + bj * 128 + 4);
                    *(f32x4*)(X1 + off + bj * 128) = v0; *(f32x4*)(X1 + off + bj * 128 + 4) = v1;
                    s += (v0[0] * v0[0] + v0[1] * v0[1]) + (v0[2] * v0[2] + v0[3] * v0[3]) + (v1[0] * v1[0] + v1[1] * v1[1]) + (v1[2] * v1[2] + v1[3] * v1[3]);
                    *(u32x4*)(A2 + off + bj * 128) = pack8bf(v0 * gg[bj][0], v1 * gg[bj][1]); }
                s += __shfl_xor(s, 16); s += __shfl_xor(s, 32);
                if (fq == 0) SSQ[(size_t)row * 16 + u.pn * 4 + wc] = s;
                asm volatile("" ::: "memory"); }
    }
};

struct EpiFfnIn {
    static constexpr bool PERM = true, AFTER_DRAIN = false, MIDK = false;
    const float* SSQ; bf16_t* ACT;
    __device__ __forceinline__ void midk(f32x4 (&)[2][2][4][2], const Unit&, int, int, int, int) const {}
    __device__ __forceinline__ void operator()(const f32x4 (&acc)[2][2][4][2], const Unit& u, int wr, int wc, int fr, int fq) const {
        const int row0 = u.pm * BM + wr * 64 + fr, col0 = u.pn * 128 + wc * 32 + 8 * fq;
#pragma unroll
        for (int ai = 0; ai < 2; ++ai)
#pragma unroll
            for (int m = 0; m < 4; ++m) { const int row = row0 + ai * 128 + m * 16; const f32x4* sp = (const f32x4*)(SSQ + (size_t)row * 16);
                const f32x4 s0 = sp[0], s1 = sp[1], s2 = sp[2], s3 = sp[3];
                const float tot = ((s0[0] + s0[1]) + (s0[2] + s0[3])) + ((s1[0] + s1[1]) + (s1[2] + s1[3])) + ((s2[0] + s2[1]) + (s2[2] + s2[3])) + ((s3[0] + s3[1]) + (s3[2] + s3[3]));
                const float rstd = __builtin_amdgcn_rsqf(tot * (1.f / 1024.f) + NORM_EPS);
                f32x4 o0, o1;
#pragma unroll
                for (int j = 0; j < 4; ++j) { const float ga = acc[ai][0][m][0][j] * rstd, gb = acc[ai][0][m][1][j] * rstd;
                    o0[j] = ga * fsigmoid(ga) * (acc[ai][1][m][0][j] * rstd); o1[j] = gb * fsigmoid(gb) * (acc[ai][1][m][1][j] * rstd); }
                *(u32x4*)(ACT + (size_t)row * DFF + col0) = pack8bf(o0, o1);
                asm volatile("" ::: "memory"); }
    }
};

struct EpiDown {
    static constexpr bool PERM = true, AFTER_DRAIN = false, MIDK = false;
    const float* X1; float* OUT;
    __device__ __forceinline__ void midk(f32x4 (&)[2][2][4][2], const Unit&, int, int, int, int) const {}
    __device__ __forceinline__ void operator()(const f32x4 (&acc)[2][2][4][2], const Unit& u, int wr, int wc, int fr, int fq) const {
        const int row0 = u.pm * BM + wr * 64 + fr, col0 = u.pn * BM + wc * 32 + 8 * fq;
#pragma unroll
        for (int ai = 0; ai < 2; ++ai)
#pragma unroll
            for (int m = 0; m < 4; ++m) { const size_t off = (size_t)(row0 + ai * 128 + m * 16) * 1024 + col0;
#pragma unroll
                for (int bj = 0; bj < 2; ++bj) { *(f32x4*)(OUT + off + bj * 128) = acc[ai][bj][m][0] + *(const f32x4*)(X1 + off + bj * 128);
                    *(f32x4*)(OUT + off + bj * 128 + 4) = acc[ai][bj][m][1] + *(const f32x4*)(X1 + off + bj * 128 + 4); }
                asm volatile("" ::: "memory"); }
    }
};


template <class Epi, class Sched, bool ALIGN_EPI = false, bool SP2 = false>
__device__ __forceinline__ void gemm_phase(PG8_LAS unsigned char* lds, const Gemm g, const Sched& S, const Epi& E) {
    const int tid = threadIdx.x, wid = __builtin_amdgcn_readfirstlane(tid >> 6), lane = tid & 63, wr = wid >> 2, wc = wid & 3, fr = lane & 15, fq = lane >> 4;
    const int K = g.K, nt = K / BK;
    unsigned voffA[2], voffB[2];
#pragma unroll
    for (int i = 0; i < 2; ++i) { int R, C; stage_rc(tid * 16 + i * 8192, R, C); const int Rb = Epi::PERM ? ((R & ~31) + perm32(R & 31)) : R;
        voffA[i] = (unsigned)(R * K + C) * 2u; voffB[i] = (unsigned)(Rb * K + C) * 2u; }
    const size_t kstep = (size_t)(BK * 2);
    const size_t hstep = (size_t)HALF * K * 2;
    const size_t tstep = 2 * hstep;
    const unsigned ldsw = (unsigned)wid * 1024u;
    const int aoff = lds_byte(wr * 64 + fr, fq * 8), boff = lds_byte(wc * 32 + fr, fq * 8);
#define PG8_SA(b, h) (((b) * 2 + (h)) * HTB)
#define PG8_SB(b, h) ((4 + (b) * 2 + (h)) * HTB)
#define PG8_STAGE(bufoff, gbase, voff) do { _Pragma("unroll") for (int _i = 0; _i < 2; ++_i) \
        __builtin_amdgcn_global_load_lds((const unsigned*)((const char*)(gbase) + (voff)[_i]), (PG8_LAS unsigned*)(lds + (bufoff) + ldsw + _i * 8192), 16, 0, 0); } while (0)
#define PG8_LDA(dst, b, h) do { _Pragma("unroll") for (int m = 0; m < 4; ++m) _Pragma("unroll") for (int k = 0; k < 2; ++k) dst[m][k] = *(const PG8_LAS bf16x8*)(lds + PG8_SA(b, h) + aoff + m * 2048 + k * 1024); } while (0)
#define PG8_LDB(dst, b, h) do { _Pragma("unroll") for (int n = 0; n < 2; ++n) _Pragma("unroll") for (int k = 0; k < 2; ++k) dst[n][k] = *(const PG8_LAS bf16x8*)(lds + PG8_SB(b, h) + boff + n * 2048 + k * 1024); } while (0)
#define PG8_MMA(ai, bj, At, Bt) do { __builtin_amdgcn_s_setprio(1); _Pragma("unroll") for (int m = 0; m < 4; ++m) _Pragma("unroll") for (int n = 0; n < 2; ++n) _Pragma("unroll") for (int k = 0; k < 2; ++k) \
        acc[ai][bj][m][n] = __builtin_amdgcn_mfma_f32_16x16x32_bf16(Bt[n][k], At[m][k], acc[ai][bj][m][n], 0, 0, 0); __builtin_amdgcn_s_setprio(0); } while (0)
#define PG8_WAIT_V(n) asm volatile("s_waitcnt vmcnt(" #n ")" ::: "memory")
#define PG8_WAIT_L(n) asm volatile("s_waitcnt lgkmcnt(" #n ")" ::: "memory")
#define PG8_BAR __builtin_amdgcn_s_barrier()
#define PG8_SCHED __builtin_amdgcn_sched_barrier(0)
    Unit cur, nxt; int ui = 0;
    if (!S.next(0, cur)) return;
    f32x4 acc[2][2][4][2];
#pragma unroll
    for (int a = 0; a < 2; ++a)
#pragma unroll
        for (int b = 0; b < 2; ++b)
#pragma unroll
            for (int m = 0; m < 4; ++m)
#pragma unroll
                for (int n = 0; n < 2; ++n) acc[a][b][m][n] = (f32x4){0.f, 0.f, 0.f, 0.f};
    bf16x8 At[4][2], B0[2][2], B1[2][2];
    const char* cA = (const char*)g.A + (size_t)cur.pm * tstep; const char* cB = (const char*)g.Bt + (size_t)cur.pn * tstep;
    S.a_ready(cur);
    if constexpr (SP2) {
        PG8_STAGE(PG8_SB(0, 0), cB, voffB); PG8_STAGE(PG8_SB(0, 1), cB + hstep, voffB); PG8_STAGE(PG8_SA(0, 0), cA, voffA); PG8_STAGE(PG8_SA(0, 1), cA + hstep, voffA);
        if (wr == 1) PG8_BAR;
        PG8_WAIT_V(2); PG8_BAR;
        PG8_STAGE(PG8_SB(1, 0), cB + kstep, voffB); PG8_STAGE(PG8_SA(1, 0), cA + kstep, voffA); PG8_STAGE(PG8_SB(1, 1), cB + hstep + kstep, voffB);
        PG8_WAIT_V(6); PG8_BAR;
    } else {
        PG8_STAGE(PG8_SB(0, 0), cB, voffB); PG8_STAGE(PG8_SA(0, 0), cA, voffA); PG8_STAGE(PG8_SB(0, 1), cB + hstep, voffB); PG8_STAGE(PG8_SA(0, 1), cA + hstep, voffA);
        if (wr == 1) PG8_BAR;
        PG8_WAIT_V(4); PG8_BAR;
        PG8_STAGE(PG8_SB(1, 0), cB + kstep, voffB); PG8_STAGE(PG8_SA(1, 0), cA + kstep, voffA); PG8_STAGE(PG8_SB(1, 1), cB + hstep + kstep, voffB);
        PG8_WAIT_V(6); PG8_BAR;
    }
    for (;;) {
        const bool has_next = S.next(ui + 1, nxt);
        const char* nA = has_next ? (const char*)g.A + (size_t)nxt.pm * tstep : cA; const char* nB = has_next ? (const char*)g.Bt + (size_t)nxt.pn * tstep : cB;
        for (int t = 0; t < nt; t += 2) {
            if constexpr (Epi::MIDK) { if (t == (nt >> 1)) E.midk(acc, cur, wr, wc, fr, fq); }
            const bool last = (t == nt - 2);
            const char* a1 = cA + (size_t)(t + 1) * kstep;
            const char* a2 = last ? nA : cA + (size_t)(t + 2) * kstep; const char* b2 = last ? nB : cB + (size_t)(t + 2) * kstep;
            const char* a3 = a2 + kstep; const char* b3 = b2 + kstep;
            if (last && has_next) S.a_ready(nxt);
            if constexpr (SP2) {
            PG8_LDB(B0, 0, 0); PG8_LDB(B1, 0, 1); PG8_SCHED; PG8_LDA(At, 0, 0); PG8_STAGE(PG8_SA(1, 1), a1 + hstep, voffA);
            PG8_WAIT_V(8); PG8_WAIT_L(0); PG8_BAR; PG8_MMA(0, 0, At, B0); PG8_MMA(0, 1, At, B1); PG8_BAR; PG8_SCHED;
            PG8_LDA(At, 0, 1); PG8_STAGE(PG8_SB(0, 0), b2, voffB); PG8_STAGE(PG8_SB(0, 1), b2 + hstep, voffB); PG8_STAGE(PG8_SA(0, 0), a2, voffA);
            PG8_WAIT_V(8); PG8_WAIT_L(0); PG8_BAR; PG8_MMA(1, 0, At, B0); PG8_MMA(1, 1, At, B1); PG8_BAR; PG8_SCHED;
            PG8_LDB(B0, 1, 0); PG8_LDB(B1, 1, 1); PG8_SCHED; PG8_LDA(At, 1, 0); PG8_STAGE(PG8_SA(0, 1), a2 + hstep, voffA);
            PG8_WAIT_V(8); PG8_WAIT_L(0); PG8_BAR; PG8_MMA(0, 0, At, B0); PG8_MMA(0, 1, At, B1); PG8_BAR; PG8_SCHED;
            PG8_LDA(At, 1, 1); PG8_STAGE(PG8_SB(1, 0), b3, voffB); PG8_STAGE(PG8_SB(1, 1), b3 + hstep, voffB); PG8_STAGE(PG8_SA(1, 0), a3, voffA);
            PG8_WAIT_V(8); PG8_WAIT_L(0); PG8_BAR; PG8_MMA(1, 0, At, B0); PG8_MMA(1, 1, At, B1); PG8_BAR; PG8_SCHED;
            } else {
            PG8_LDB(B0, 0, 0); PG8_SCHED; PG8_LDA(At, 0, 0); PG8_STAGE(PG8_SA(1, 1), a1 + hstep, voffA);
            PG8_WAIT_L(8); PG8_BAR; PG8_WAIT_L(0); PG8_MMA(0, 0, At, B0); PG8_BAR; PG8_SCHED;
            PG8_LDB(B1, 0, 1); PG8_STAGE(PG8_SB(0, 0), b2, voffB);
            PG8_BAR; PG8_WAIT_L(0); PG8_MMA(0, 1, At, B1); PG8_BAR;
            PG8_LDA(At, 0, 1); PG8_STAGE(PG8_SA(0, 0), a2, voffA);
            PG8_BAR; PG8_WAIT_L(0); PG8_MMA(1, 0, At, B0); PG8_BAR; PG8_SCHED;
            PG8_STAGE(PG8_SB(0, 1), b2 + hstep, voffB);
            PG8_WAIT_V(6); PG8_BAR; PG8_MMA(1, 1, At, B1); PG8_BAR;
            PG8_LDB(B0, 1, 0); PG8_SCHED; PG8_LDA(At, 1, 0); PG8_STAGE(PG8_SA(0, 1), a2 + hstep, voffA);
            PG8_WAIT_L(8); PG8_BAR; PG8_WAIT_L(0); PG8_MMA(0, 0, At, B0); PG8_BAR; PG8_SCHED;
            PG8_LDB(B1, 1, 1); PG8_STAGE(PG8_SB(1, 0), b3, voffB);
            PG8_BAR; PG8_WAIT_L(0); PG8_MMA(0, 1, At, B1); PG8_BAR;
            PG8_LDA(At, 1, 1); PG8_STAGE(PG8_SA(1, 0), a3, voffA);
            PG8_BAR; PG8_WAIT_L(0); PG8_MMA(1, 0, At, B0); PG8_BAR; PG8_SCHED;
            PG8_STAGE(PG8_SB(1, 1), b3 + hstep, voffB);
            PG8_WAIT_V(6); PG8_BAR; PG8_MMA(1, 1, At, B1); PG8_BAR;
            }
        }
        if constexpr (ALIGN_EPI) { if (wr == 0) PG8_BAR; }
        if constexpr (!Epi::AFTER_DRAIN) { E(acc, cur, wr, wc, fr, fq); S.done(cur); }
        if (!has_next) break;
#pragma unroll
        for (int a = 0; a < 2; ++a)
#pragma unroll
            for (int b = 0; b < 2; ++b)
#pragma unroll
                for (int m = 0; m < 4; ++m)
#pragma unroll
                    for (int n = 0; n < 2; ++n) acc[a][b][m][n] = (f32x4){0.f, 0.f, 0.f, 0.f};
        cur = nxt; cA = nA; cB = nB; ++ui;
        if constexpr (ALIGN_EPI) { if (wr == 1) PG8_BAR; }
    }
    PG8_WAIT_V(0);
    if constexpr (!ALIGN_EPI) { if (wr == 0) PG8_BAR; }
    PG8_BAR;
    if constexpr (Epi::AFTER_DRAIN) { E.fused(acc, cur, wr, wc, fr, fq, lds, wid, lane); S.done(cur); }
#undef PG8_SA
#undef PG8_SB
#undef PG8_STAGE
#undef PG8_LDA
#undef PG8_LDB
#undef PG8_MMA
#undef PG8_WAIT_V
#undef PG8_WAIT_L
#undef PG8_BAR
#undef PG8_SCHED
}
}

constexpr size_t MiB = 1u << 20;
constexpr size_t WS_CTL = 0, CTL_ZERO_BYTES = 1 * MiB;
constexpr size_t WS_WT_IN = 1 * MiB;
constexpr size_t WS_LST = 1 * MiB, WS_DST = 17 * MiB;
constexpr size_t WS_WT_CAT = 19 * MiB;
constexpr size_t WS_WT_OUT = 23 * MiB;
constexpr size_t WS_H = 25 * MiB;
constexpr size_t WS_WT_FIN = 25 * MiB;
constexpr size_t WS_WT_DOWN = 36 * MiB;
constexpr size_t WS_QQ = 57 * MiB;
constexpr size_t WS_AK = 121 * MiB, WS_AV = 153 * MiB;
constexpr size_t WS_HLF = 185 * MiB, WS_HSG = 217 * MiB;
constexpr size_t WS_KMEAN = 249 * MiB, WS_KMEANB = 249 * MiB + 512 * 1024, WS_LB = 250 * MiB, WS_SSQ = 251 * MiB;
constexpr size_t WS_MERGED = 121 * MiB;
constexpr size_t WS_X1 = 153 * MiB;
constexpr size_t WS_A2 = 217 * MiB;
constexpr size_t WS_ACT = 57 * MiB;
constexpr size_t WS_END = 256 * MiB;
static_assert(WS_ACT + (size_t)MTOK * DFF * 2 <= WS_X1 && WS_SSQ + (size_t)MTOK * 16 * 4 <= WS_END, "d_ws map");
constexpr int CW_TMO = 0, CW_BAR = 4096;

constexpr int RING_OFF = 0, RING_BYTES = 131072;
constexpr int EPI_SCR_OFF = RING_BYTES;
constexpr int LDSCTL_OFF = RING_BYTES + 12288, MISC_OFF = LDSCTL_OFF + 320;
constexpr int LDS_BYTES = 147456;
static_assert(MISC_OFF + 128 <= LDS_BYTES, "LDS map");
constexpr int NWAVES = 8;

__device__ __forceinline__ float bf2f(unsigned short b) { return __uint_as_float((unsigned)b << 16); }


#define GAS __attribute__((address_space(1)))
#define LAS __attribute__((address_space(3)))
typedef unsigned short bf16;
typedef unsigned v4u __attribute__((ext_vector_type(4)));
typedef float f32x4 __attribute__((ext_vector_type(4)));
typedef short bf16x8 __attribute__((ext_vector_type(8)));
typedef GAS unsigned gu32;
typedef GAS unsigned long long gu64;
#define RLX_AGENT __ATOMIC_RELAXED, __HIP_MEMORY_SCOPE_AGENT
#define LDS_WAIT() asm volatile("s_waitcnt lgkmcnt(0)" ::: "memory")
#define VM_WAIT() asm volatile("s_waitcnt vmcnt(0)" ::: "memory")
__device__ __forceinline__ unsigned long long rt() { return __builtin_amdgcn_s_memrealtime(); }
__device__ __forceinline__ unsigned f2bf(float f) { unsigned u = __builtin_bit_cast(unsigned, f); return (u + 0x7fffu + ((u >> 16) & 1u)) >> 16; }
__device__ __forceinline__ unsigned pk2(float lo, float hi) { return f2bf(lo) | (f2bf(hi) << 16); }

#define XB_TMO      128
#define XB_XCNT(j)  (256  + 64 * (j))
#define XB_XSUB(j)  (1280 + 64 * (j))
#define XB_XGEN(j)  (2304 + 64 * (j))
#define XB_TOP      3328
#define XB_TOPGEN   3392
#define XCD_BAR_WORDS 3456
#define XB_SPIN_CAP (1u << 18)

__device__ __forceinline__ unsigned xb_ld(unsigned* p)              { return __hip_atomic_load(p, __ATOMIC_RELAXED, __HIP_MEMORY_SCOPE_AGENT); }
__device__ __forceinline__ unsigned xb_add(unsigned* p, unsigned v) { return __hip_atomic_fetch_add(p, v, __ATOMIC_RELAXED, __HIP_MEMORY_SCOPE_AGENT); }
__device__ __forceinline__ unsigned xb_xcc_id() { return (unsigned)__builtin_amdgcn_s_getreg((3 << 11) | 20) & 0xFu; }
#define XB_SPIN(cond, bar) do { unsigned _sp = 0; while (cond) { __builtin_amdgcn_s_sleep(1); \
    if ((++_sp & 255u) == 0u) { if (xb_ld(&(bar)[XB_TMO])) break; if (_sp > XB_SPIN_CAP) { atomicAdd(&(bar)[XB_TMO], 1u); break; } } } } while (0)

struct XcdBarrier {
    unsigned* bar; unsigned x;
    volatile LAS unsigned* st;
};

__device__ __forceinline__ XcdBarrier xcd_barrier_post(unsigned* bar, volatile LAS unsigned* st) {
    XcdBarrier b; b.bar = bar; b.x = xb_xcc_id(); b.st = st;
    if (threadIdx.x == 0) (void)xb_add(&bar[XB_XCNT(b.x)], 1u);
    return b;
}
__device__ __forceinline__ void xcd_barrier_complete(unsigned* bar, unsigned x, unsigned& nloc, unsigned& nx) {
    const unsigned G = gridDim.x * gridDim.y * gridDim.z;
    unsigned sum, cnt, mine, sp = 0u;
    for (;;) {
        sum = 0u; cnt = 0u; mine = 0u;
#pragma unroll
        for (unsigned j = 0; j < 16; ++j) { const unsigned c = xb_ld(&bar[XB_XCNT(j)]); sum += c; cnt += (c > 0u) ? 1u : 0u; mine = (j == x) ? c : mine; }
        if (sum == G) break;
        __builtin_amdgcn_s_sleep(1);
        if ((++sp & 255u) == 0u) { if (xb_ld(&bar[XB_TMO])) break; if (sp > XB_SPIN_CAP) { atomicAdd(&bar[XB_TMO], 1u); break; } }
    }
    nloc = mine > 0u ? mine : 1u; nx = cnt > 0u ? cnt : 1u;
}

__device__ __forceinline__ void xcd_barrier(const XcdBarrier& b) {
    asm volatile("s_waitcnt vmcnt(0)" ::: "memory");
    __syncthreads();
    if (threadIdx.x == 0) {
        unsigned* bar = b.bar;
        __builtin_amdgcn_s_waitcnt(0);
        unsigned nloc = b.st[0], nx = b.st[1];
        if (nloc == 0u) { xcd_barrier_complete(bar, b.x, nloc, nx); b.st[0] = nloc; b.st[1] = nx; }
        const unsigned old = xb_add(&bar[XB_XSUB(b.x)], 1u);
        const unsigned gen = old / nloc;
        if (old + 1u == (gen + 1u) * nloc) {
            __builtin_amdgcn_fence(__ATOMIC_RELEASE, "agent");
            asm volatile("s_waitcnt vmcnt(0)" ::: "memory");
            const unsigned og = xb_add(&bar[XB_TOP], 1u);
            const unsigned tg = og / nx;
            if (og + 1u == (tg + 1u) * nx) xb_add(&bar[XB_TOPGEN], 1u);
            else XB_SPIN(xb_ld(&bar[XB_TOPGEN]) == tg, bar);
            __builtin_amdgcn_fence(__ATOMIC_ACQUIRE, "agent");
            xb_add(&bar[XB_XGEN(b.x)], 1u);
            asm volatile("s_waitcnt vmcnt(0)" ::: "memory");
        } else {
            XB_SPIN(xb_ld(&bar[XB_XGEN(b.x)]) == gen, bar);
            __builtin_amdgcn_fence(__ATOMIC_ACQUIRE, "agent");
            asm volatile("s_waitcnt vmcnt(0)" ::: "memory");
        }
    }
    __syncthreads();
}


struct Frame {
    LAS unsigned char* lds;
    volatile LAS unsigned* MISC;
    gu32* ctl;
    int tid, lane, wave;
    int vcu, G;
};

__device__ __forceinline__ float wave_sum(float v) {
#pragma unroll
    for (int o = 1; o < 64; o <<= 1) v += __shfl_xor(v, o);
    return v;
}
__device__ __forceinline__ void p0_transpose_item(const float* W, int ldw, int k0, int ncol0, bf16* WT, int ldt, int drow, int dk0, LAS float* scr, int lane) {
#pragma unroll 8
    for (int i = 0; i < 32; ++i) { const int kk = 2 * i + (lane >> 5); scr[kk * 33 + (lane & 31)] = W[(size_t)(k0 + kk) * ldw + ncol0 + (lane & 31)]; }
    LDS_WAIT(); asm volatile("" ::: "memory");
    const int c = lane & 7;
#pragma unroll
    for (int j = 0; j < 4; ++j) { const int n = (lane >> 3) + 8 * j; const LAS float* s = scr + (8 * c) * 33 + n;
        v4u o; o.x = pk2(s[0 * 33], s[1 * 33]); o.y = pk2(s[2 * 33], s[3 * 33]); o.z = pk2(s[4 * 33], s[5 * 33]); o.w = pk2(s[6 * 33], s[7 * 33]);
        *(GAS v4u*)(WT + (size_t)(drow + n) * ldt + dk0 + k0 + 8 * c) = o; }
    LDS_WAIT(); asm volatile("" ::: "memory");
}
__device__ __forceinline__ void rms_row_to_bf16(const float* xrow, const float* g, bf16* orow, int lane) {
    const GAS f32x4* xr = (const GAS f32x4*)xrow + lane; const GAS f32x4* gr = (const GAS f32x4*)g + lane;
    f32x4 v[4]; float s = 0.f;
#pragma unroll
    for (int j = 0; j < 4; ++j) { v[j] = xr[64 * j]; s += (v[j].x * v[j].x + v[j].y * v[j].y) + (v[j].z * v[j].z + v[j].w * v[j].w); }
    const float rstd = 1.f / sqrtf(wave_sum(s) * (1.f / DM) + NORM_EPS);
    GAS unsigned long long* o8 = (GAS unsigned long long*)orow + lane;
#pragma unroll
    for (int j = 0; j < 4; ++j) { const f32x4 gg = gr[64 * j];
        o8[64 * j] = (unsigned long long)pk2(v[j].x * rstd * gg.x, v[j].y * rstd * gg.y) | ((unsigned long long)pk2(v[j].z * rstd * gg.z, v[j].w * rstd * gg.w) << 32); }
}

struct Args { const float* in[15]; float* out; unsigned char* ws; int ph_lo, ph_hi; };
static_assert(sizeof(Args) == 15 * 8 + 8 + 8 + 8, "Args has no padding");

__global__ void __launch_bounds__(NWAVES * 64, 2) mk_fwd(Args args) {
    extern __shared__ __attribute__((aligned(16))) unsigned char lds[];
    Frame F;
    F.lds = (LAS unsigned char*)lds;
    F.MISC = (volatile LAS unsigned*)(F.lds + MISC_OFF);
    F.tid = threadIdx.x; F.lane = F.tid & 63; F.wave = __builtin_amdgcn_readfirstlane(F.tid >> 6);
    F.G = gridDim.x; { const int bx = blockIdx.x; F.vcu = (F.G % 8 == 0) ? (bx % 8) * (F.G / 8) + bx / 8 : bx; }
    unsigned char* ws = args.ws;
    F.ctl = (gu32*)(ws + WS_CTL);
    const float* x = args.in[0]; const float* attn_g = args.in[1]; const float* w_in = args.in[2]; const float* lb_gamma = args.in[3];
    const float* hg_out_g = args.in[4]; const float* q_g = args.in[5]; const float* k_g = args.in[6]; const float* rel_tab = args.in[7];
    const float* w_bh = args.in[8]; const float* w_ba = args.in[9]; const float* w_out = args.in[10]; const float* ffn_g = args.in[11];
    const float* w_gate = args.in[12]; const float* w_up = args.in[13]; const float* w_down = args.in[14];
    (void)hg_out_g; (void)rel_tab;
    bf16* WT_IN = (bf16*)(ws + WS_WT_IN); bf16* WT_CAT = (bf16*)(ws + WS_WT_CAT); bf16* WT_OUT = (bf16*)(ws + WS_WT_OUT);
    bf16* WT_FIN = (bf16*)(ws + WS_WT_FIN); bf16* WT_DOWN = (bf16*)(ws + WS_WT_DOWN); bf16* HB = (bf16*)(ws + WS_H);
    bf16* QQ = (bf16*)(ws + WS_QQ); bf16* AK = (bf16*)(ws + WS_AK); bf16* AV = (bf16*)(ws + WS_AV);
    unsigned short* HLF = (unsigned short*)(ws + WS_HLF); bf16* HSG = (bf16*)(ws + WS_HSG);
    float* KMEAN = (float*)(ws + WS_KMEAN); bf16* KMEANB = (bf16*)(ws + WS_KMEANB); float* LB = (float*)(ws + WS_LB); float* SSQ = (float*)(ws + WS_SSQ);
    bf16* MERGED = (bf16*)(ws + WS_MERGED); float* X1 = (float*)(ws + WS_X1); bf16* A2 = (bf16*)(ws + WS_A2); bf16* ACT = (bf16*)(ws + WS_ACT);
    bf16* GATES = (bf16*)args.out;

    for (int u = F.tid; u < (LDS_BYTES - LDSCTL_OFF) / 4; u += NWAVES * 64) ((LAS unsigned*)(F.lds + LDSCTL_OFF))[u] = 0u;
    __syncthreads();
    const int lo = args.ph_lo, hi = args.ph_hi;
    XcdBarrier bar; bar.bar = (unsigned*)(F.ctl + CW_BAR); bar.x = 0; bar.st = nullptr;
    if (hi - lo > 1) bar = xcd_barrier_post((unsigned*)(F.ctl + CW_BAR), F.MISC + 8);
#ifndef PHMASK
#define PHMASK 0x3ff
#endif
#define IN(k) (((PHMASK >> (k)) & 1) && lo <= (k) && (k) < hi)
#define BOTH(k) (IN(k) && IN((k) + 1))
#define GRID_BAR() xcd_barrier(bar)
    const int gw = F.vcu * NWAVES + F.wave, NGW = F.G * NWAVES;
    LAS float* scr = (LAS float*)(F.lds + RING_OFF + F.wave * 16384);

    if (IN(0)) {
        constexpr int I_IN = 16 * 288, I_B = 16 * 32;
        for (int it = gw; it < I_IN + 3 * I_B; it += NGW) {
            int r = it;
            if (r < I_IN) { const int kb = r / 288, nb = r % 288, c = 32 * nb; const int d = (c >= 4096 && c < 7168) ? c - 4096 : (c < 4096 ? 3072 + c : c);
                p0_transpose_item(w_in, INCOLS, 64 * kb, c, WT_IN, 1024, d, 0, scr, F.lane); continue; } r -= I_IN;
            if (r < I_B) { p0_transpose_item(w_bh, 1024, 64 * (r / 32), 32 * (r % 32), WT_CAT, 2048, 32 * (r % 32), 0, scr, F.lane); continue; } r -= I_B;
            if (r < I_B) { p0_transpose_item(w_ba, 1024, 64 * (r / 32), 32 * (r % 32), WT_CAT, 2048, 32 * (r % 32), 1024, scr, F.lane); continue; } r -= I_B;
            p0_transpose_item(w_out, 1024, 64 * (r / 32), 32 * (r % 32), WT_OUT, 1024, 32 * (r % 32), 0, scr, F.lane);
        }
        for (int m = gw; m < MTOK; m += NGW) rms_row_to_bf16(x + (size_t)m * DM, attn_g, HB + (size_t)m * DM, F.lane);
        { const int gt = blockIdx.x * (NWAVES * 64) + F.tid; if (gt < 1024) LB[gt] = 1.f / (1.f + __expf(lb_gamma[1024 + gt] - lb_gamma[gt])); }
        if (BOTH(0)) GRID_BAR();
    }
    if (IN(1)) {
        pg8::Gemm g{HB, WT_IN, MTOK, 3072, 1024}; pg8::StaticOrder S; S.init(MTOK, 3072, F.G, (int)blockIdx.x);
        pg8::EpiProj E{0, QQ, AK, AV, HLF, HSG, GATES, KMEAN, KMEANB, LB, q_g, k_g, (PG8_LAS unsigned char*)(F.lds + EPI_SCR_OFF)};
        pg8::gemm_phase<pg8::EpiProj, pg8::StaticOrder, true, true>(F.lds + RING_OFF, g, S, E);
        if (BOTH(1)) GRID_BAR();
    }
    if (IN(2)) {
        if (BOTH(2)) GRID_BAR();
    }
    if (IN(3)) {
        pg8::Gemm g{HB, WT_IN + (size_t)3072 * 1024, MTOK, 6144, 1024}; pg8::StaticOrder S; S.init(MTOK, 6144, F.G, (int)blockIdx.x);
        pg8::EpiProj E{1, QQ, AK, AV, HLF, HSG, GATES, KMEAN, KMEANB, LB, q_g, k_g, (PG8_LAS unsigned char*)(F.lds + EPI_SCR_OFF)};
        pg8::gemm_phase<pg8::EpiProj, pg8::StaticOrder, true, true>(F.lds + RING_OFF, g, S, E);
        if (BOTH(3)) GRID_BAR();
    }
    if (IN(4)) {
        constexpr int I_G = 16 * 88, I_D = 44 * 32;
        for (int it = gw; it < 2 * I_G + I_D; it += NGW) {
            int r = it;
            if (r < 2 * I_G) { const int up = r >= I_G; if (up) r -= I_G; const int kb = r / 88, c = 32 * (r % 88);
                p0_transpose_item(up ? w_up : w_gate, DFF, 64 * kb, c, WT_FIN, 1024, 256 * (c / 128) + (c % 128) + (up ? 128 : 0), 0, scr, F.lane); continue; } r -= 2 * I_G;
            p0_transpose_item(w_down, 1024, 64 * (r / 32), 32 * (r % 32), WT_DOWN, DFF, 32 * (r % 32), 0, scr, F.lane);
        }
        if (BOTH(4)) GRID_BAR();
    }
    if (IN(5)) {
        if (BOTH(5)) GRID_BAR();
    }
    if (IN(6)) {
        pg8::Gemm g{QQ, WT_CAT, MTOK, 1024, 2048}; pg8::StaticOrder S; S.init(MTOK, 1024, F.G, (int)blockIdx.x);
        pg8::EpiMerge E{GATES, MERGED};
        pg8::gemm_phase<pg8::EpiMerge, pg8::StaticOrder, false, true>(F.lds + RING_OFF, g, S, E);
        if (BOTH(6)) GRID_BAR();
    }
    if (IN(7)) {
        pg8::Gemm g{MERGED, WT_OUT, MTOK, 1024, 1024}; pg8::StaticOrder S; S.init(MTOK, 1024, F.G, (int)blockIdx.x);
        pg8::EpiOut E{x, X1, A2, ffn_g, SSQ};
        pg8::gemm_phase<pg8::EpiOut, pg8::StaticOrder, false, true>(F.lds + RING_OFF, g, S, E);
        if (BOTH(7)) GRID_BAR();
    }
    if (IN(8)) {
        pg8::Gemm g{A2, WT_FIN, MTOK, 2 * DFF, 1024}; pg8::StaticOrder S; S.init(MTOK, 2 * DFF, F.G, (int)blockIdx.x);
        pg8::EpiFfnIn E{SSQ, ACT};
        pg8::gemm_phase<pg8::EpiFfnIn, pg8::StaticOrder, true, true>(F.lds + RING_OFF, g, S, E);
        if (BOTH(8)) GRID_BAR();
    }
    if (IN(9)) {
        pg8::Gemm g{ACT, WT_DOWN, MTOK, 1024, DFF}; pg8::StaticOrder S; S.init(MTOK, 1024, F.G, (int)blockIdx.x);
        pg8::EpiDown E{X1, args.out};
        pg8::gemm_phase<pg8::EpiDown, pg8::StaticOrder, false, true>(F.lds + RING_OFF, g, S, E);
    }
#undef IN
#undef BOTH
#undef GRID_BAR
}

__device__ __forceinline__ int t5_bucket(int n) {
    if (n < 16) return n;
    int b = 15;
    b += n >= 16; b += n >= 19; b += n >= 21; b += n >= 24; b += n >= 27; b += n >= 31; b += n >= 35; b += n >= 40;
    b += n >= 46; b += n >= 52; b += n >= 59; b += n >= 67; b += n >= 77; b += n >= 87; b += n >= 99; b += n >= 113;
    return b;
}
__global__ void __launch_bounds__(256) naive_attn(const bf16* AK, const bf16* AV, bf16* QQ, const float* KMEAN, const float* table) {
    __shared__ float qs[128]; __shared__ float gate[16]; __shared__ int sel[4]; __shared__ float lg[1024]; __shared__ float red[256]; __shared__ float bias_s[32];
    const int tid = threadIdx.x; const int t = blockIdx.x % SEQ, bh = blockIdx.x / SEQ, h = bh % NH, b = bh / NH;
    const size_t m = (size_t)b * SEQ + t; const int c = t >> 8;
    if (tid < 128) qs[tid] = bf2f(QQ[m * 2048 + 1024 + h * 128 + tid]);
    if (tid < 32) bias_s[tid] = table[tid * 8 + h];
    __syncthreads();
    if (tid < 16) { float g = -INFINITY; if (tid < c) { g = 0.f; const float* km = KMEAN + ((size_t)bh * NBLK + tid) * HD; for (int d = 0; d < 128; ++d) g += qs[d] * km[d]; } gate[tid] = g; }
    __syncthreads();
    if (tid == 0) { unsigned used = 0u;
        for (int s = 0; s < 3; ++s) { int best = -1; float bv = 0.f; for (int n = 0; n < 16; ++n) if (!((used >> n) & 1u)) { const float gv = gate[n]; if (best < 0 || gv > bv) { best = n; bv = gv; } } used |= 1u << best; sel[s] = best; } }
    __syncthreads();
    for (int s = 0; s < 4; ++s) {
        int blk; bool valid;
        if (s == 0) { blk = c; valid = tid <= (t & 255); } else { blk = sel[s - 1]; valid = blk < c; }
        float logit = -INFINITY;
        if (valid) { const int pos = blk * 256 + tid; const bf16* kr = AK + ((size_t)b * SEQ + pos) * 1024 + h * 128; float dot = 0.f;
            for (int d = 0; d < 128; ++d) dot += qs[d] * bf2f(kr[d]);
            logit = dot * ATT_SCALE + bias_s[t5_bucket(t - pos)]; }
        lg[s * 256 + tid] = logit;
    }
    __syncthreads();
    float mx = fmaxf(fmaxf(lg[tid], lg[256 + tid]), fmaxf(lg[512 + tid], lg[768 + tid]));
    red[tid] = mx; __syncthreads();
    for (int o = 128; o > 0; o >>= 1) { if (tid < o) red[tid] = fmaxf(red[tid], red[tid + o]); __syncthreads(); }
    mx = red[0]; __syncthreads();
    float ps = 0.f;
    for (int s = 0; s < 4; ++s) { const float p = __expf(lg[s * 256 + tid] - mx); lg[s * 256 + tid] = p; ps += p; }
    red[tid] = ps; __syncthreads();
    for (int o = 128; o > 0; o >>= 1) { if (tid < o) red[tid] += red[tid + o]; __syncthreads(); }
    const float tot = red[0];
    if (tid < 128) { float acc = 0.f;
        for (int s = 0; s < 4; ++s) { const int blk = (s == 0) ? c : sel[s - 1]; if (s > 0 && blk >= c) continue;
            const bf16* vr = AV + ((size_t)b * SEQ + blk * 256) * 1024 + h * 128 + tid;
            for (int j = 0; j < 256; ++j) { const float p = lg[s * 256 + j]; if (p != 0.f) acc += p * bf2f(vr[(size_t)j * 1024]); } }
        QQ[m * 2048 + 1024 + h * 128 + tid] = (bf16)f2bf(acc / tot); }
}
__global__ void __launch_bounds__(128) naive_hgrn(bf16* QQ, const bf16* HK, const bf16* HV, const unsigned short* HLF, const bf16* HSG, const float* gout) {
    __shared__ float qs[128], ks[128], fs[128]; __shared__ float red[2];
    const int v = threadIdx.x, bh = blockIdx.x, h = bh % NH, b = bh / NH; const float g = gout[v];
    float S[128];
#pragma unroll
    for (int k = 0; k < 128; ++k) S[k] = 0.f;
    for (int t = 0; t < SEQ; ++t) { const size_t m = (size_t)b * SEQ + t;
        qs[v] = bf2f(QQ[m * 2048 + h * 128 + v]); ks[v] = bf2f(HK[m * 1024 + h * 128 + v]);
        { const unsigned short hb = HLF[m * 1024 + h * 128 + v]; _Float16 hf = __builtin_bit_cast(_Float16, hb); fs[v] = exp2f((float)hf); }
        const float vv = bf2f(HV[m * 1024 + h * 128 + v]), sg = bf2f(HSG[m * 1024 + h * 128 + v]);
        __syncthreads();
        float o = 0.f;
#pragma unroll
        for (int k = 0; k < 128; ++k) { S[k] = fs[k] * S[k] + ks[k] * vv; o += qs[k] * S[k]; }
        const float ss = wave_sum(o * o); if ((v & 63) == 0) red[v >> 6] = ss;
        __syncthreads();
        const float rstd = 1.f / sqrtf((red[0] + red[1]) * (1.f / 128.f) + NORM_EPS);
        QQ[m * 2048 + h * 128 + v] = (bf16)f2bf(o * rstd * g * sg);
    }
}

extern "C" void kernel_launch(void* const* d_in, const int* in_sizes, int n_in, void* d_out, int out_size, void* d_ws, size_t ws_size, hipStream_t stream) {
    static int grid = 0;
    if (grid == 0) {
        if (n_in != 15 || in_sizes[0] != MTOK * DM || out_size != MTOK * DM || ws_size < WS_END) {
            fprintf(stderr, "kernel_launch: shape/workspace mismatch (n_in %d, in0 %d, out %d, ws %zu); nothing launched\n", n_in, n_in > 0 ? in_sizes[0] : -1, out_size, ws_size); grid = -1; return; }
        int dev = 0, cus = 0, per_cu = 0;
        if (hipGetDevice(&dev) != hipSuccess || hipDeviceGetAttribute(&cus, hipDeviceAttributeMultiprocessorCount, dev) != hipSuccess) { grid = -1; return; }
        if (hipFuncSetAttribute((const void*)mk_fwd, hipFuncAttributeMaxDynamicSharedMemorySize, LDS_BYTES) != hipSuccess) { fprintf(stderr, "kernel_launch: hipFuncSetAttribute failed\n"); grid = -1; return; }
        if (hipOccupancyMaxActiveBlocksPerMultiprocessor(&per_cu, (const void*)mk_fwd, NWAVES * 64, LDS_BYTES) != hipSuccess || per_cu < 1) { fprintf(stderr, "kernel_launch: occupancy query says %d\n", per_cu); per_cu = 1; }
        (void)hipGetLastError();
        grid = cus;
    }
    if (grid < 0) return;
    (void)hipMemsetAsync((char*)d_ws + WS_CTL, 0, CTL_ZERO_BYTES, stream);
    Args a{};
    for (int i = 0; i < 15; ++i) a.in[i] = (const float*)d_in[i];
    a.out = (float*)d_out; a.ws = (unsigned char*)d_ws;
    unsigned char* ws = (unsigned char*)d_ws;
#define FRAME(lo_, hi_) do { a.ph_lo = (lo_); a.ph_hi = (hi_); hipLaunchKernelGGL(mk_fwd, dim3(grid), dim3(NWAVES * 64), LDS_BYTES, stream, a); } while (0)
    FRAME(0, 1);
    FRAME(1, 2);
    hipLaunchKernelGGL(naive_attn, dim3(BATCH * NH * SEQ), dim3(256), 0, stream, (const bf16*)(ws + WS_AK), (const bf16*)(ws + WS_AV), (bf16*)(ws + WS_QQ), (const float*)(ws + WS_KMEAN), (const float*)d_in[7]);
    FRAME(3, 4);
    FRAME(4, 5);
    hipLaunchKernelGGL(naive_hgrn, dim3(BATCH * NH), dim3(128), 0, stream, (bf16*)(ws + WS_QQ), (const bf16*)(ws + WS_AK), (const bf16*)(ws + WS_AV), (const unsigned short*)(ws + WS_HLF), (const bf16*)(ws + WS_HSG), (const float*)d_in[4]);
    FRAME(6, 7);
    FRAME(7, 8);
    FRAME(8, 9);
    FRAME(9, 10);
#undef FRAME
    const hipError_t le = hipPeekAtLastError();
    if (le != hipSuccess) fprintf(stderr, "kernel_launch: launch failed: %s\n", hipGetErrorName(le));
}
```

```cpp
#include <hip/hip_runtime.h>
#include <cstdio>
#include <cstdint>

constexpr int BATCH = 4, SEQ = 4096, DM = 1024, MTOK = BATCH * SEQ;
constexpr int NH = 8, HD = 128;
constexpr int DFF = 2816, INCOLS = 9216;
constexpr int MBLK = 256, NBLK = SEQ / MBLK, TOPK = 3;
constexpr float NORM_EPS = 1e-6f;
constexpr float ATT_SCALE = 0.08838834764831845f;
constexpr float LOG2E = 1.4426950408889634f;


namespace pg8 {
#define PG8_LAS __attribute__((address_space(3)))
typedef unsigned short bf16_t;
typedef short bf16x8 __attribute__((ext_vector_type(8)));
typedef float f32x4 __attribute__((ext_vector_type(4)));
typedef unsigned u32x4 __attribute__((ext_vector_type(4)));
constexpr int BM = 256, BK = 64, HALF = 128, HTB = HALF * BK * 2  , STAGE_BYTES = 8 * HTB, NXCD = 8;

__host__ __device__ __forceinline__ int lds_byte(int r, int c) { const int st = (r >> 4) * 2 + (c >> 5), rr = r & 15, cc = c & 31, ob = rr * 64 + cc * 2; return st * 1024 + (ob ^ (((ob >> 9) & 1) << 5)); }
__host__ __device__ __forceinline__ void stage_rc(int b, int& R, int& C) { const int st = b / 1024, sb = b % 1024, swz = sb ^ (((sb >> 9) & 1) << 5); R = (st >> 1) * 16 + swz / 64; C = (st & 1) * 32 + (swz % 64) / 2; }
__host__ __device__ __forceinline__ int perm32(int rho) { const int n = rho >> 4, i = rho & 15; return 8 * (i >> 2) + 4 * n + (i & 3); }

struct Unit { int pm, pn; };
struct Gemm { const bf16_t* A; const bf16_t* Bt; int M, N, K; };

struct StaticOrder {
    int nM, nN, nwg, G, c, WGM;
    __host__ __device__ void init(int M, int N, int G_, int c_, int wgm = 4) { nM = M / BM; nN = N / BM; nwg = nM * nN; G = G_; c = c_; WGM = wgm; }
    __host__ __device__ bool next(int i, Unit& u) const {
        const long L = (long)i * G + c; if (L >= nwg) return false;
        int wgid = (int)L; { const int q = nwg / NXCD, r = nwg % NXCD, xcd = wgid % NXCD, off = wgid / NXCD; wgid = (xcd < r ? xcd * (q + 1) : r * (q + 1) + (xcd - r) * q) + off; }
        const int nig = WGM * nN, gid = wgid / nig, fm = gid * WGM, gsz = (nM - fm) < WGM ? (nM - fm) : WGM;
        u.pm = fm + ((wgid % nig) % gsz); u.pn = (wgid % nig) / gsz; return true;
    }
    __device__ __forceinline__ void a_ready(const Unit&) const {}
    __device__ __forceinline__ void done(const Unit&) const {}
};

__device__ __forceinline__ unsigned cvt_pk_bf16(float lo, float hi) { unsigned r; asm volatile("v_cvt_pk_bf16_f32 %0, %1, %2" : "=v"(r) : "v"(lo), "v"(hi)); return r; }
typedef float f32x2 __attribute__((ext_vector_type(2)));

typedef unsigned u32x2 __attribute__((ext_vector_type(2)));
typedef _Float16 f16x8 __attribute__((ext_vector_type(8)));
__device__ __forceinline__ float bf2f(unsigned short b) { return __uint_as_float((unsigned)b << 16); }
__device__ __forceinline__ u32x4 pack8bf(f32x4 a, f32x4 b) { u32x4 w; w.x = cvt_pk_bf16(a[0], a[1]); w.y = cvt_pk_bf16(a[2], a[3]); w.z = cvt_pk_bf16(b[0], b[1]); w.w = cvt_pk_bf16(b[2], b[3]); return w; }
__device__ __forceinline__ void unpack8bf(u32x4 w, f32x4& a, f32x4& b) {
    a[0] = __uint_as_float(w.x << 16); a[1] = __uint_as_float(w.x & 0xffff0000u); a[2] = __uint_as_float(w.y << 16); a[3] = __uint_as_float(w.y & 0xffff0000u);
    b[0] = __uint_as_float(w.z << 16); b[1] = __uint_as_float(w.z & 0xffff0000u); b[2] = __uint_as_float(w.w << 16); b[3] = __uint_as_float(w.w & 0xffff0000u); }
__device__ __forceinline__ float fsigmoid(float x) { return __builtin_amdgcn_rcpf(1.f + __builtin_amdgcn_exp2f(-x * 1.4426950408889634f)); }
template <int CTRL> __device__ __forceinline__ float dpp_mov(float v) { return __int_as_float(__builtin_amdgcn_update_dpp(0, __float_as_int(v), CTRL, 0xf, 0xf, true)); }
__device__ __forceinline__ float row16_sum(float s) { s += dpp_mov<0xB1>(s); s += dpp_mov<0x4E>(s); s += dpp_mov<0x141>(s); s += dpp_mov<0x140>(s); return s; }
__device__ __forceinline__ float rows4_sum(float s) {
    auto r16 = __builtin_amdgcn_permlane16_swap(__float_as_uint(s), __float_as_uint(s), false, false);
    const float pr = __uint_as_float(r16[0]) + __uint_as_float(r16[1]);
    auto r32 = __builtin_amdgcn_permlane32_swap(__float_as_uint(pr), __float_as_uint(pr), false, false);
    return __uint_as_float(r32[0]) + __uint_as_float(r32[1]);
}
#define PG8_EPI_BAR() do { asm volatile("s_waitcnt lgkmcnt(0)" ::: "memory"); __builtin_amdgcn_s_barrier(); asm volatile("" ::: "memory"); } while (0)

struct EpiProj {
    static constexpr bool PERM = true, AFTER_DRAIN = false, MIDK = false;
    int mode;
    bf16_t* QQ; bf16_t* AK; bf16_t* AV; unsigned short* HLF; bf16_t* HSG; bf16_t* GATES; float* KMEAN; bf16_t* KMEANB;
    const float* lb; const float* qg; const float* kg;
    PG8_LAS unsigned char* scr;
    __device__ __forceinline__ void midk(f32x4 (&)[2][2][4][2], const Unit&, int, int, int, int) const {}
    __device__ __forceinline__ void operator()(const f32x4 (&acc)[2][2][4][2], const Unit& u, int wr, int wc, int fr, int fq) const {
        const int row0 = u.pm * BM + wr * 64 + fr;
        const int cw = wc * 32 + 8 * fq;
        int kind, c0;
        if (mode == 0) { kind = u.pn >> 2; c0 = (u.pn & 3) * 256; }
        else if (u.pn < 16) { kind = 3 + (u.pn >> 2); c0 = (u.pn & 3) * 256; }
        else { kind = 7; c0 = (u.pn - 16) * 256; }
        if (kind <= 1) {
            PG8_LAS float* P = (PG8_LAS float*)scr; PG8_LAS float* CS = (PG8_LAS float*)(scr + 8192);
#pragma unroll
            for (int ai = 0; ai < 2; ++ai)
#pragma unroll
                for (int m = 0; m < 4; ++m)
#pragma unroll
                    for (int bj = 0; bj < 2; ++bj) { const f32x4 a = acc[ai][bj][m][0], b = acc[ai][bj][m][1];
                        float s = (a[0] * a[0] + a[1] * a[1]) + (a[2] * a[2] + a[3] * a[3]) + (b[0] * b[0] + b[1] * b[1]) + (b[2] * b[2] + b[3] * b[3]);
                        s = rows4_sum(s);
                        if (fq == 0) P[((ai * 128 + wr * 64 + m * 16 + fr) * 2 + bj) * 4 + wc] = s; }
            PG8_EPI_BAR();
            const float* gp = (kind == 0 ? qg : kg) + cw;
            const f32x4 g0 = *(const f32x4*)gp, g1 = *(const f32x4*)(gp + 4);
            f32x4 cs[2][2];
#pragma unroll
            for (int bj = 0; bj < 2; ++bj) { cs[bj][0] = (f32x4){0.f, 0.f, 0.f, 0.f}; cs[bj][1] = (f32x4){0.f, 0.f, 0.f, 0.f}; }
            bf16_t* dst = (kind == 0) ? (QQ + 1024 + c0 + cw) : (AK + c0 + cw); const int ld = (kind == 0) ? 2048 : 1024;
#pragma unroll
            for (int ai = 0; ai < 2; ++ai)
#pragma unroll
                for (int m = 0; m < 4; ++m) { const int row = row0 + ai * 128 + m * 16;
#pragma unroll
                    for (int bj = 0; bj < 2; ++bj) { const f32x4 p4 = *(const PG8_LAS f32x4*)&P[((ai * 128 + wr * 64 + m * 16 + fr) * 2 + bj) * 4];
                        const float rstd = __builtin_amdgcn_rsqf(((p4[0] + p4[1]) + (p4[2] + p4[3])) * (1.f / 128.f) + NORM_EPS);
                        const f32x4 y0 = acc[ai][bj][m][0] * rstd * g0, y1 = acc[ai][bj][m][1] * rstd * g1;
                        cs[bj][0] += y0; cs[bj][1] += y1;
                        *(u32x4*)(dst + (size_t)row * ld + bj * 128) = pack8bf(y0, y1); } }
            if (kind == 1) {
#pragma unroll
                for (int bj = 0; bj < 2; ++bj)
#pragma unroll
                    for (int n = 0; n < 2; ++n)
#pragma unroll
                        for (int j = 0; j < 4; ++j) { const float v = row16_sum(cs[bj][n][j]);
                            if (fr == 0) CS[wr * 256 + bj * 128 + cw + 4 * n + j] = v; }
                PG8_EPI_BAR();
                const int t = threadIdx.x;
                if (t < 256) { const float km = (CS[t] + CS[256 + t]) * (1.f / 256.f);
                    const int bb = u.pm >> 4, nb = u.pm & 15, head = (c0 + t) >> 7, d = t & 127;
                    const size_t o = ((size_t)((bb * NH + head) * NBLK + nb)) * HD + d;
                    KMEAN[o] = km; KMEANB[o] = (bf16_t)(cvt_pk_bf16(km, 0.f) & 0xffffu); }
            }
            return;
        }
        if (kind == 4) {
#pragma unroll
            for (int bj = 0; bj < 2; ++bj) { const int col = c0 + bj * 128 + cw;
                const f32x4 l0 = *(const f32x4*)(lb + col), l1 = *(const f32x4*)(lb + col + 4);
#pragma unroll
                for (int ai = 0; ai < 2; ++ai)
#pragma unroll
                    for (int m = 0; m < 4; ++m) { const int row = row0 + ai * 128 + m * 16;
                        f32x4 k0, k1; f16x8 lf;
#pragma unroll
                        for (int j = 0; j < 4; ++j) { const float ka = (1.f - l0[j]) * fsigmoid(-acc[ai][bj][m][0][j]), kb = (1.f - l1[j]) * fsigmoid(-acc[ai][bj][m][1][j]);
                            k0[j] = ka; k1[j] = kb; lf[j] = (_Float16)__builtin_amdgcn_logf(1.f - ka); lf[4 + j] = (_Float16)__builtin_amdgcn_logf(1.f - kb); }
                        *(u32x4*)(AK + (size_t)row * 1024 + col) = pack8bf(k0, k1);
                        *(f16x8*)(HLF + (size_t)row * 1024 + col) = lf; } }
            return;
        }
        if (kind == 7) {
            bf16_t* RT = GATES + (c0 >> 1) + cw; bf16_t* G1 = RT + (size_t)MTOK * 1024;
#pragma unroll
            for (int ai = 0; ai < 2; ++ai)
#pragma unroll
                for (int m = 0; m < 4; ++m) { const int row = row0 + ai * 128 + m * 16; f32x4 r0, r1, s0, s1;
#pragma unroll
                    for (int j = 0; j < 4; ++j) { const float e0a = __builtin_amdgcn_exp2f(-acc[ai][0][m][0][j] * 1.4426950408889634f), e1a = __builtin_amdgcn_exp2f(-acc[ai][1][m][0][j] * 1.4426950408889634f);
                        const float e0b = __builtin_amdgcn_exp2f(-acc[ai][0][m][1][j] * 1.4426950408889634f), e1b = __builtin_amdgcn_exp2f(-acc[ai][1][m][1][j] * 1.4426950408889634f);
                        r0[j] = (1.f + e1a) * __builtin_amdgcn_rcpf(1.f + e0a); r1[j] = (1.f + e1b) * __builtin_amdgcn_rcpf(1.f + e0b);
                        s0[j] = __builtin_amdgcn_rcpf(1.f + e1a); s1[j] = __builtin_amdgcn_rcpf(1.f + e1b); }
                    *(u32x4*)(RT + (size_t)row * 1024) = pack8bf(r0, r1); *(u32x4*)(G1 + (size_t)row * 1024) = pack8bf(s0, s1); }
            return;
        }
        bf16_t* dst; int ld;
        if (kind == 2) { dst = AV; ld = 1024; } else if (kind == 3) { dst = QQ; ld = 2048; } else if (kind == 5) { dst = AV; ld = 1024; } else { dst = HSG; ld = 1024; }
        dst += c0 + cw;
#pragma unroll
        for (int ai = 0; ai < 2; ++ai)
#pragma unroll
            for (int m = 0; m < 4; ++m) { const int row = row0 + ai * 128 + m * 16;
#pragma unroll
                for (int bj = 0; bj < 2; ++bj) { f32x4 v0 = acc[ai][bj][m][0], v1 = acc[ai][bj][m][1];
                    if (kind == 3) { v0 = v0 * ATT_SCALE; v1 = v1 * ATT_SCALE; }
                    else if (kind == 6) {
#pragma unroll
                        for (int j = 0; j < 4; ++j) { v0[j] = v0[j] * fsigmoid(v0[j]); v1[j] = v1[j] * fsigmoid(v1[j]); } }
                    *(u32x4*)(dst + (size_t)row * ld + bj * 128) = pack8bf(v0, v1); } }
    }
};

struct EpiPlain {
    static constexpr bool PERM = true, AFTER_DRAIN = false, MIDK = false;
    bf16_t* O; int ldc;
    __device__ __forceinline__ void midk(f32x4 (&)[2][2][4][2], const Unit&, int, int, int, int) const {}
    __device__ __forceinline__ void operator()(const f32x4 (&acc)[2][2][4][2], const Unit& u, int wr, int wc, int fr, int fq) const {
        const int row0 = u.pm * BM + wr * 64 + fr, col0 = u.pn * BM + wc * 32 + 8 * fq;
#pragma unroll
        for (int ai = 0; ai < 2; ++ai)
#pragma unroll
            for (int m = 0; m < 4; ++m) { bf16_t* rowp = O + (size_t)(row0 + ai * 128 + m * 16) * ldc + col0;
#pragma unroll
                for (int bj = 0; bj < 2; ++bj) *(u32x4*)(rowp + bj * 128) = pack8bf(acc[ai][bj][m][0], acc[ai][bj][m][1]); }
    }
};

struct EpiMerge {
    static constexpr bool PERM = true, AFTER_DRAIN = false, MIDK = true;
    const bf16_t* G; bf16_t* O;
    __device__ __forceinline__ void midk(f32x4 (&acc)[2][2][4][2], const Unit& u, int wr, int wc, int fr, int fq) const {
        int row0 = u.pm * BM + wr * 64 + fr, col0 = u.pn * BM + wc * 32 + 8 * fq;
        asm volatile("" : "+v"(row0), "+v"(col0));
#pragma unroll
        for (int ai = 0; ai < 2; ++ai)
#pragma unroll
            for (int m = 0; m < 4; ++m) { const bf16_t* gp = G + (size_t)(row0 + ai * 128 + m * 16) * 1024 + col0;
#pragma unroll
                for (int bj = 0; bj < 2; ++bj) { const u32x4 w0 = *(const u32x4*)(gp + bj * 128); f32x4 a0, a1; unpack8bf(w0, a0, a1);
                    acc[ai][bj][m][0] *= a0; acc[ai][bj][m][1] *= a1; }
                asm volatile("" ::: "memory"); }
    }
    __device__ __forceinline__ void operator()(const f32x4 (&acc)[2][2][4][2], const Unit& u, int wr, int wc, int fr, int fq) const {
        const int row0 = u.pm * BM + wr * 64 + fr, col0 = u.pn * BM + wc * 32 + 8 * fq;
#pragma unroll
        for (int ai = 0; ai < 2; ++ai)
#pragma unroll
            for (int m = 0; m < 4; ++m) { const int row = row0 + ai * 128 + m * 16; const bf16_t* gp = G + (size_t)MTOK * 1024 + (size_t)row * 1024 + col0;
#pragma unroll
                for (int bj = 0; bj < 2; ++bj) { const u32x4 w1 = *(const u32x4*)(gp + bj * 128); f32x4 b0, b1; unpack8bf(w1, b0, b1);
                    *(u32x4*)(O + (size_t)row * 1024 + col0 + bj * 128) = pack8bf(acc[ai][bj][m][0] * b0, acc[ai][bj][m][1] * b1); }
                asm volatile("" ::: "memory"); }
    }
};

struct EpiOut {
    static constexpr bool PERM = true, AFTER_DRAIN = false, MIDK = false;
    const float* X; bf16_t* X1B; float* SSQ;
    __device__ __forceinline__ void midk(f32x4 (&)[2][2][4][2], const Unit&, int, int, int, int) const {}
    __device__ __forceinline__ void operator()(const f32x4 (&acc)[2][2][4][2], const Unit& u, int wr, int wc, int fr, int fq) const {
        const int row0 = u.pm * BM + wr * 64 + fr, col0 = u.pn * BM + wc * 32 + 8 * fq;
#pragma unroll
        for (int ai = 0; ai < 2; ++ai)
#pragma unroll
            for (int m = 0; m < 4; ++m) { const int row = row0 + ai * 128 + m * 16; const size_t off = (size_t)row * 1024 + col0; float s = 0.f;
#pragma unroll
                for (int bj = 0; bj < 2; ++bj) { const f32x4 v0 = acc[ai][bj][m][0] + *(const f32x4*)(X + off + bj * 128), v1 = acc[ai][bj][m][1] + *(const f32x4*)(X + off + bj * 128 + 4);
                    s += (v0[0] * v0[0] + v0[1] * v0[1]) + (v0[2] * v0[2] + v0[3] * v0[3]) + (v1[0] * v1[0] + v1[1] * v1[1]) + (v1[2] * v1[2] + v1[3] * v1[3]);
                    *(u32x4*)(X1B + off + bj * 128) = pack8bf(v0, v1); }
                s = rows4_sum(s);
                if (fq == 0) SSQ[(size_t)row * 16 + u.pn * 4 + wc] = s;
                asm volatile("" ::: "memory"); }
    }
};

struct EpiFfnIn {
    static constexpr bool PERM = true, AFTER_DRAIN = false, MIDK = false;
    const float* SSQ; bf16_t* ACT;
    __device__ __forceinline__ void midk(f32x4 (&)[2][2][4][2], const Unit&, int, int, int, int) const {}
    __device__ __forceinline__ void operator()(const f32x4 (&acc)[2][2][4][2], const Unit& u, int wr, int wc, int fr, int fq) const {
        const int row0 = u.pm * BM + wr * 64 + fr, col0 = u.pn * 128 + wc * 32 + 8 * fq;
#pragma unroll
        for (int ai = 0; ai < 2; ++ai)
#pragma unroll
            for (int m = 0; m < 4; ++m) { const int row = row0 + ai * 128 + m * 16; const f32x4* sp = (const f32x4*)(SSQ + (size_t)row * 16);
                const f32x4 s0 = sp[0], s1 = sp[1], s2 = sp[2], s3 = sp[3];
                const float tot = ((s0[0] + s0[1]) + (s0[2] + s0[3])) + ((s1[0] + s1[1]) + (s1[2] + s1[3])) + ((s2[0] + s2[1]) + (s2[2] + s2[3])) + ((s3[0] + s3[1]) + (s3[2] + s3[3]));
                const float rstd = __builtin_amdgcn_rsqf(tot * (1.f / 1024.f) + NORM_EPS);
                f32x4 o0, o1;
#pragma unroll
                for (int j = 0; j < 4; ++j) { const float ga = acc[ai][0][m][0][j] * rstd, gb = acc[ai][0][m][1][j] * rstd;
                    o0[j] = ga * fsigmoid(ga) * (acc[ai][1][m][0][j] * rstd); o1[j] = gb * fsigmoid(gb) * (acc[ai][1][m][1][j] * rstd); }
                *(u32x4*)(ACT + (size_t)row * DFF + col0) = pack8bf(o0, o1);
                asm volatile("" ::: "memory"); }
    }
};

struct EpiDown {
    static constexpr bool PERM = true, AFTER_DRAIN = false, MIDK = false;
    const bf16_t* X1B; float* OUT;
    __device__ __forceinline__ void midk(f32x4 (&)[2][2][4][2], const Unit&, int, int, int, int) const {}
    __device__ __forceinline__ void operator()(const f32x4 (&acc)[2][2][4][2], const Unit& u, int wr, int wc, int fr, int fq) const {
        const int row0 = u.pm * BM + wr * 64 + fr, col0 = u.pn * BM + wc * 32 + 8 * fq;
#pragma unroll
        for (int ai = 0; ai < 2; ++ai)
#pragma unroll
            for (int m = 0; m < 4; ++m) { const size_t off = (size_t)(row0 + ai * 128 + m * 16) * 1024 + col0;
#pragma unroll
                for (int bj = 0; bj < 2; ++bj) { f32x4 r0, r1; unpack8bf(*(const u32x4*)(X1B + off + bj * 128), r0, r1);
                    *(f32x4*)(OUT + off + bj * 128) = acc[ai][bj][m][0] + r0; *(f32x4*)(OUT + off + bj * 128 + 4) = acc[ai][bj][m][1] + r1; }
                asm volatile("" ::: "memory"); }
    }
};


template <class Epi, class Sched, bool ALIGN_EPI = false, bool SP2 = false>
__device__ __forceinline__ void gemm_phase(PG8_LAS unsigned char* lds, const Gemm g, const Sched& S, const Epi& E) {
    int tid = threadIdx.x; asm volatile("" : "+v"(tid));
    const int wid = __builtin_amdgcn_readfirstlane(tid >> 6), lane = tid & 63, wr = wid >> 2, wc = wid & 3, fr = lane & 15, fq = lane >> 4;
    const int K = g.K, nt = K / BK;
    unsigned voffA[2], voffB[2];
#pragma unroll
    for (int i = 0; i < 2; ++i) { int R, C; stage_rc(tid * 16 + i * 8192, R, C); const int Rb = Epi::PERM ? ((R & ~31) + perm32(R & 31)) : R;
        voffA[i] = (unsigned)(R * K + C) * 2u; voffB[i] = (unsigned)(Rb * K + C) * 2u; }
    const size_t kstep = (size_t)(BK * 2);
    const size_t hstep = (size_t)HALF * K * 2;
    const size_t tstep = 2 * hstep;
    const unsigned ldsw = (unsigned)wid * 1024u;
    const int aoff = lds_byte(wr * 64 + fr, fq * 8), boff = lds_byte(wc * 32 + fr, fq * 8);
#define PG8_SA(b, h) (((b) * 2 + (h)) * HTB)
#define PG8_SB(b, h) ((4 + (b) * 2 + (h)) * HTB)
#define PG8_STAGE(bufoff, gbase, voff) do { _Pragma("unroll") for (int _i = 0; _i < 2; ++_i) \
        __builtin_amdgcn_global_load_lds((const unsigned*)((const char*)(gbase) + (voff)[_i]), (PG8_LAS unsigned*)(lds + (bufoff) + ldsw + _i * 8192), 16, 0, 0); } while (0)
#define PG8_LDA(dst, b, h) do { _Pragma("unroll") for (int m = 0; m < 4; ++m) _Pragma("unroll") for (int k = 0; k < 2; ++k) dst[m][k] = *(const PG8_LAS bf16x8*)(lds + PG8_SA(b, h) + aoff + m * 2048 + k * 1024); } while (0)
#define PG8_LDB(dst, b, h) do { _Pragma("unroll") for (int n = 0; n < 2; ++n) _Pragma("unroll") for (int k = 0; k < 2; ++k) dst[n][k] = *(const PG8_LAS bf16x8*)(lds + PG8_SB(b, h) + boff + n * 2048 + k * 1024); } while (0)
#define PG8_MMA(ai, bj, At, Bt) do { __builtin_amdgcn_s_setprio(1); _Pragma("unroll") for (int m = 0; m < 4; ++m) _Pragma("unroll") for (int n = 0; n < 2; ++n) _Pragma("unroll") for (int k = 0; k < 2; ++k) \
        acc[ai][bj][m][n] = __builtin_amdgcn_mfma_f32_16x16x32_bf16(Bt[n][k], At[m][k], acc[ai][bj][m][n], 0, 0, 0); __builtin_amdgcn_s_setprio(0); } while (0)
#define PG8_WAIT_V(n) asm volatile("s_waitcnt vmcnt(" #n ")" ::: "memory")
#define PG8_WAIT_L(n) asm volatile("s_waitcnt lgkmcnt(" #n ")" ::: "memory")
#define PG8_BAR __builtin_amdgcn_s_barrier()
#define PG8_SCHED __builtin_amdgcn_sched_barrier(0)
    Unit cur, nxt; int ui = 0;
    if (!S.next(0, cur)) return;
    f32x4 acc[2][2][4][2];
#pragma unroll
    for (int a = 0; a < 2; ++a)
#pragma unroll
        for (int b = 0; b < 2; ++b)
#pragma unroll
            for (int m = 0; m < 4; ++m)
#pragma unroll
                for (int n = 0; n < 2; ++n) acc[a][b][m][n] = (f32x4){0.f, 0.f, 0.f, 0.f};
    bf16x8 At[4][2], B0[2][2], B1[2][2];
    const char* cA = (const char*)g.A + (size_t)cur.pm * tstep; const char* cB = (const char*)g.Bt + (size_t)cur.pn * tstep;
    S.a_ready(cur);
    if constexpr (SP2) {
        PG8_STAGE(PG8_SB(0, 0), cB, voffB); PG8_STAGE(PG8_SB(0, 1), cB + hstep, voffB); PG8_STAGE(PG8_SA(0, 0), cA, voffA); PG8_STAGE(PG8_SA(0, 1), cA + hstep, voffA);
        if (wr == 1) PG8_BAR;
        PG8_WAIT_V(2); PG8_BAR;
        PG8_STAGE(PG8_SB(1, 0), cB + kstep, voffB); PG8_STAGE(PG8_SA(1, 0), cA + kstep, voffA); PG8_STAGE(PG8_SB(1, 1), cB + hstep + kstep, voffB);
        PG8_WAIT_V(6); PG8_BAR;
    } else {
        PG8_STAGE(PG8_SB(0, 0), cB, voffB); PG8_STAGE(PG8_SA(0, 0), cA, voffA); PG8_STAGE(PG8_SB(0, 1), cB + hstep, voffB); PG8_STAGE(PG8_SA(0, 1), cA + hstep, voffA);
        if (wr == 1) PG8_BAR;
        PG8_WAIT_V(4); PG8_BAR;
        PG8_STAGE(PG8_SB(1, 0), cB + kstep, voffB); PG8_STAGE(PG8_SA(1, 0), cA + kstep, voffA); PG8_STAGE(PG8_SB(1, 1), cB + hstep + kstep, voffB);
        PG8_WAIT_V(6); PG8_BAR;
    }
    for (;;) {
        const bool has_next = S.next(ui + 1, nxt);
        const char* nA = has_next ? (const char*)g.A + (size_t)nxt.pm * tstep : cA; const char* nB = has_next ? (const char*)g.Bt + (size_t)nxt.pn * tstep : cB;
        for (int t = 0; t < nt; t += 2) {
            if constexpr (Epi::MIDK) { if (t == (nt >> 1)) E.midk(acc, cur, wr, wc, fr, fq); }
            const bool last = (t == nt - 2);
            const char* a1 = cA + (size_t)(t + 1) * kstep;
            const char* a2 = last ? nA : cA + (size_t)(t + 2) * kstep; const char* b2 = last ? nB : cB + (size_t)(t + 2) * kstep;
            const char* a3 = a2 + kstep; const char* b3 = b2 + kstep;
            if (last && has_next) S.a_ready(nxt);
            if constexpr (SP2) {
            PG8_LDB(B0, 0, 0); PG8_LDB(B1, 0, 1); PG8_SCHED; PG8_LDA(At, 0, 0); PG8_STAGE(PG8_SA(1, 1), a1 + hstep, voffA);
            PG8_WAIT_V(8); PG8_WAIT_L(0); PG8_BAR; PG8_MMA(0, 0, At, B0); PG8_MMA(0, 1, At, B1); PG8_BAR; PG8_SCHED;
            PG8_LDA(At, 0, 1); PG8_STAGE(PG8_SB(0, 0), b2, voffB); PG8_STAGE(PG8_SB(0, 1), b2 + hstep, voffB); PG8_STAGE(PG8_SA(0, 0), a2, voffA);
            PG8_WAIT_V(8); PG8_WAIT_L(0); PG8_BAR; PG8_MMA(1, 0, At, B0); PG8_MMA(1, 1, At, B1); PG8_BAR; PG8_SCHED;
            PG8_LDB(B0, 1, 0); PG8_LDB(B1, 1, 1); PG8_SCHED; PG8_LDA(At, 1, 0); PG8_STAGE(PG8_SA(0, 1), a2 + hstep, voffA);
            PG8_WAIT_V(8); PG8_WAIT_L(0); PG8_BAR; PG8_MMA(0, 0, At, B0); PG8_MMA(0, 1, At, B1); PG8_BAR; PG8_SCHED;
            PG8_LDA(At, 1, 1); PG8_STAGE(PG8_SB(1, 0), b3, voffB); PG8_STAGE(PG8_SB(1, 1), b3 + hstep, voffB); PG8_STAGE(PG8_SA(1, 0), a3, voffA);
            PG8_WAIT_V(8); PG8_WAIT_L(0); PG8_BAR; PG8_MMA(1, 0, At, B0); PG8_MMA(1, 1, At, B1); PG8_BAR; PG8_SCHED;
            } else {
            PG8_LDB(B0, 0, 0); PG8_SCHED; PG8_LDA(At, 0, 0); PG8_STAGE(PG8_SA(1, 1), a1 + hstep, voffA);
            PG8_WAIT_L(8); PG8_BAR; PG8_WAIT_L(0); PG8_MMA(0, 0, At, B0); PG8_BAR; PG8_SCHED;
            PG8_LDB(B1, 0, 1); PG8_STAGE(PG8_SB(0, 0), b2, voffB);
            PG8_BAR; PG8_WAIT_L(0); PG8_MMA(0, 1, At, B1); PG8_BAR;
            PG8_LDA(At, 0, 1); PG8_STAGE(PG8_SA(0, 0), a2, voffA);
            PG8_BAR; PG8_WAIT_L(0); PG8_MMA(1, 0, At, B0); PG8_BAR; PG8_SCHED;
            PG8_STAGE(PG8_SB(0, 1), b2 + hstep, voffB);
            PG8_WAIT_V(6); PG8_BAR; PG8_MMA(1, 1, At, B1); PG8_BAR;
            PG8_LDB(B0, 1, 0); PG8_SCHED; PG8_LDA(At, 1, 0); PG8_STAGE(PG8_SA(0, 1), a2 + hstep, voffA);
            PG8_WAIT_L(8); PG8_BAR; PG8_WAIT_L(0); PG8_MMA(0, 0, At, B0); PG8_BAR; PG8_SCHED;
            PG8_LDB(B1, 1, 1); PG8_STAGE(PG8_SB(1, 0), b3, voffB);
            PG8_BAR; PG8_WAIT_L(0); PG8_MMA(0, 1, At, B1); PG8_BAR;
            PG8_LDA(At, 1, 1); PG8_STAGE(PG8_SA(1, 0), a3, voffA);
            PG8_BAR; PG8_WAIT_L(0); PG8_MMA(1, 0, At, B0); PG8_BAR; PG8_SCHED;
            PG8_STAGE(PG8_SB(1, 1), b3 + hstep, voffB);
            PG8_WAIT_V(6); PG8_BAR; PG8_MMA(1, 1, At, B1); PG8_BAR;
            }
        }
        if constexpr (ALIGN_EPI) { if (wr == 0) PG8_BAR; }
        if constexpr (!Epi::AFTER_DRAIN) { E(acc, cur, wr, wc, fr, fq); S.done(cur); }
        if (!has_next) break;
#pragma unroll
        for (int a = 0; a < 2; ++a)
#pragma unroll
            for (int b = 0; b < 2; ++b)
#pragma unroll
                for (int m = 0; m < 4; ++m)
#pragma unroll
                    for (int n = 0; n < 2; ++n) acc[a][b][m][n] = (f32x4){0.f, 0.f, 0.f, 0.f};
        cur = nxt; cA = nA; cB = nB; ++ui;
        if constexpr (ALIGN_EPI) { if (wr == 1) PG8_BAR; }
    }
    PG8_WAIT_V(0);
    if constexpr (!ALIGN_EPI) { if (wr == 0) PG8_BAR; }
    PG8_BAR;
    if constexpr (Epi::AFTER_DRAIN) { E.fused(acc, cur, wr, wc, fr, fq, lds, wid, lane); S.done(cur); }
#undef PG8_SA
#undef PG8_SB
#undef PG8_STAGE
#undef PG8_LDA
#undef PG8_LDB
#undef PG8_MMA
#undef PG8_WAIT_V
#undef PG8_WAIT_L
#undef PG8_BAR
#undef PG8_SCHED
}
}

constexpr size_t MiB = 1u << 20;
constexpr size_t WS_CTL = 0, CTL_ZERO_BYTES = 64 * 1024;
constexpr size_t WS_WT_IN = 1 * MiB;
constexpr size_t WS_LST = 1 * MiB, WS_DST = 17 * MiB;
constexpr size_t WS_WT_CAT = 19 * MiB;
constexpr size_t WS_WT_OUT = 23 * MiB;
constexpr size_t WS_H = 25 * MiB;
constexpr size_t WS_WT_FIN = 25 * MiB;
constexpr size_t WS_WT_DOWN = 36 * MiB;
constexpr size_t WS_QQ = 57 * MiB;
constexpr size_t WS_AK = 121 * MiB, WS_AV = 153 * MiB;
constexpr size_t WS_HLF = 185 * MiB, WS_HSG = 217 * MiB;
constexpr size_t WS_KMEAN = 249 * MiB, WS_KMEANB = 249 * MiB + 512 * 1024, WS_LB = 250 * MiB, WS_SSQ = 251 * MiB;
constexpr size_t WS_MERGED = 121 * MiB;
constexpr size_t WS_X1 = 153 * MiB;
constexpr size_t WS_A2 = 217 * MiB;
constexpr size_t WS_ACT = 57 * MiB;
constexpr size_t WS_END = 256 * MiB;
static_assert(WS_ACT + (size_t)MTOK * DFF * 2 <= WS_X1 && WS_SSQ + (size_t)MTOK * 16 * 4 <= WS_END, "d_ws map");
constexpr int CW_TMO = 0, CW_BAR = 4096;

constexpr int RING_OFF = 0, RING_BYTES = 131072;
constexpr int EPI_SCR_OFF = RING_BYTES;
constexpr int LDSCTL_OFF = RING_BYTES + 12288, MISC_OFF = LDSCTL_OFF + 320;
constexpr int LDS_BYTES = 147456;
static_assert(MISC_OFF + 128 <= LDS_BYTES, "LDS map");
constexpr int NWAVES = 8;

__device__ __forceinline__ float bf2f(unsigned short b) { return __uint_as_float((unsigned)b << 16); }


#define GAS __attribute__((address_space(1)))
#define LAS __attribute__((address_space(3)))
typedef unsigned short bf16;
typedef unsigned v4u __attribute__((ext_vector_type(4)));
typedef float f32x4 __attribute__((ext_vector_type(4)));
typedef short bf16x8 __attribute__((ext_vector_type(8)));
typedef GAS unsigned gu32;
typedef GAS unsigned long long gu64;
#define RLX_AGENT __ATOMIC_RELAXED, __HIP_MEMORY_SCOPE_AGENT
#define LDS_WAIT() asm volatile("s_waitcnt lgkmcnt(0)" ::: "memory")
#define VM_WAIT() asm volatile("s_waitcnt vmcnt(0)" ::: "memory")
__device__ __forceinline__ unsigned long long rt() { return __builtin_amdgcn_s_memrealtime(); }
__device__ __forceinline__ unsigned f2bf(float f) { unsigned u = __builtin_bit_cast(unsigned, f); return (u + 0x7fffu + ((u >> 16) & 1u)) >> 16; }
__device__ __forceinline__ unsigned pk2(float lo, float hi) { return f2bf(lo) | (f2bf(hi) << 16); }

#define XB_TMO      128
#define XB_XCNT(j)  (256  + 64 * (j))
#define XB_XSUB(j)  (1280 + 64 * (j))
#define XB_XGEN(j)  (2304 + 64 * (j))
#define XB_TOP      3328
#define XB_TOPGEN   3392
#define XCD_BAR_WORDS 3456
#define XB_SPIN_CAP (1u << 18)

__device__ __forceinline__ unsigned xb_ld(unsigned* p)              { return __hip_atomic_load(p, __ATOMIC_RELAXED, __HIP_MEMORY_SCOPE_AGENT); }
__device__ __forceinline__ unsigned xb_add(unsigned* p, unsigned v) { return __hip_atomic_fetch_add(p, v, __ATOMIC_RELAXED, __HIP_MEMORY_SCOPE_AGENT); }
__device__ __forceinline__ unsigned xb_xcc_id() { return (unsigned)__builtin_amdgcn_s_getreg((3 << 11) | 20) & 0xFu; }
#define XB_SPIN(cond, bar) do { unsigned _sp = 0; while (cond) { __builtin_amdgcn_s_sleep(1); \
    if ((++_sp & 255u) == 0u) { if (xb_ld(&(bar)[XB_TMO])) break; if (_sp > XB_SPIN_CAP) { atomicAdd(&(bar)[XB_TMO], 1u); break; } } } } while (0)

struct XcdBarrier {
    unsigned* bar; unsigned x;
    volatile LAS unsigned* st;
};

__device__ __forceinline__ XcdBarrier xcd_barrier_post(unsigned* bar, volatile LAS unsigned* st) {
    XcdBarrier b; b.bar = bar; b.x = xb_xcc_id(); b.st = st;
    if (threadIdx.x == 0) (void)xb_add(&bar[XB_XCNT(b.x)], 1u);
    return b;
}
__device__ __forceinline__ void xcd_barrier_complete(unsigned* bar, unsigned x, unsigned& nloc, unsigned& nx) {
    const unsigned G = gridDim.x * gridDim.y * gridDim.z;
    unsigned sum, cnt, mine, sp = 0u;
    for (;;) {
        sum = 0u; cnt = 0u; mine = 0u;
#pragma unroll
        for (unsigned j = 0; j < 16; ++j) { const unsigned c = xb_ld(&bar[XB_XCNT(j)]); sum += c; cnt += (c > 0u) ? 1u : 0u; mine = (j == x) ? c : mine; }
        if (sum == G) break;
        __builtin_amdgcn_s_sleep(1);
        if ((++sp & 255u) == 0u) { if (xb_ld(&bar[XB_TMO])) break; if (sp > XB_SPIN_CAP) { atomicAdd(&bar[XB_TMO], 1u); break; } }
    }
    nloc = mine > 0u ? mine : 1u; nx = cnt > 0u ? cnt : 1u;
}

__device__ __forceinline__ void xcd_barrier(const XcdBarrier& b) {
    asm volatile("s_waitcnt vmcnt(0)" ::: "memory");
    __syncthreads();
    if (threadIdx.x == 0) {
        unsigned* bar = b.bar;
        __builtin_amdgcn_s_waitcnt(0);
        unsigned nloc = b.st[0], nx = b.st[1];
        if (nloc == 0u) { xcd_barrier_complete(bar, b.x, nloc, nx); b.st[0] = nloc; b.st[1] = nx; }
        const unsigned old = xb_add(&bar[XB_XSUB(b.x)], 1u);
        const unsigned gen = old / nloc;
        if (old + 1u == (gen + 1u) * nloc) {
            __builtin_amdgcn_fence(__ATOMIC_RELEASE, "agent");
            asm volatile("s_waitcnt vmcnt(0)" ::: "memory");
            const unsigned og = xb_add(&bar[XB_TOP], 1u);
            const unsigned tg = og / nx;
            if (og + 1u == (tg + 1u) * nx) xb_add(&bar[XB_TOPGEN], 1u);
            else XB_SPIN(xb_ld(&bar[XB_TOPGEN]) == tg, bar);
            __builtin_amdgcn_fence(__ATOMIC_ACQUIRE, "agent");
            xb_add(&bar[XB_XGEN(b.x)], 1u);
            asm volatile("s_waitcnt vmcnt(0)" ::: "memory");
        } else {
            XB_SPIN(xb_ld(&bar[XB_XGEN(b.x)]) == gen, bar);
            __builtin_amdgcn_fence(__ATOMIC_ACQUIRE, "agent");
            asm volatile("s_waitcnt vmcnt(0)" ::: "memory");
        }
    }
    __syncthreads();
}

namespace moba {
typedef unsigned short bf16;
typedef short bf16x8 __attribute__((ext_vector_type(8)));
typedef short s16x4 __attribute__((ext_vector_type(4)));
typedef float f32x16 __attribute__((ext_vector_type(16)));
typedef float f32x4 __attribute__((ext_vector_type(4)));
typedef unsigned u32x4 __attribute__((ext_vector_type(4)));
constexpr float SCALE = 0.08838834764831845f;
constexpr float THR = 8.f;
constexpr int NW = 8, QBLK = 32, KVBLK = 64, QB = NW * QBLK, D = 128;
constexpr int QP = 2048, KP = 1024;
constexpr int SHM_V = KVBLK * D * 2, SHM_K = KVBLK * D * 2;
constexpr int OFF_WS = 2 * SHM_V + 2 * SHM_K, OFF_BIAS = OFF_WS + NW * 64 * 4, LDS_BYTES = OFF_BIAS + 512;
#define KSWZ(row, colB) ((row) * 256 + ((colB) ^ (((row) & 7) << 4)))
#define SBAR() __builtin_amdgcn_sched_barrier(0)
__device__ __forceinline__ int v_st(int k, int c) { const int kk = (k & ~0xC) | ((k & 4) << 1) | ((k & 8) >> 1); return ((kk >> 3) * 4 + (c >> 5)) * 512 + ((kk & 7) * 32 + (c & 31)) * 2; }
__device__ __forceinline__ int v_rd_base(int lane) { return ((lane & 3) << 3) | (((lane >> 2) & 3) << 6) | (((lane >> 4) & 1) << 5) | (((lane >> 5) & 1) << 8); }
constexpr int v_rd_off(int d0, int ks, int half) { return d0 * 512 + ks * 4096 + half * 2048; }
__device__ __forceinline__ int crow(int r, int hi) { return (r & 3) + 8 * (r >> 2) + 4 * hi; }
__device__ __forceinline__ unsigned cvtpk(float lo, float hi) { unsigned r; asm volatile("v_cvt_pk_bf16_f32 %0, %1, %2" : "=v"(r) : "v"(lo), "v"(hi)); return r; }
template <int CTRL> __device__ __forceinline__ float dpp_mov(float v) { return __int_as_float(__builtin_amdgcn_update_dpp(0, __float_as_int(v), CTRL, 0xf, 0xf, true)); }
__device__ __forceinline__ bf16x8 load8(const bf16* p) { return *reinterpret_cast<const bf16x8*>(p); }

__device__ __forceinline__ void partialSM(f32x16& p0, f32x16& p1, float& m_reg, float& mn, float& alpha) {
    float pmax = p0[0]; for (int r = 1; r < 16; ++r) pmax = fmaxf(pmax, p0[r]); for (int r = 0; r < 16; ++r) pmax = fmaxf(pmax, p1[r]);
    { auto rr = __builtin_amdgcn_permlane32_swap(__float_as_uint(pmax), __float_as_uint(pmax), false, false);
      pmax = fmaxf(__uint_as_float(rr[0]), __uint_as_float(rr[1])); }
    constexpr float C2 = 1.4426950408889634f * SCALE;
    if (__builtin_expect(__all((pmax - m_reg) * SCALE <= THR), 1)) { mn = m_reg; alpha = 1.f; }
    else { mn = fmaxf(m_reg, pmax); alpha = __builtin_amdgcn_exp2f((m_reg - mn) * C2); m_reg = mn; }
    const float mnL = -mn * C2;
    for (int r = 0; r < 16; ++r) p0[r] = fmaf(p0[r], C2, mnL); for (int r = 0; r < 16; ++r) p1[r] = fmaf(p1[r], C2, mnL);
    for (int r = 0; r < 16; ++r) p0[r] = __builtin_amdgcn_exp2f(p0[r]);
}
__device__ __forceinline__ void finishSM(f32x16& p0, f32x16& p1, float alpha, float& l_reg, bf16x8& pa0, bf16x8& pa1, bf16x8& pa2, bf16x8& pa3) {
    for (int r = 0; r < 16; ++r) p1[r] = __builtin_amdgcn_exp2f(p1[r]);
    float ps = 0; for (int r = 0; r < 16; ++r) ps += p0[r]; for (int r = 0; r < 16; ++r) ps += p1[r];
    { auto rr = __builtin_amdgcn_permlane32_swap(__float_as_uint(ps), __float_as_uint(ps), false, false);
      ps = __uint_as_float(rr[0]) + __uint_as_float(rr[1]); }
    l_reg = l_reg * alpha + ps;
#define PK4(P, B_, OUT) do { unsigned a0 = cvtpk(P[B_+0], P[B_+1]), a1 = cvtpk(P[B_+2], P[B_+3]);                          \
        unsigned b0 = cvtpk(P[B_+4], P[B_+5]), b1 = cvtpk(P[B_+6], P[B_+7]);                                             \
        auto r0 = __builtin_amdgcn_permlane32_swap(a0, b0, false, false); auto r1 = __builtin_amdgcn_permlane32_swap(a1, b1, false, false); \
        u32x4 w = {r0[0], r1[0], r0[1], r1[1]}; OUT = *reinterpret_cast<bf16x8*>(&w); } while (0)
    PK4(p0, 0, pa0); PK4(p0, 8, pa1); PK4(p1, 0, pa2); PK4(p1, 8, pa3);
#undef PK4
}
__device__ __forceinline__ void expA(f32x16& p0, f32x16& p1, float negMC) {
    constexpr float C2 = 1.4426950408889634f * SCALE;
    for (int r = 0; r < 16; ++r) p0[r] = fmaf(p0[r], C2, negMC); for (int r = 0; r < 16; ++r) p1[r] = fmaf(p1[r], C2, negMC);
    for (int r = 0; r < 16; ++r) p0[r] = __builtin_amdgcn_exp2f(p0[r]);
}
__device__ __forceinline__ void finishFS(f32x16& p0, f32x16& p1, bool keep, float& l_reg, bf16x8& pa0, bf16x8& pa1, bf16x8& pa2, bf16x8& pa3) {
    for (int r = 0; r < 16; ++r) p1[r] = __builtin_amdgcn_exp2f(p1[r]);
    float ps = 0; for (int r = 0; r < 16; ++r) ps += p0[r]; for (int r = 0; r < 16; ++r) ps += p1[r];
    { auto rr = __builtin_amdgcn_permlane32_swap(__float_as_uint(ps), __float_as_uint(ps), false, false);
      ps = __uint_as_float(rr[0]) + __uint_as_float(rr[1]); }
    l_reg += keep ? ps : 0.f;
    const unsigned km = keep ? 0xffffffffu : 0u;
#define PK4(P, B_, OUT) do { unsigned a0 = cvtpk(P[B_+0], P[B_+1]) & km, a1 = cvtpk(P[B_+2], P[B_+3]) & km;                 \
        unsigned b0 = cvtpk(P[B_+4], P[B_+5]) & km, b1 = cvtpk(P[B_+6], P[B_+7]) & km;                                     \
        auto r0 = __builtin_amdgcn_permlane32_swap(a0, b0, false, false); auto r1 = __builtin_amdgcn_permlane32_swap(a1, b1, false, false); \
        u32x4 w = {r0[0], r1[0], r0[1], r1[1]}; OUT = *reinterpret_cast<bf16x8*>(&w); } while (0)
    PK4(p0, 0, pa0); PK4(p0, 8, pa1); PK4(p1, 0, pa2); PK4(p1, 8, pa3);
#undef PK4
}
template <int KB>
__device__ __forceinline__ void qkt(f32x16& p0, f32x16& p1, const char* K_lds, int r32, int hi, const bf16x8* qr) {
    p0 = f32x16{}; p1 = f32x16{};
    const char* kb[4];
#pragma unroll
    for (int dd = 0; dd < 4; ++dd) kb[dd] = K_lds + KB * SHM_K + KSWZ(r32, (dd * 16 + hi * 8) * 2);
#pragma unroll
    for (int d0 = 0; d0 < 8; ++d0) { const char* a = kb[d0 & 3] + (d0 >> 2) * 128;
        bf16x8 b0 = *reinterpret_cast<const bf16x8*>(a);
        bf16x8 b1 = *reinterpret_cast<const bf16x8*>(a + 32 * 256);
        p0 = __builtin_amdgcn_mfma_f32_32x32x16_bf16(b0, qr[d0], p0, 0, 0, 0);
        p1 = __builtin_amdgcn_mfma_f32_32x32x16_bf16(b1, qr[d0], p1, 0, 0, 0); }
}
template <int VB>
__device__ __forceinline__ void pv_tile(f32x16* o, int vb0, bf16x8 pa0, bf16x8 pa1, bf16x8 pa2, bf16x8 pa3) {
#define TRRD(dst, off) asm volatile("ds_read_b64_tr_b16 %0, %1 offset:%2" : "=&v"(dst) : "v"(vb0), "i"(off) : "memory")
#define PV_D0(d0) do { s16x4 l0, l1, l2, l3, h0, h1, h2, h3; constexpr int b_ = VB * SHM_V + v_rd_off(d0, 0, 0); \
        TRRD(l0, b_); TRRD(h0, b_ + 2048); TRRD(l1, b_ + 4096); TRRD(h1, b_ + 6144); TRRD(l2, b_ + 8192); TRRD(h2, b_ + 10240); TRRD(l3, b_ + 12288); TRRD(h3, b_ + 14336); \
        asm volatile("s_waitcnt lgkmcnt(0)" ::: "memory"); SBAR();   \
        o[d0] = __builtin_amdgcn_mfma_f32_32x32x16_bf16(pa0, (bf16x8){l0[0], l0[1], l0[2], l0[3], h0[0], h0[1], h0[2], h0[3]}, o[d0], 0, 0, 0);   \
        o[d0] = __builtin_amdgcn_mfma_f32_32x32x16_bf16(pa1, (bf16x8){l1[0], l1[1], l1[2], l1[3], h1[0], h1[1], h1[2], h1[3]}, o[d0], 0, 0, 0);   \
        o[d0] = __builtin_amdgcn_mfma_f32_32x32x16_bf16(pa2, (bf16x8){l2[0], l2[1], l2[2], l2[3], h2[0], h2[1], h2[2], h2[3]}, o[d0], 0, 0, 0);   \
        o[d0] = __builtin_amdgcn_mfma_f32_32x32x16_bf16(pa3, (bf16x8){l3[0], l3[1], l3[2], l3[3], h3[0], h3[1], h3[2], h3[3]}, o[d0], 0, 0, 0); } while (0)
    PV_D0(0); PV_D0(1); PV_D0(2); PV_D0(3);
#undef PV_D0
#undef TRRD
}
__device__ __forceinline__ void mask_all(f32x16& p0, f32x16& p1, bool keep) {
    const float NEG = -__builtin_inff();
#pragma unroll
    for (int r = 0; r < 16; ++r) { p0[r] = keep ? p0[r] : NEG; p1[r] = keep ? p1[r] : NEG; }
}
__device__ __forceinline__ void mask_bias(f32x16& p0, f32x16& p1, int dq, const float* biasL, bool causal) {
    const float NEG = -__builtin_inff();
#pragma unroll
    for (int g = 0; g < 4; ++g) {
#pragma unroll
        for (int j = 0; j < 4; ++j) { const int r = 4 * g + j;
            const int c = (r & 3) + 8 * (r >> 2); const int d0 = dq - c, d1 = d0 - 32;
            const int i0 = d0 < 0 ? 0 : (d0 > 113 ? 113 : d0), i1 = d1 < 0 ? 0 : (d1 > 113 ? 113 : d1);
            const float v0 = p0[r] + biasL[i0], v1 = p1[r] + biasL[i1];
            p0[r] = (causal && d0 < 0) ? NEG : v0; p1[r] = (causal && d1 < 0) ? NEG : v1; }
        SBAR();
    }
}

struct BlockRef { const bf16* Q; const bf16* K; const bf16* V; bf16* O; const bf16* KM; const float* BT; const float* QG; const float* KG; int P0; };
struct Seam { bf16x8 qr[8]; bf16x8 st_v0, st_v1, st_k0, st_k1; };
#define ROWK(p, k0, rr) ((p) + (size_t)((k0) + (rr)) * KP + sc)
#define VMW() asm volatile("s_waitcnt vmcnt(0)" ::: "memory")
#define VMWN(n) asm volatile("s_waitcnt vmcnt(%0)" :: "i"(n) : "memory")
#define SLOAD_H(Kp, Vp, k0) do { S.st_v0 = load8(ROWK(Vp, k0, sr)); S.st_v1 = load8(ROWK(Vp, k0, 32 + sr));              \
                         S.st_k0 = load8(ROWK(Kp, k0, sr)); S.st_k1 = load8(ROWK(Kp, k0, 32 + sr)); } while (0)
#define SWRITE_HK(bf) do { *(bf16x8*)(K_lds + (bf) * SHM_K + kws) = S.st_k0; *(bf16x8*)(K_lds + (bf) * SHM_K + kws + 32 * 256) = S.st_k1; } while (0)
#define SWRITE_HV(bf) do { *(bf16x8*)(V_lds + (bf) * SHM_V + vst0) = S.st_v0; *(bf16x8*)(V_lds + (bf) * SHM_V + vst1) = S.st_v1; } while (0)
#define SWRITE_H(bf) do { SWRITE_HV(bf); SWRITE_HK(bf); } while (0)
__device__ __forceinline__ void moba_prime(const BlockRef& cur, char* lds, Seam& S) {
    int tid = threadIdx.x; asm volatile("" : "+v"(tid));
    const int wid = __builtin_amdgcn_readfirstlane(tid >> 6), lane = tid & 63, r32 = lane & 31, hi = lane >> 5;
    const int sr = tid >> 4, sc = (tid & 15) * 8, kws = KSWZ(sr, sc * 2); char* K_lds = lds + 2 * SHM_V;
    for (int d0 = 0; d0 < 8; ++d0) S.qr[d0] = load8(cur.Q + (size_t)(wid * QBLK + r32) * QP + d0 * 16 + hi * 8);
    SLOAD_H(cur.K, cur.V, 0); VMW(); SWRITE_HK(0);
    __syncthreads();
}
__device__ __forceinline__ void moba_block(const BlockRef& cur, const BlockRef& nxt, char* lds, Seam& S) {
    int tid = threadIdx.x; asm volatile("" : "+v"(tid));
    const int wid = __builtin_amdgcn_readfirstlane(tid >> 6), lane = tid & 63, r32 = lane & 31, hi = lane >> 5;
    const int cblk = cur.P0 >> 8;
    const int NT = 4 * (cblk + 1);
    const int qlo = cur.P0 + wid * QBLK, qm = qlo + r32 - 4 * hi;
    char* V_lds = lds; char* K_lds = lds + 2 * SHM_V;
    float* ws = (float*)(lds + OFF_WS) + wid * 64; float* li_l = ws; float* biasL = (float*)(lds + OFF_BIAS);
    float l_reg = 0; f32x16 o[4];
    const int sr = tid >> 4, sc = (tid & 15) * 8, vst0 = v_st(sr, sc), vst1 = v_st(32 + sr, sc), kws = KSWZ(sr, sc * 2);
    const int vb0 = (int)(uintptr_t)V_lds + v_rd_base(lane);
    const bf16* Kh = cur.K; const bf16* Vh = cur.V;
    f32x16 pA0, pA1, pB0, pB1; bf16x8 pa0, pa1, pa2, pa3;
    if (tid < 128) { const int d = tid < 113 ? tid : 113; int bk = d;
        if (d >= 16) { bk = 15; bk += d >= 16; bk += d >= 19; bk += d >= 21; bk += d >= 24; bk += d >= 27; bk += d >= 31; bk += d >= 35; bk += d >= 40;
            bk += d >= 46; bk += d >= 52; bk += d >= 59; bk += d >= 67; bk += d >= 77; bk += d >= 87; bk += d >= 99; bk += d >= 113; }
        biasL[tid] = (cur.BT[bk * 8] - cur.BT[31 * 8]) * (1.f / SCALE); }
    if (tid < 256) { const bf16x8 kmv = load8(cur.KM + (size_t)(tid >> 4) * 128 + (tid & 15) * 8); *(bf16x8*)(K_lds + SHM_K + KSWZ(tid >> 4, (tid & 15) * 16)) = kmv; }
    __syncthreads();
    unsigned selmask = 0u;
#ifndef ATT_NOGATE
    { qkt<1>(pA0, pA1, K_lds, r32, hi, S.qr);
      float G[16];
#pragma unroll
      for (int r = 0; r < 8; ++r) { auto rr = __builtin_amdgcn_permlane32_swap(__float_as_uint(pA0[r]), __float_as_uint(pA0[r]), false, false);
          const int n0 = (r & 3) + 8 * (r >> 2); G[n0] = __uint_as_float(rr[0]); G[n0 + 4] = __uint_as_float(rr[1]); }
#pragma unroll
      for (int s = 0; s < 3; ++s) { float bv = 0.f; int bi = -1;
#pragma unroll
          for (int n = 0; n < 16; ++n) { const bool ok = (n < cblk) && !((selmask >> n) & 1u); const bool take = ok && (bi < 0 || G[n] > bv); bv = take ? G[n] : bv; bi = take ? n : bi; }
          selmask |= (bi >= 0) ? (1u << bi) : 0u; }
    }
#endif
    __syncthreads();
    o[0] = f32x16{}; o[1] = f32x16{}; o[2] = f32x16{}; o[3] = f32x16{};
#define KBASE(t) ((t) * KVBLK)
    float negMC;
    { float mq = fmaxf(fabsf(cur.QG[lane]), fabsf(cur.QG[lane + 64])), mk = fmaxf(fabsf(cur.KG[lane]), fabsf(cur.KG[lane + 64])), mb = fmaxf(biasL[lane], biasL[lane + 64]);
#pragma unroll
      for (int s = 1; s < 64; s <<= 1) { mq = fmaxf(mq, __shfl_xor(mq, s)); mk = fmaxf(mk, __shfl_xor(mk, s)); mb = fmaxf(mb, __shfl_xor(mb, s)); }
      negMC = -(1.02f * 128.f * mq * mk + fmaxf(mb, 0.f)) * (1.4426950408889634f * SCALE); }
#define MASKT(P0_, P1_, t) do { const int kb_ = KBASE(t), nb_ = (t) >> 2; \
        if (qlo - (kb_ + KVBLK - 1) < 113) mask_bias(P0_, P1_, qm - kb_, biasL, nb_ == cblk); } while (0)
#define KEEP(t) ((((t) >> 2) >= cblk) || ((selmask >> ((t) >> 2)) & 1u))
    constexpr int NQL = 8;
#define SEAM_K0() do { VMWN(NQL); SWRITE_HK(0); SBAR(); } while (0)
    SWRITE_HV(0); SBAR();
    SLOAD_H(Kh, Vh, KBASE(1));
    SBAR(); qkt<0>(pA0, pA1, K_lds, r32, hi, S.qr);
    MASKT(pA0, pA1, 0); expA(pA0, pA1, negMC);
    VMW(); SWRITE_H(1);
    __syncthreads();
#define HALF_STEP(PX0, PX1, PY0, PY1, t, KB, VB, SB) do {                                                                     \
        SBAR(); qkt<KB>(PX0, PX1, K_lds, r32, hi, S.qr);                                                                      \
        finishFS(PY0, PY1, KEEP((t) - 1), l_reg, pa0, pa1, pa2, pa3); SBAR();                                                 \
        if ((t) + 1 < NT) { SLOAD_H(Kh, Vh, KBASE((t) + 1)); SBAR(); }                                                        \
        pv_tile<VB>(o, vb0, pa0, pa1, pa2, pa3); MASKT(PX0, PX1, (t)); expA(PX0, PX1, negMC);                                 \
        __syncthreads();                                                                                                      \
        if ((t) + 1 < NT) { VMW(); SWRITE_H(SB); }                                                                            \
        __syncthreads(); } while (0)
    for (int t = 1; t + 1 < NT; t += 2) {
        HALF_STEP(pB0, pB1, pA0, pA1, t, 1, 0, 0);
        HALF_STEP(pA0, pA1, pB0, pB1, t + 1, 0, 1, 1);
    }
    SBAR(); qkt<1>(pB0, pB1, K_lds, r32, hi, S.qr); SBAR();
    SLOAD_H(nxt.K, nxt.V, 0); SBAR();
#pragma unroll
    for (int d0 = 0; d0 < 8; ++d0) S.qr[d0] = load8(nxt.Q + (size_t)(wid * QBLK + r32) * QP + d0 * 16 + hi * 8);
    SBAR();
    finishFS(pA0, pA1, true, l_reg, pa0, pa1, pa2, pa3); SBAR();
    pv_tile<0>(o, vb0, pa0, pa1, pa2, pa3);
    MASKT(pB0, pB1, NT - 1); expA(pB0, pB1, negMC); __syncthreads();
    finishFS(pB0, pB1, true, l_reg, pa0, pa1, pa2, pa3); SBAR(); pv_tile<1>(o, vb0, pa0, pa1, pa2, pa3);
    SBAR(); SEAM_K0();
    if (hi == 0) li_l[r32] = l_reg; asm volatile("s_waitcnt lgkmcnt(0)" ::: "memory");
    float rli[16];
#pragma unroll
    for (int r = 0; r < 16; ++r) rli[r] = __builtin_amdgcn_rcpf(li_l[crow(r, hi)]);
    bf16* Ow = cur.O + (size_t)(wid * QBLK) * QP;
#pragma unroll
    for (int r = 0; r < 16; ++r) { const int orow = crow(r, hi);
#pragma unroll
        for (int d0 = 0; d0 < 4; ++d0) { const float v = o[d0][r] * rli[r];
            const float vn = dpp_mov<0xB1>(v);
            if ((r32 & 1) == 0) *(unsigned*)(Ow + (size_t)orow * QP + d0 * 32 + r32) = cvtpk(v, vn); } }
    __syncthreads();
#undef KBASE
#undef MASKT
#undef KEEP
#undef SEAM_K0
#undef HALF_STEP
}
#undef ROWK
#undef VMW
#undef VMWN
#undef SLOAD_H
#undef SWRITE_HK
#undef SWRITE_HV
#undef SWRITE_H
#undef KSWZ
#undef SBAR
}


namespace hgrn {
typedef short s16x4 __attribute__((ext_vector_type(4)));
typedef short bf16x8 __attribute__((ext_vector_type(8)));
typedef float f32x4 __attribute__((ext_vector_type(4)));
typedef unsigned u32x2 __attribute__((ext_vector_type(2)));
typedef unsigned u32x4 __attribute__((ext_vector_type(4)));
constexpr int QROW = 272, TROW = 40;
constexpr int OFF_QH = 0, OFF_KH = 16 * QROW, OFF_KDT = 2 * 16 * QROW, OFF_VT = OFF_KDT + 128 * TROW, OFF_DV = OFF_VT + 128 * TROW, SET_BYTES = OFF_DV + 512;
constexpr int OFF_PART = 2 * SET_BYTES, OFF_RAW = 40960, RAW_T = 16 * QROW  , RAW_SLOT = 5 * RAW_T, OFF_OBUF = OFF_RAW + 3 * RAW_SLOT, LDS_BYTES = OFF_OBUF + 64 * QROW;
static_assert(SET_BYTES % 16 == 0 && OFF_KDT % 16 == 0 && OFF_VT % 8 == 0 && OFF_DV % 16 == 0 && OFF_PART + 1024 <= OFF_RAW && LDS_BYTES <= 131072, "hgrn LDS map");
typedef float f32x2_t __attribute__((ext_vector_type(2))); typedef __bf16 bf16x2_t __attribute__((ext_vector_type(2)));
__device__ __forceinline__ unsigned cvtpk(float lo, float hi) { f32x2_t v = {lo, hi}; bf16x2_t b = __builtin_convertvector(v, bf16x2_t); return __builtin_bit_cast(unsigned, b); }
__device__ __forceinline__ float bf2f(unsigned short b) { return __uint_as_float((unsigned)b << 16); }
__device__ __forceinline__ s16x4 pack4(f32x4 v) { u32x2 w; w.x = cvtpk(v[0], v[1]); w.y = cvtpk(v[2], v[3]); return __builtin_bit_cast(s16x4, w); }

template <int CTRL> __device__ __forceinline__ float dpp_mov(float v) { return __int_as_float(__builtin_amdgcn_update_dpp(0, __float_as_int(v), CTRL, 0xf, 0xf, true)); }
__device__ __forceinline__ float row16_sum(float s) { s += dpp_mov<0xB1>(s); s += dpp_mov<0x4E>(s); s += dpp_mov<0x141>(s); s += dpp_mov<0x140>(s); return s; }
__device__ __forceinline__ void quarter_scan(float T, int qt, float& pre, float& post, float& tot) {
    auto r16 = __builtin_amdgcn_permlane16_swap(__float_as_uint(T), __float_as_uint(T), false, false);
    const float a = __uint_as_float(r16[0]), b = __uint_as_float(r16[1]);
    const float pr = a + b;
    auto r32 = __builtin_amdgcn_permlane32_swap(__float_as_uint(pr), __float_as_uint(pr), false, false);
    const float c = __uint_as_float(r32[0]), d = __uint_as_float(r32[1]);
    pre = qt == 0 ? 0.f : qt == 1 ? a : qt == 2 ? c : c + a;
    post = qt == 0 ? b + d : qt == 1 ? d : qt == 2 ? b : 0.f;
    tot = c + d;
}
struct Ptrs { const unsigned short* QQ; const unsigned short* HK; const unsigned short* HV; const unsigned short* HLF; const unsigned short* HSG; };
struct RawRegs { u32x4 a, b, c; };

template <bool OUT> __device__ __forceinline__ void g_load(RawRegs& R, const Ptrs& P, size_t row0, int hcol, int w, int lane) {
    const bool lo = w < 4; const size_t r = row0 + 4 * (w & 3) + (lane >> 4); const int c = hcol + 8 * (lane & 15);
    R.a = *(const u32x4*)((lo ? P.HLF : P.HK) + r * 1024 + c);
    if constexpr (OUT) { R.b = *(const u32x4*)((lo ? P.HV + r * 1024 : P.QQ + r * 2048) + c); if (lo) R.c = *(const u32x4*)(P.HSG + r * 1024 + c); }
    else { if (lo) R.b = *(const u32x4*)(P.HV + r * 1024 + c); }
}
template <bool OUT> __device__ __forceinline__ void raw_write(const RawRegs& R, char* slot, int w, int lane) {
    const bool lo = w < 4; const int d = (4 * (w & 3) + (lane >> 4)) * QROW + 16 * (lane & 15);
    *(u32x4*)(slot + (lo ? 0 : RAW_T) + d) = R.a;
    if constexpr (OUT) { *(u32x4*)(slot + (lo ? 2 * RAW_T : 3 * RAW_T) + d) = R.b; if (lo) *(u32x4*)(slot + 4 * RAW_T + d) = R.c; }
    else { if (lo) *(u32x4*)(slot + 2 * RAW_T + d) = R.b; }
}
template <bool OUT>
__device__ __forceinline__ float stage(const char* raw, char* set, int ch, int qt, float run, float (&sg)[4]) {
    float lf[4], kk[4], vv4[4], qq[4];
#pragma unroll
    for (int j = 0; j < 4; ++j) { const int o = (4 * qt + j) * QROW + ch * 2;
        lf[j] = (float)__builtin_bit_cast(_Float16, *(const unsigned short*)(raw + o));
        kk[j] = bf2f(*(const unsigned short*)(raw + RAW_T + o)); vv4[j] = bf2f(*(const unsigned short*)(raw + 2 * RAW_T + o));
        if constexpr (OUT) { qq[j] = bf2f(*(const unsigned short*)(raw + 3 * RAW_T + o)); sg[j] = bf2f(*(const unsigned short*)(raw + 4 * RAW_T + o)); } }
    float pre, post, tot;
    f32x4 kd, vv;
    if constexpr (OUT) {
        float c[4]; c[0] = lf[0]; c[1] = c[0] + lf[1]; c[2] = c[1] + lf[2]; c[3] = c[2] + lf[3];
        quarter_scan(c[3], qt, pre, post, tot);
#pragma unroll
        for (int j = 0; j < 4; ++j) { const float b = pre + c[j]; const int t = 4 * qt + j;
            kd[j] = kk[j] * __builtin_amdgcn_exp2f(tot - b); vv[j] = vv4[j];
            *(unsigned short*)(set + OFF_QH + t * QROW + ch * 2) = (unsigned short)(cvtpk(qq[j] * __builtin_amdgcn_exp2f(b), 0.f) & 0xffffu);
            *(unsigned short*)(set + OFF_KH + t * QROW + ch * 2) = (unsigned short)(cvtpk(kk[j] * __builtin_amdgcn_exp2f(fminf(-b, 100.f)), 0.f) & 0xffffu); }
        if (qt == 0) *(float*)(set + OFF_DV + ch * 4) = __builtin_amdgcn_exp2f(tot);
    } else {
        float e[4]; e[3] = 0.f; e[2] = lf[3]; e[1] = e[2] + lf[2]; e[0] = e[1] + lf[1];
        quarter_scan(e[0] + lf[0], qt, pre, post, tot);
#pragma unroll
        for (int j = 0; j < 4; ++j) { kd[j] = kk[j] * __builtin_amdgcn_exp2f(e[j] + post + run); vv[j] = vv4[j]; }
    }
    *(s16x4*)(set + OFF_KDT + ch * TROW + 8 * qt) = pack4(kd);
    *(s16x4*)(set + OFF_VT + ch * TROW + 8 * qt) = pack4(vv);
    return tot;
}

template <bool OUT>
__device__ __forceinline__ void run_item(char* lds, const Ptrs& P, unsigned short* OUTQ  , const float* gout, float* LST, float* DST, int item, int g, size_t m0, int h) {
    int tid = threadIdx.x; asm volatile("" : "+v"(tid));
    const int w = __builtin_amdgcn_readfirstlane(tid >> 6), lane = tid & 63, c16 = lane & 15, q = lane >> 4;
    const int ch = 16 * w + c16, hcol = h * 128;
    float* part = (float*)(lds + OFF_PART); char* rawb = lds + OFF_RAW; char* obuf = lds + OFF_OBUF; (void)obuf;
    constexpr int NSUB = 32;
#define HG_ROW(s) (m0 + 16 * (OUT ? (s) : (NSUB - 1 - (s))))
    RawRegs RA, RB; RA.a = RA.b = RA.c = RB.a = RB.b = RB.c = (u32x4){0u, 0u, 0u, 0u};
    g_load<OUT>(RA, P, HG_ROW(0), hcol, w, lane); g_load<OUT>(RB, P, HG_ROW(1), hcol, w, lane);
    f32x4 S[8];
#pragma unroll
    for (int kb = 0; kb < 8; ++kb) S[kb] = (f32x4){0.f, 0.f, 0.f, 0.f};
    if constexpr (OUT) {
        int gp = 0;
        for (; gp + 1 < g; gp += 2) { const int it0 = item - g + gp, it1 = it0 + 1;
#pragma unroll
            for (int kb = 0; kb < 8; ++kb) { const f32x4 d0 = *(const f32x4*)(DST + (size_t)it0 * 128 + 16 * kb + 4 * q), d1 = *(const f32x4*)(DST + (size_t)it1 * 128 + 16 * kb + 4 * q);
                const f32x4 l0 = *(const f32x4*)(LST + ((size_t)(it0 * 8 + w) * 8 + kb) * 256 + lane * 4), l1 = *(const f32x4*)(LST + ((size_t)(it1 * 8 + w) * 8 + kb) * 256 + lane * 4);
#pragma unroll
                for (int r = 0; r < 4; ++r) S[kb][r] = __builtin_amdgcn_exp2f(d1[r]) * (__builtin_amdgcn_exp2f(d0[r]) * S[kb][r] + l0[r]) + l1[r]; } }
        if (gp < g) { const int itp = item - g + gp;
#pragma unroll
            for (int kb = 0; kb < 8; ++kb) { const f32x4 dl = *(const f32x4*)(DST + (size_t)itp * 128 + 16 * kb + 4 * q);
                const f32x4 l4 = *(const f32x4*)(LST + ((size_t)(itp * 8 + w) * 8 + kb) * 256 + lane * 4);
#pragma unroll
                for (int r = 0; r < 4; ++r) S[kb][r] = __builtin_amdgcn_exp2f(dl[r]) * S[kb][r] + l4[r]; } }
    }
    float gv = 0.f; if constexpr (OUT) gv = gout[ch];
    float dsum = 0.f;
    raw_write<OUT>(RA, rawb, w, lane); raw_write<OUT>(RB, rawb + RAW_SLOT, w, lane);
    g_load<OUT>(RA, P, HG_ROW(2), hcol, w, lane); g_load<OUT>(RB, P, HG_ROW(3), hcol, w, lane);
    __syncthreads();
    float sgc[4] = {0.f, 0.f, 0.f, 0.f};
    dsum += stage<OUT>(rawb, lds, ch, q, dsum, sgc);
    __syncthreads();
#define HG_STEP(i, RX) do { \
        char* set = lds + ((i) & 1) * SET_BYTES; char* setn = lds + (((i) + 1) & 1) * SET_BYTES; \
        if ((i) + 2 < NSUB) { raw_write<OUT>(RX, rawb + (((i) + 2) % 3) * RAW_SLOT, w, lane); if ((i) + 4 < NSUB) g_load<OUT>(RX, P, HG_ROW((i) + 4), hcol, w, lane); } \
        const s16x4 vb = *(const s16x4*)(set + OFF_VT + ch * TROW + 8 * q); \
        f32x4 o = (f32x4){0.f, 0.f, 0.f, 0.f}; \
        if constexpr (OUT) { \
            f32x4 at = (f32x4){0.f, 0.f, 0.f, 0.f}; \
            _Pragma("unroll") for (int ks = 0; ks < 4; ++ks) { const bf16x8 a = *(const bf16x8*)(set + OFF_KH + c16 * QROW + (32 * ks + 8 * q) * 2), b = *(const bf16x8*)(set + OFF_QH + c16 * QROW + (32 * ks + 8 * q) * 2); \
                at = __builtin_amdgcn_mfma_f32_16x16x32_bf16(a, b, at, 0, 0, 0); } \
            _Pragma("unroll") for (int r = 0; r < 4; ++r) at[r] = (4 * q + r > c16) ? 0.f : at[r]; \
            _Pragma("unroll") for (int kb = 0; kb < 8; ++kb) { const s16x4 a = *(const s16x4*)(set + OFF_QH + c16 * QROW + (16 * kb + 4 * q) * 2); \
                o = __builtin_amdgcn_mfma_f32_16x16x16bf16_1k(a, pack4(S[kb]), o, 0, 0, 0); } \
            o = __builtin_amdgcn_mfma_f32_16x16x16bf16_1k(pack4(at), vb, o, 0, 0, 0); \
        } \
        _Pragma("unroll") for (int kb = 0; kb < 8; ++kb) { const s16x4 a = *(const s16x4*)(set + OFF_KDT + (16 * kb + c16) * TROW + 8 * q); \
            if constexpr (OUT) { const f32x4 dv = *(const f32x4*)(set + OFF_DV + (16 * kb + 4 * q) * 4); S[kb] = __builtin_amdgcn_mfma_f32_16x16x16bf16_1k(a, vb, S[kb] * dv, 0, 0, 0); } \
            else S[kb] = __builtin_amdgcn_mfma_f32_16x16x16bf16_1k(a, vb, S[kb], 0, 0, 0); } \
        if constexpr (OUT) { \
            _Pragma("unroll") for (int r = 0; r < 4; ++r) { const float s = row16_sum(o[r] * o[r]); \
                if (c16 == 0) part[(((i) & 1) * 8 + w) * 16 + 4 * q + r] = s; } \
        } \
        float sgn[4] = {0.f, 0.f, 0.f, 0.f}; \
        if ((i) + 1 < NSUB) dsum += stage<OUT>(rawb + (((i) + 1) % 3) * RAW_SLOT, setn, ch, q, dsum, sgn); \
        __syncthreads(); \
        if constexpr (OUT) { \
            _Pragma("unroll") for (int r = 0; r < 4; ++r) { float tot = 0.f; \
                _Pragma("unroll") for (int ww = 0; ww < 8; ++ww) tot += part[(((i) & 1) * 8 + ww) * 16 + 4 * q + r]; \
                const float rstd = __builtin_amdgcn_rsqf(tot * (1.f / 128.f) + NORM_EPS); \
                *(unsigned short*)(obuf + ((((i) & 3) * 16) + 4 * q + r) * QROW + ch * 2) = (unsigned short)(cvtpk(o[r] * rstd * gv * sgc[r], 0.f) & 0xffffu); } \
            _Pragma("unroll") for (int j = 0; j < 4; ++j) sgc[j] = sgn[j]; \
            if (((i) & 3) == 3) { __syncthreads();            \
                _Pragma("unroll") for (int k2 = 0; k2 < 2; ++k2) { const int id = tid + 512 * k2, row = id >> 4, c8 = id & 15; \
                    *(u32x4*)(OUTQ + (m0 + 16 * ((i) - 3) + row) * 2048 + hcol + 8 * c8) = *(const u32x4*)(obuf + row * QROW + 16 * c8); } } \
        } } while (0)
#pragma unroll 1
    for (int i = 0; i < NSUB; i += 2) { HG_STEP(i, RA); HG_STEP(i + 1, RB); }
#undef HG_STEP
#undef HG_ROW
    if constexpr (!OUT) {
#pragma unroll
        for (int kb = 0; kb < 8; ++kb) *(f32x4*)(LST + ((size_t)(item * 8 + w) * 8 + kb) * 256 + lane * 4) = S[kb];
        if (q == 0) DST[(size_t)item * 128 + ch] = dsum;
    }
    __syncthreads();
}
}


#ifndef H2_DEFER
#define H2_DEFER 1
#endif
namespace hg2 {
typedef short s16x4 __attribute__((ext_vector_type(4)));
typedef short bf16x8 __attribute__((ext_vector_type(8)));
typedef float f32x4 __attribute__((ext_vector_type(4)));
typedef unsigned u32x2 __attribute__((ext_vector_type(2)));
typedef unsigned u32x4 __attribute__((ext_vector_type(4)));
constexpr int C = 32, NCH = 16;
constexpr int QROW = 272, TROW = 80;
constexpr int OFF_QH = 0, OFF_KH = C * QROW, OFF_KDT = 2 * C * QROW, OFF_VT = OFF_KDT + 128 * TROW, OFF_DV = OFF_VT + 128 * TROW, OFF_ER = OFF_DV + 512, SET_BYTES = OFF_ER + 512;
constexpr int RAW_T = 16 * QROW, RAW_SLOT = 5 * RAW_T;
constexpr int OFF_RAW = SET_BYTES, OFF_PART = OFF_RAW + 3 * RAW_SLOT, OFF_OBUF = OFF_PART + 2 * 4 * C * 4, OFF_SG = OFF_OBUF + 64 * QROW  , LDS_BYTES = OFF_SG + 2 * C * QROW;
static_assert(SET_BYTES % 16 == 0 && OFF_KDT % 16 == 0 && OFF_VT % 16 == 0 && OFF_DV % 16 == 0 && OFF_RAW % 16 == 0 && OFF_PART % 16 == 0 && OFF_OBUF % 16 == 0 && LDS_BYTES <= 143360, "hg2 LDS map");
typedef float f32x2_t __attribute__((ext_vector_type(2))); typedef __bf16 bf16x2_t __attribute__((ext_vector_type(2)));
__device__ __forceinline__ unsigned cvtpk(float lo, float hi) { f32x2_t v = {lo, hi}; bf16x2_t b = __builtin_convertvector(v, bf16x2_t); return __builtin_bit_cast(unsigned, b); }
__device__ __forceinline__ float bf2f(unsigned short b) { return __uint_as_float((unsigned)b << 16); }
__device__ __forceinline__ s16x4 pack4(f32x4 v) { u32x2 w; w.x = cvtpk(v[0], v[1]); w.y = cvtpk(v[2], v[3]); return __builtin_bit_cast(s16x4, w); }
template <int CTRL> __device__ __forceinline__ float dpp_mov(float v) { return __int_as_float(__builtin_amdgcn_update_dpp(0, __float_as_int(v), CTRL, 0xf, 0xf, true)); }
__device__ __forceinline__ float row16_sum(float s) { s += dpp_mov<0xB1>(s); s += dpp_mov<0x4E>(s); s += dpp_mov<0x141>(s); s += dpp_mov<0x140>(s); return s; }

struct Ptrs { const unsigned short* QQ; const unsigned short* HK; const unsigned short* HV; const unsigned short* HLF; const unsigned short* HSG; };
#define U4(x) __builtin_bit_cast(u32x4, (x))
#define F4(x) __builtin_bit_cast(f32x4, (x))
template <bool OUT> __device__ __forceinline__ void g_load(f32x4* R, const Ptrs& P, size_t row0, int hcol, int sw, int lane) {
    const size_t r = row0 + 4 * sw + (lane >> 4); const int c = hcol + 8 * (lane & 15);
    R[0] = *(const f32x4*)(P.HLF + r * 1024 + c); R[1] = *(const f32x4*)(P.HK + r * 1024 + c); R[2] = *(const f32x4*)(P.HV + r * 1024 + c);
    if constexpr (OUT) { R[3] = *(const f32x4*)(P.QQ + r * 2048 + c); R[4] = *(const f32x4*)(P.HSG + r * 1024 + c); }
}
template <bool OUT> __device__ __forceinline__ void raw_write(const f32x4* R, char* slot, int sw, int lane) {
    const int d = (4 * sw + (lane >> 4)) * QROW + 16 * (lane & 15);
    *(f32x4*)(slot + d) = R[0]; *(f32x4*)(slot + RAW_T + d) = R[1]; *(f32x4*)(slot + 2 * RAW_T + d) = R[2];
    if constexpr (OUT) { *(f32x4*)(slot + 3 * RAW_T + d) = R[3]; *(f32x4*)(slot + 4 * RAW_T + d) = R[4]; }
}
template <bool OUT>
__device__ __forceinline__ float stage_compute(f32x4* Zr, float& zdv, float& zer, const char* raw, int ch, int hf, float run) {
    const char* rp = raw + ch * 2;
    float c[16];
    float tot, pre = 0.f, bref = 0.f, post = 0.f;
    if constexpr (OUT) {
        c[0] = (float)__builtin_bit_cast(_Float16, *(const unsigned short*)rp);
#pragma unroll
        for (int j = 1; j < 16; ++j) c[j] = c[j - 1] + (float)__builtin_bit_cast(_Float16, *(const unsigned short*)(rp + j * QROW));
        auto rr = __builtin_amdgcn_permlane32_swap(__float_as_uint(c[15]), __float_as_uint(c[15]), false, false);
        const float t0 = __uint_as_float(rr[0]), t1 = __uint_as_float(rr[1]);
        tot = t0 + t1; bref = t0; pre = hf ? t0 : 0.f;
        zdv = __builtin_amdgcn_exp2f(tot); zer = __builtin_amdgcn_exp2f(bref);
    } else {
        c[15] = 0.f;
#pragma unroll
        for (int j = 14; j >= 0; --j) c[j] = c[j + 1] + (float)__builtin_bit_cast(_Float16, *(const unsigned short*)(rp + (j + 1) * QROW));
        const float T = c[0] + (float)__builtin_bit_cast(_Float16, *(const unsigned short*)rp);
        auto rr = __builtin_amdgcn_permlane32_swap(__float_as_uint(T), __float_as_uint(T), false, false);
        const float t0 = __uint_as_float(rr[0]), t1 = __uint_as_float(rr[1]);
        tot = t0 + t1; post = (hf ? 0.f : t1) + run;
        zdv = 0.f; zer = 0.f;
    }
#pragma unroll
    for (int hh = 0; hh < 2; ++hh) {
        u32x4 qh, kh, sg, kd, vv;
#pragma unroll
        for (int jj = 0; jj < 4; ++jj) { const int j = 4 * hh + jj; const char* r0 = rp + 2 * j * QROW; const char* r1 = r0 + QROW;
            const float k0 = bf2f(*(const unsigned short*)(r0 + RAW_T)), k1 = bf2f(*(const unsigned short*)(r1 + RAW_T));
            vv[jj] = (unsigned)*(const unsigned short*)(r0 + 2 * RAW_T) | ((unsigned)*(const unsigned short*)(r1 + 2 * RAW_T) << 16);
            if constexpr (OUT) {
                const float q0 = bf2f(*(const unsigned short*)(r0 + 3 * RAW_T)), q1 = bf2f(*(const unsigned short*)(r1 + 3 * RAW_T));
                sg[jj] = (unsigned)*(const unsigned short*)(r0 + 4 * RAW_T) | ((unsigned)*(const unsigned short*)(r1 + 4 * RAW_T) << 16);
                const float b0 = pre + c[2 * j], b1 = pre + c[2 * j + 1];
                kd[jj] = cvtpk(k0 * __builtin_amdgcn_exp2f(tot - b0), k1 * __builtin_amdgcn_exp2f(tot - b1));
                qh[jj] = cvtpk(q0 * __builtin_amdgcn_exp2f(fminf(b0 - bref, 100.f)), q1 * __builtin_amdgcn_exp2f(fminf(b1 - bref, 100.f)));
                kh[jj] = cvtpk(k0 * __builtin_amdgcn_exp2f(fminf(bref - b0, 100.f)), k1 * __builtin_amdgcn_exp2f(fminf(bref - b1, 100.f)));
            } else {
                kd[jj] = cvtpk(k0 * __builtin_amdgcn_exp2f(c[2 * j] + post), k1 * __builtin_amdgcn_exp2f(c[2 * j + 1] + post));
            } }
        if constexpr (OUT) { Zr[hh] = F4(qh); Zr[2 + hh] = F4(kh); Zr[4 + hh] = F4(sg); }
        Zr[6 + hh] = F4(kd); Zr[8 + hh] = F4(vv);
        __builtin_amdgcn_sched_barrier(0);
    }
    return tot;
}
template <bool OUT>
__device__ __forceinline__ void stage_write(const f32x4* Zr, float zdv, float zer, char* set, char* sgb, int ch, int hf) {
    *(f32x4*)(set + OFF_KDT + ch * TROW + 32 * hf) = Zr[6]; *(f32x4*)(set + OFF_KDT + ch * TROW + 32 * hf + 16) = Zr[7];
    *(f32x4*)(set + OFF_VT + ch * TROW + 32 * hf) = Zr[8]; *(f32x4*)(set + OFF_VT + ch * TROW + 32 * hf + 16) = Zr[9];
    if constexpr (OUT) {
#pragma unroll
        for (int j = 0; j < 8; ++j) { const int o = (16 * hf + 2 * j) * QROW + ch * 2;
            const unsigned qw = U4(Zr[j >> 2])[j & 3], kw = U4(Zr[2 + (j >> 2)])[j & 3], sw_ = U4(Zr[4 + (j >> 2)])[j & 3];
            *(unsigned short*)(set + OFF_QH + o) = (unsigned short)(qw & 0xffffu); *(unsigned short*)(set + OFF_QH + o + QROW) = (unsigned short)(qw >> 16);
            *(unsigned short*)(set + OFF_KH + o) = (unsigned short)(kw & 0xffffu); *(unsigned short*)(set + OFF_KH + o + QROW) = (unsigned short)(kw >> 16);
            *(unsigned short*)(sgb + o) = (unsigned short)(sw_ & 0xffffu); *(unsigned short*)(sgb + o + QROW) = (unsigned short)(sw_ >> 16); }
        if (hf == 0) { *(float*)(set + OFF_DV + ch * 4) = zdv; *(float*)(set + OFF_ER + ch * 4) = zer; }
    }
}

template <bool OUT>
__device__ __forceinline__ void run_item(char* lds, const Ptrs& P, unsigned short* OUTQ, const float* gout, float* LST, float* DST, int item, int g, size_t m0, int h) {
    int tid = threadIdx.x; asm volatile("" : "+v"(tid));
    const int w = __builtin_amdgcn_readfirstlane(tid >> 6), lane = tid & 63, c16 = lane & 15, q = lane >> 4;
    const bool stager = w >= 4; const int cw = w & 3;
    const int hcol = h * 128;
    char* set = lds; char* rawb = lds + OFF_RAW; float* part = (float*)(lds + OFF_PART); char* obuf = lds + OFF_OBUF;
    const int ch = 32 * cw + (lane & 31), hf = lane >> 5;
#define H2_ROW(vh) (m0 + 16 * (OUT ? (vh) : (2 * (NCH - 1 - ((vh) >> 1)) + ((vh) & 1))))
    f32x4 U[20];
#pragma unroll
    for (int k = 0; k < 20; ++k) U[k] = (f32x4){0.f, 0.f, 0.f, 0.f};
#define S_(vt, kb) U[8 * (vt) + (kb)]
#define O_(vt, tt) U[16 + 2 * (vt) + (tt)]
    float gv[2] = {0.f, 0.f};
    if constexpr (OUT) {
        if (!stager) {
            gv[0] = gout[32 * cw + c16]; gv[1] = gout[32 * cw + 16 + c16];
            for (int gp = 0; gp < g; ++gp) { const int itp = item - g + gp;
#pragma unroll
                for (int kb = 0; kb < 8; ++kb) { const f32x4 dl = *(const f32x4*)(DST + (size_t)itp * 128 + 16 * kb + 4 * q);
                    f32x4 e4; e4[0] = __builtin_amdgcn_exp2f(dl[0]); e4[1] = __builtin_amdgcn_exp2f(dl[1]); e4[2] = __builtin_amdgcn_exp2f(dl[2]); e4[3] = __builtin_amdgcn_exp2f(dl[3]);
#pragma unroll
                    for (int vt = 0; vt < 2; ++vt) { const f32x4 l4 = *(const f32x4*)(LST + ((size_t)((itp * 4 + cw) * 2 + vt) * 8 + kb) * 256 + lane * 4);
                        S_(vt, kb) = e4 * S_(vt, kb) + l4; } } }
        }
    }
    f32x4* const GA = U; f32x4* const GB = U + 5; f32x4* const Z = U + 10;
    float dsum = 0.f, zdv = 0.f, zer = 0.f;
    if (stager) { g_load<OUT>(GA, P, H2_ROW(0), hcol, cw, lane); g_load<OUT>(GB, P, H2_ROW(1), hcol, cw, lane);
        raw_write<OUT>(GA, rawb, cw, lane); raw_write<OUT>(GB, rawb + RAW_SLOT, cw, lane);
        g_load<OUT>(GA, P, H2_ROW(2), hcol, cw, lane); g_load<OUT>(GB, P, H2_ROW(3), hcol, cw, lane); }
    __syncthreads();
    if (stager) { dsum += stage_compute<OUT>(Z, zdv, zer, rawb + hf * RAW_SLOT, ch, hf, dsum);
        raw_write<OUT>(GA, rawb + 2 * RAW_SLOT, cw, lane); g_load<OUT>(GA, P, H2_ROW(4), hcol, cw, lane); }
    __syncthreads();
    if (stager) { stage_write<OUT>(Z, zdv, zer, set, lds + OFF_SG, ch, hf);
        raw_write<OUT>(GB, rawb, cw, lane); g_load<OUT>(GB, P, H2_ROW(5), hcol, cw, lane); }
    __syncthreads();
#pragma unroll 1
    for (int i = 0; i < NCH; ++i) {
        if (stager) {
            if (2 * i + 4 < 2 * NCH) { raw_write<OUT>(GA, rawb + ((2 * i + 4) % 3) * RAW_SLOT, cw, lane); if (2 * i + 6 < 2 * NCH) g_load<OUT>(GA, P, H2_ROW(2 * i + 6), hcol, cw, lane); }
            if (i + 1 < NCH) dsum += stage_compute<OUT>(Z, zdv, zer, rawb + ((2 * i + 2 + hf) % 3) * RAW_SLOT, ch, hf, dsum);
        } else {
            if constexpr (OUT) {
                f32x4 a00 = (f32x4){0.f, 0.f, 0.f, 0.f}, a01 = a00, a11 = a00;
#pragma unroll
                for (int ks = 0; ks < 4; ++ks) { const int ko = (32 * ks + 8 * q) * 2;
                    const bf16x8 k0 = *(const bf16x8*)(set + OFF_KH + c16 * QROW + ko), k1 = *(const bf16x8*)(set + OFF_KH + (16 + c16) * QROW + ko);
                    const bf16x8 q0 = *(const bf16x8*)(set + OFF_QH + c16 * QROW + ko), q1 = *(const bf16x8*)(set + OFF_QH + (16 + c16) * QROW + ko);
                    a00 = __builtin_amdgcn_mfma_f32_16x16x32_bf16(k0, q0, a00, 0, 0, 0); a01 = __builtin_amdgcn_mfma_f32_16x16x32_bf16(k0, q1, a01, 0, 0, 0); a11 = __builtin_amdgcn_mfma_f32_16x16x32_bf16(k1, q1, a11, 0, 0, 0); }
#pragma unroll
                for (int r = 0; r < 4; ++r) { const bool drop = 4 * q + r > c16; a00[r] = drop ? 0.f : a00[r]; a11[r] = drop ? 0.f : a11[r]; }
                const s16x4 p00 = pack4(a00), p01 = pack4(a01), p11 = pack4(a11);
#pragma unroll
                for (int vt = 0; vt < 2; ++vt) { O_(vt, 0) = (f32x4){0.f, 0.f, 0.f, 0.f}; O_(vt, 1) = (f32x4){0.f, 0.f, 0.f, 0.f}; }
#pragma unroll
                for (int kb = 0; kb < 8; ++kb) { const f32x4 er = *(const f32x4*)(set + OFF_ER + (16 * kb + 4 * q) * 4);
                    const s16x4 qa0 = *(const s16x4*)(set + OFF_QH + c16 * QROW + (16 * kb + 4 * q) * 2), qa1 = *(const s16x4*)(set + OFF_QH + (16 + c16) * QROW + (16 * kb + 4 * q) * 2);
#pragma unroll
                    for (int vt = 0; vt < 2; ++vt) {
#if defined(DBG_NO_ER)
                        const s16x4 sb = pack4(S_(vt, kb));
#elif defined(DBG_ZERO_S)
                        const s16x4 sb = pack4(S_(vt, kb) * 0.f + er * 1e-3f);
#else
                        const s16x4 sb = pack4(S_(vt, kb) * er);
#endif

#ifndef DBG_NO_INTER
                        O_(vt, 0) = __builtin_amdgcn_mfma_f32_16x16x16bf16_1k(qa0, sb, O_(vt, 0), 0, 0, 0); O_(vt, 1) = __builtin_amdgcn_mfma_f32_16x16x16bf16_1k(qa1, sb, O_(vt, 1), 0, 0, 0);
#endif
                    } }
#pragma unroll
                for (int vt = 0; vt < 2; ++vt) { const char* vr = set + OFF_VT + (32 * cw + 16 * vt + c16) * TROW + 8 * q;
                    const s16x4 va = *(const s16x4*)vr, vbh = *(const s16x4*)(vr + 32);
#ifndef DBG_NO_INTRA
                    O_(vt, 0) = __builtin_amdgcn_mfma_f32_16x16x16bf16_1k(p00, va, O_(vt, 0), 0, 0, 0);
                    O_(vt, 1) = __builtin_amdgcn_mfma_f32_16x16x16bf16_1k(p01, va, O_(vt, 1), 0, 0, 0);
                    O_(vt, 1) = __builtin_amdgcn_mfma_f32_16x16x16bf16_1k(p11, vbh, O_(vt, 1), 0, 0, 0);
#endif
                }
            }
            __builtin_amdgcn_sched_barrier(0);
            const bf16x8 vb0 = *(const bf16x8*)(set + OFF_VT + (32 * cw + c16) * TROW + 16 * q), vb1 = *(const bf16x8*)(set + OFF_VT + (32 * cw + 16 + c16) * TROW + 16 * q);
#pragma unroll
            for (int kb = 0; kb < 8; ++kb) { const bf16x8 a = *(const bf16x8*)(set + OFF_KDT + (16 * kb + c16) * TROW + 16 * q);
                if constexpr (OUT) { const f32x4 dv = *(const f32x4*)(set + OFF_DV + (16 * kb + 4 * q) * 4);
                    S_(0, kb) = __builtin_amdgcn_mfma_f32_16x16x32_bf16(a, vb0, S_(0, kb) * dv, 0, 0, 0); S_(1, kb) = __builtin_amdgcn_mfma_f32_16x16x32_bf16(a, vb1, S_(1, kb) * dv, 0, 0, 0); }
                else { S_(0, kb) = __builtin_amdgcn_mfma_f32_16x16x32_bf16(a, vb0, S_(0, kb), 0, 0, 0); S_(1, kb) = __builtin_amdgcn_mfma_f32_16x16x32_bf16(a, vb1, S_(1, kb), 0, 0, 0); } }
#ifdef DBG_CHECK_S
            if constexpr (OUT) { bool bad = false;
#pragma unroll
                for (int vt = 0; vt < 2; ++vt)
#pragma unroll
                    for (int kb = 0; kb < 8; ++kb)
#pragma unroll
                        for (int r = 0; r < 4; ++r) bad |= !(fabsf(S_(vt, kb)[r]) < 1e30f);
                if (bad) { O_(0, 0)[0] = __builtin_nanf(""); } }
#endif
            if constexpr (OUT) {
#pragma unroll
                for (int tt = 0; tt < 2; ++tt)
#pragma unroll
                    for (int r = 0; r < 4; ++r) { const float s = row16_sum(O_(0, tt)[r] * O_(0, tt)[r] + O_(1, tt)[r] * O_(1, tt)[r]);
                        if (c16 == 0) part[((i & 1) * 4 + cw) * C + 16 * tt + 4 * q + r] = s;
#if H2_DEFER
#pragma unroll
                        for (int vt = 0; vt < 2; ++vt) *(unsigned short*)(obuf + ((i & 1) * C + 16 * tt + 4 * q + r) * QROW + (32 * cw + 16 * vt + c16) * 2) = (unsigned short)(cvtpk(O_(vt, tt)[r] * gv[vt], 0.f) & 0xffffu);
#endif
                    }
            }
        }
        __syncthreads();
        if (stager) {
            if (i + 1 < NCH) stage_write<OUT>(Z, zdv, zer, set, lds + OFF_SG + ((i + 1) & 1) * C * QROW, ch, hf);
            if (2 * i + 5 < 2 * NCH) { raw_write<OUT>(GB, rawb + ((2 * i + 5) % 3) * RAW_SLOT, cw, lane); if (2 * i + 7 < 2 * NCH) g_load<OUT>(GB, P, H2_ROW(2 * i + 7), hcol, cw, lane); }
        }
#if H2_DEFER
        if constexpr (OUT) {
            const int row = tid >> 4, c8 = tid & 15;
            const float tot = (part[((i & 1) * 4 + 0) * C + row] + part[((i & 1) * 4 + 1) * C + row]) + (part[((i & 1) * 4 + 2) * C + row] + part[((i & 1) * 4 + 3) * C + row]);
            const float rstd = __builtin_amdgcn_rsqf(tot * (1.f / 128.f) + NORM_EPS);
            const u32x4 o8 = *(const u32x4*)(obuf + ((i & 1) * C + row) * QROW + 16 * c8), s8 = *(const u32x4*)(lds + OFF_SG + (i & 1) * C * QROW + row * QROW + 16 * c8);
            u32x4 w;
#pragma unroll
            for (int j = 0; j < 4; ++j) w[j] = cvtpk(__uint_as_float(o8[j] << 16) * rstd * __uint_as_float(s8[j] << 16), __uint_as_float(o8[j] & 0xffff0000u) * rstd * __uint_as_float(s8[j] & 0xffff0000u));
            *(u32x4*)(OUTQ + (m0 + 32 * i + row) * 2048 + hcol + 8 * c8) = w;
        }
#else
        else if constexpr (OUT) {
#pragma unroll
            for (int tt = 0; tt < 2; ++tt)
#pragma unroll
                for (int r = 0; r < 4; ++r) { const int t = 16 * tt + 4 * q + r;
                    const float tot = (part[((i & 1) * 4 + 0) * C + t] + part[((i & 1) * 4 + 1) * C + t]) + (part[((i & 1) * 4 + 2) * C + t] + part[((i & 1) * 4 + 3) * C + t]);
                    const float rstd = __builtin_amdgcn_rsqf(tot * (1.f / 128.f) + NORM_EPS);
#pragma unroll
                    for (int vt = 0; vt < 2; ++vt) { const float sgx = bf2f(*(const unsigned short*)(lds + OFF_SG + (i & 1) * C * QROW + t * QROW + (32 * cw + 16 * vt + c16) * 2));
                        *(unsigned short*)(obuf + ((i & 1) * C + t) * QROW + (32 * cw + 16 * vt + c16) * 2) = (unsigned short)(cvtpk(O_(vt, tt)[r] * rstd * gv[vt] * sgx, 0.f) & 0xffffu); } }
        }
#endif
        __syncthreads();
#if !H2_DEFER
        if constexpr (OUT) {
            if (i & 1) {
#pragma unroll
                for (int k2 = 0; k2 < 2; ++k2) { const int id = tid + 512 * k2, row = id >> 4, c8 = id & 15;
                    *(u32x4*)(OUTQ + (m0 + 32 * (i - 1) + row) * 2048 + hcol + 8 * c8) = *(const u32x4*)(obuf + row * QROW + 16 * c8); } }
        }
#endif
    }
#undef H2_ROW
    if constexpr (!OUT) {
        if (!stager) {
#pragma unroll
            for (int vt = 0; vt < 2; ++vt)
#pragma unroll
                for (int kb = 0; kb < 8; ++kb) *(f32x4*)(LST + ((size_t)((item * 4 + cw) * 2 + vt) * 8 + kb) * 256 + lane * 4) = S_(vt, kb);
        } else if (hf == 0) DST[(size_t)item * 128 + ch] = dsum;
    }
    __syncthreads();
#undef S_
#undef O_
}
#undef U4
#undef F4
}


struct Frame {
    LAS unsigned char* lds;
    volatile LAS unsigned* MISC;
    gu32* ctl;
    int tid, lane, wave;
    int vcu, G;
};

__device__ __forceinline__ float wave_sum(float v) { return pg8::rows4_sum(pg8::row16_sum(v)); }
__device__ __forceinline__ void p0_transpose64(const float* W, int ldw, int k0, int ncol0, bf16* WT, int ldt, int drow, int dk0, LAS unsigned char* scr, int lane, const float* ksc = nullptr) {
    const int n4 = lane & 15, qk = lane >> 4;
    const GAS f32x4* src = (const GAS f32x4*)(W + (size_t)(k0 + 2 * qk) * ldw + ncol0 + 4 * n4);
    f32x4 v[16];
#pragma unroll
    for (int p = 0; p < 8; ++p) { v[2 * p] = src[(size_t)(8 * p) * ldw / 4]; v[2 * p + 1] = src[(size_t)(8 * p + 1) * ldw / 4]; }
    if (ksc) {
#pragma unroll
        for (int p = 0; p < 8; ++p) { const float s0 = ksc[k0 + 2 * qk + 8 * p], s1 = ksc[k0 + 2 * qk + 8 * p + 1]; v[2 * p] = v[2 * p] * s0; v[2 * p + 1] = v[2 * p + 1] * s1; } }
#pragma unroll
    for (int p = 0; p < 8; ++p)
#pragma unroll
        for (int j = 0; j < 4; ++j) *(LAS unsigned*)(scr + (4 * n4 + j) * 132 + 16 * p + 4 * qk) = pk2(v[2 * p][j], v[2 * p + 1][j]);
    LDS_WAIT(); asm volatile("" ::: "memory");
    const int c = lane & 7;
#pragma unroll
    for (int j = 0; j < 8; ++j) { const int n = (lane >> 3) + 8 * j; const LAS unsigned* s = (const LAS unsigned*)(scr + n * 132 + 16 * c);
        v4u o; o.x = s[0]; o.y = s[1]; o.z = s[2]; o.w = s[3];
        *(GAS v4u*)(WT + (size_t)(drow + n) * ldt + dk0 + k0 + 8 * c) = o; }
    LDS_WAIT(); asm volatile("" ::: "memory");
}
__device__ __forceinline__ void rms_row_to_bf16(const float* xrow, const float* g, bf16* orow, int lane) {
    const GAS f32x4* xr = (const GAS f32x4*)xrow + lane; const GAS f32x4* gr = (const GAS f32x4*)g + lane;
    f32x4 v[4]; float s = 0.f;
#pragma unroll
    for (int j = 0; j < 4; ++j) { v[j] = xr[64 * j]; s += (v[j].x * v[j].x + v[j].y * v[j].y) + (v[j].z * v[j].z + v[j].w * v[j].w); }
    const float rstd = 1.f / sqrtf(wave_sum(s) * (1.f / DM) + NORM_EPS);
    GAS unsigned long long* o8 = (GAS unsigned long long*)orow + lane;
#pragma unroll
    for (int j = 0; j < 4; ++j) { const f32x4 gg = gr[64 * j];
        o8[64 * j] = (unsigned long long)pk2(v[j].x * rstd * gg.x, v[j].y * rstd * gg.y) | ((unsigned long long)pk2(v[j].z * rstd * gg.z, v[j].w * rstd * gg.w) << 32); }
}

__host__ __device__ __forceinline__ int win_row(int c) { if (c >= 4096 && c < 7168) return c - 4096; if (c < 4096) return 3072 + c; const int gi = c - 7168, hi = gi >= 1024, g2 = gi & 1023; return 7168 + 256 * (g2 >> 7) + 128 * hi + (g2 & 127); }
struct TrDesc { const float* W; int ldw, k0, ncol0; bf16* WT; int ldt, drow, dk0; };
__device__ __forceinline__ void tr_load(f32x4 (&v)[16], const TrDesc& d, int lane) {
    const int n4 = lane & 15, qk = lane >> 4;
    const GAS f32x4* src = (const GAS f32x4*)(d.W + (size_t)(d.k0 + 2 * qk) * d.ldw + d.ncol0 + 4 * n4);
#pragma unroll
    for (int p = 0; p < 8; ++p) { v[2 * p] = src[(size_t)(8 * p) * d.ldw / 4]; v[2 * p + 1] = src[(size_t)(8 * p + 1) * d.ldw / 4]; }
}
__device__ __forceinline__ void tr_store(const f32x4 (&v)[16], const TrDesc& d, LAS unsigned char* scr, int lane) {
    const int n4 = lane & 15, qk = lane >> 4;
#pragma unroll
    for (int p = 0; p < 8; ++p)
#pragma unroll
        for (int j = 0; j < 4; ++j) *(LAS unsigned*)(scr + (4 * n4 + j) * 132 + 16 * p + 4 * qk) = pk2(v[2 * p][j], v[2 * p + 1][j]);
    LDS_WAIT(); asm volatile("" ::: "memory");
    const int c = lane & 7;
#pragma unroll
    for (int j = 0; j < 8; ++j) { const int n = (lane >> 3) + 8 * j; const LAS unsigned* s = (const LAS unsigned*)(scr + n * 132 + 16 * c);
        v4u o; o.x = s[0]; o.y = s[1]; o.z = s[2]; o.w = s[3];
        *(GAS v4u*)(d.WT + (size_t)(d.drow + n) * d.ldt + d.dk0 + d.k0 + 8 * c) = o; }
    LDS_WAIT(); asm volatile("" ::: "memory");
}
__device__ __forceinline__ void h2_load(f32x4 (&v)[16], const float* x, int row, int lane) {
    const GAS f32x4* xr = (const GAS f32x4*)(x + (size_t)row * DM) + lane;
#pragma unroll
    for (int j = 0; j < 4; ++j) { v[j] = xr[64 * j]; v[4 + j] = xr[256 + 64 * j]; }
}
__device__ __forceinline__ void h2_store(const f32x4 (&v)[16], const float* g, bf16* HBp, int row, int lane) {
    const GAS f32x4* gr = (const GAS f32x4*)g + lane;
#pragma unroll
    for (int rr = 0; rr < 2; ++rr) { float s = 0.f;
#pragma unroll
        for (int j = 0; j < 4; ++j) { const f32x4 t = v[4 * rr + j]; s += (t.x * t.x + t.y * t.y) + (t.z * t.z + t.w * t.w); }
        const float rstd = 1.f / sqrtf(wave_sum(s) * (1.f / DM) + NORM_EPS);
        GAS unsigned long long* o8 = (GAS unsigned long long*)(HBp + (size_t)(row + rr) * DM) + lane;
#pragma unroll
        for (int j = 0; j < 4; ++j) { const f32x4 gg = gr[64 * j]; const f32x4 t = v[4 * rr + j];
            o8[64 * j] = (unsigned long long)pk2(t.x * rstd * gg.x, t.y * rstd * gg.y) | ((unsigned long long)pk2(t.z * rstd * gg.z, t.w * rstd * gg.w) << 32); } }
}


__device__ __forceinline__ int t5_bucket(int n) {
    if (n < 16) return n;
    int b = 15;
    b += n >= 16; b += n >= 19; b += n >= 21; b += n >= 24; b += n >= 27; b += n >= 31; b += n >= 35; b += n >= 40;
    b += n >= 46; b += n >= 52; b += n >= 59; b += n >= 67; b += n >= 77; b += n >= 87; b += n >= 99; b += n >= 113;
    return b;
}
__device__ __forceinline__ void naive_attn_row(int r, bool active, int tid, LAS float* sm, const bf16* AK, const bf16* AV, bf16* QQ, const float* KMEAN, const float* table) {
    LAS float* qs = sm; LAS float* gate = sm + 128; LAS int* sel = (LAS int*)(sm + 144); LAS float* bias_s = sm + 160; LAS float* lg = sm + 192; LAS float* red = sm + 192 + 1024;
    const int t = r % SEQ, bh = r / SEQ, h = bh % NH, b = bh / NH;
    const size_t m = (size_t)b * SEQ + t; const int c = t >> 8;
    if (tid < 128) qs[tid] = bf2f(QQ[m * 2048 + 1024 + h * 128 + tid]);
    if (tid < 32) bias_s[tid] = table[tid * 8 + h];
    __syncthreads();
    if (tid < 16) { float g = -INFINITY; if (tid < c) { g = 0.f; const float* km = KMEAN + ((size_t)bh * NBLK + tid) * HD; for (int d = 0; d < 128; ++d) g += qs[d] * km[d]; } gate[tid] = g; }
    __syncthreads();
    if (tid == 0) { unsigned used = 0u;
        for (int s = 0; s < 3; ++s) { int best = -1; float bv = 0.f; for (int n = 0; n < 16; ++n) if (!((used >> n) & 1u)) { const float gv = gate[n]; if (best < 0 || gv > bv) { best = n; bv = gv; } } used |= 1u << best; sel[s] = best; } }
    __syncthreads();
    for (int s = 0; s < 4; ++s) {
        int blk; bool valid;
        if (s == 0) { blk = c; valid = tid <= (t & 255); } else { blk = sel[s - 1]; valid = blk < c; }
        float logit = -INFINITY;
        if (valid) { const int pos = blk * 256 + tid; const bf16* kr = AK + ((size_t)b * SEQ + pos) * 1024 + h * 128; float dot = 0.f;
            for (int d = 0; d < 128; d += 8) { const v4u w = *(const GAS v4u*)(kr + d);
                dot += qs[d] * __uint_as_float(w.x << 16) + qs[d + 1] * __uint_as_float(w.x & 0xffff0000u) + qs[d + 2] * __uint_as_float(w.y << 16) + qs[d + 3] * __uint_as_float(w.y & 0xffff0000u)
                     + qs[d + 4] * __uint_as_float(w.z << 16) + qs[d + 5] * __uint_as_float(w.z & 0xffff0000u) + qs[d + 6] * __uint_as_float(w.w << 16) + qs[d + 7] * __uint_as_float(w.w & 0xffff0000u); }
            logit = dot * ATT_SCALE + bias_s[t5_bucket(t - pos)]; }
        lg[s * 256 + tid] = logit;
    }
    __syncthreads();
    float mx = fmaxf(fmaxf(lg[tid], lg[256 + tid]), fmaxf(lg[512 + tid], lg[768 + tid]));
    red[tid] = mx; __syncthreads();
    for (int o = 128; o > 0; o >>= 1) { if (tid < o) red[tid] = fmaxf(red[tid], red[tid + o]); __syncthreads(); }
    mx = red[0]; __syncthreads();
    float ps = 0.f;
    for (int s = 0; s < 4; ++s) { const float p = __expf(lg[s * 256 + tid] - mx); lg[s * 256 + tid] = p; ps += p; }
    red[tid] = ps; __syncthreads();
    for (int o = 128; o > 0; o >>= 1) { if (tid < o) red[tid] += red[tid + o]; __syncthreads(); }
    const float tot = red[0];
    if (tid < 128) { float acc = 0.f;
        for (int s = 0; s < 4; ++s) { const int blk = (s == 0) ? c : sel[s - 1]; if (s > 0 && blk >= c) continue;
            const bf16* vr = AV + ((size_t)b * SEQ + blk * 256) * 1024 + h * 128 + tid;
            for (int j = 0; j < 256; ++j) { const float p = lg[s * 256 + j]; if (p != 0.f) acc += p * bf2f(vr[(size_t)j * 1024]); } }
        if (active) QQ[m * 2048 + 1024 + h * 128 + tid] = (bf16)f2bf(acc / tot); }
    __syncthreads();
}

#ifndef MK_NAIVE_ATTN
#define MK_NAIVE_ATTN 0
#endif
#ifndef MK_NAIVE_HGRN
#define MK_NAIVE_HGRN 0
#endif
#ifndef PROBE_DUP
#define PROBE_DUP 0
#endif
#ifndef PROBE_T
#define PROBE_T -1
#endif
#ifndef PROBE_BLK
#define PROBE_BLK 0
#endif
#ifndef MK_P0_PIPE
#define MK_P0_PIPE 0
#endif
#ifndef PROBE_P0
#define PROBE_P0 0
#endif
#ifndef MK_ALIGN_P1A
#define MK_ALIGN_P1A true
#endif
#ifndef MK_ALIGN_P8
#define MK_ALIGN_P8 true
#endif
#ifndef MK_ALIGN_1U
#define MK_ALIGN_1U true
#endif
#ifndef MK_SP2
#define MK_SP2 true
#endif
#ifndef MK_WGM_P1B
#define MK_WGM_P1B 4
#endif
#ifndef MK_WGM_P1A
#define MK_WGM_P1A 4
#endif
#ifndef MK_WGM_P8
#define MK_WGM_P8 4
#endif
#ifndef MK_WGM_1U
#define MK_WGM_1U 4
#endif
#ifndef MK_HG2
#define MK_HG2 1
#endif
#ifndef MK_HG2A
#define MK_HG2A MK_HG2
#endif
#ifndef MK_HG2B
#define MK_HG2B MK_HG2
#endif
#ifndef MK_ATT_HEAVY_FIRST
#define MK_ATT_HEAVY_FIRST 0
#endif
#ifndef MK_ONE_LAUNCH
#define MK_ONE_LAUNCH 1
#endif
struct Args { const float* in[15]; float* out; unsigned char* ws; int ph_lo, ph_hi; };
static_assert(sizeof(Args) == 15 * 8 + 8 + 8 + 8, "Args has no padding");

__global__ void __launch_bounds__(NWAVES * 64, 2) mk_fwd(Args args) {
    extern __shared__ __attribute__((aligned(16))) unsigned char lds[];
    Frame F;
    F.lds = (LAS unsigned char*)lds;
    F.MISC = (volatile LAS unsigned*)(F.lds + MISC_OFF);
    F.tid = threadIdx.x; F.lane = F.tid & 63; F.wave = __builtin_amdgcn_readfirstlane(F.tid >> 6);
    F.G = gridDim.x; { const int bx = blockIdx.x; F.vcu = (F.G % 8 == 0) ? (bx % 8) * (F.G / 8) + bx / 8 : bx; }
    unsigned char* ws = args.ws;
    F.ctl = (gu32*)(ws + WS_CTL);
    const float* x = args.in[0]; const float* attn_g = args.in[1]; const float* w_in = args.in[2]; const float* lb_gamma = args.in[3];
    const float* hg_out_g = args.in[4]; const float* q_g = args.in[5]; const float* k_g = args.in[6]; const float* rel_tab = args.in[7];
    const float* w_bh = args.in[8]; const float* w_ba = args.in[9]; const float* w_out = args.in[10]; const float* ffn_g = args.in[11];
    const float* w_gate = args.in[12]; const float* w_up = args.in[13]; const float* w_down = args.in[14];
    (void)hg_out_g; (void)rel_tab;
    bf16* WT_IN = (bf16*)(ws + WS_WT_IN); bf16* WT_CAT = (bf16*)(ws + WS_WT_CAT); bf16* WT_OUT = (bf16*)(ws + WS_WT_OUT);
    bf16* WT_FIN = (bf16*)(ws + WS_WT_FIN); bf16* WT_DOWN = (bf16*)(ws + WS_WT_DOWN); bf16* HB = (bf16*)(ws + WS_H);
    bf16* QQ = (bf16*)(ws + WS_QQ); bf16* AK = (bf16*)(ws + WS_AK); bf16* AV = (bf16*)(ws + WS_AV);
    unsigned short* HLF = (unsigned short*)(ws + WS_HLF); bf16* HSG = (bf16*)(ws + WS_HSG);
    float* KMEAN = (float*)(ws + WS_KMEAN); bf16* KMEANB = (bf16*)(ws + WS_KMEANB); float* LB = (float*)(ws + WS_LB); float* SSQ = (float*)(ws + WS_SSQ);
    bf16* MERGED = (bf16*)(ws + WS_MERGED); bf16* X1B = (bf16*)(ws + WS_A2); bf16* ACT = (bf16*)(ws + WS_ACT);
    float* LST = (float*)(ws + WS_LST); float* DST = (float*)(ws + WS_DST);
    bf16* GATES = (bf16*)args.out;

    for (int u = F.tid; u < (LDS_BYTES - LDSCTL_OFF) / 4; u += NWAVES * 64) ((LAS unsigned*)(F.lds + LDSCTL_OFF))[u] = 0u;
    __syncthreads();
    const int lo = args.ph_lo, hi = args.ph_hi;
    XcdBarrier bar; bar.bar = (unsigned*)(F.ctl + CW_BAR); bar.x = 0; bar.st = nullptr;
    if (hi - lo > 1) bar = xcd_barrier_post((unsigned*)(F.ctl + CW_BAR), F.MISC + 8);
#ifndef PHMASK
#define PHMASK 0x3ff
#endif
#define IN(k) (((PHMASK >> (k)) & 1) && lo <= (k) && (k) < hi)
#define BOTH(k) (IN(k) && IN((k) + 1))
#define GRID_BAR() xcd_barrier(bar)
    const int gw = F.vcu * NWAVES + F.wave, NGW = F.G * NWAVES;
    unsigned long long pt0 = 0ull, pt1 = 0ull; (void)pt0; (void)pt1;
#define TSTART(k) do { if (PROBE_T == (k) || PROBE_T == (k) + 20) pt0 = __builtin_amdgcn_s_memrealtime(); } while (0)
#define TEND(k) do { if (PROBE_T == (k)) pt1 = __builtin_amdgcn_s_memrealtime(); } while (0)
    LAS unsigned char* scrb = F.lds + RING_OFF + F.wave * 16384;

#if (PROBE_DUP >> 0) & 1
    for (int rep_0 = 0; rep_0 < 2; ++rep_0) {
#endif
    if (IN(0)) { TSTART(0);
        constexpr int I_IN = 16 * 144, I_B = 16 * 16, I_T = I_IN + 3 * I_B, I_H = MTOK / 2;
        if (MK_P0_PIPE && NGW == 2048) {
            const int nit = gw < 1024 ? 5 : 6;
#define P0_DEC(k) const int k_ = (k); const bool isT = k_ == 0 || (gw < 1024 && k_ == 1); \
            const int idx = isT ? (k_ == 0 ? gw : 2048 + gw) : (gw < 1024 ? 3 * gw + k_ - 2 : 3072 + 5 * (gw - 1024) + k_ - 1); \
            TrDesc td; { int r = idx; if (r < I_IN) { const int c = 64 * (r % 144); td = TrDesc{w_in, INCOLS, 64 * (r / 144), c, WT_IN, 1024, win_row(c), 0}; } \
                else { r -= I_IN; const int wsel = r / I_B; r %= I_B; td = TrDesc{wsel == 0 ? w_bh : (wsel == 1 ? w_ba : w_out), 1024, 64 * (r / 16), 64 * (r % 16), wsel == 2 ? WT_OUT : WT_CAT, wsel == 2 ? 1024 : 2048, 64 * (r % 16), wsel == 1 ? 1024 : 0}; } }
#define P0_LOAD(v, k) do { P0_DEC(k); if (isT) tr_load(v, td, F.lane); else h2_load(v, x, 2 * idx, F.lane); } while (0)
#define P0_PROC(v, k) do { P0_DEC(k); if (isT) tr_store(v, td, scrb, F.lane); else h2_store(v, attn_g, HB, 2 * idx, F.lane); } while (0)
            f32x4 va[16], vb[16];
#pragma unroll
            for (int j = 0; j < 16; ++j) { va[j] = (f32x4){0.f, 0.f, 0.f, 0.f}; vb[j] = (f32x4){0.f, 0.f, 0.f, 0.f}; }
            P0_LOAD(va, 0);
#pragma unroll 1
            for (int k = 0; k < nit; k += 2) {
                if (k + 1 < nit) P0_LOAD(vb, k + 1);
                P0_PROC(va, k);
                if (k + 2 < nit) P0_LOAD(va, k + 2);
                if (k + 1 < nit) P0_PROC(vb, k + 1);
            }
#undef P0_DEC
#undef P0_LOAD
#undef P0_PROC
        } else
        for (int it = gw; it < I_T + I_H; it += NGW) {
            int r = it;
            if (r < I_IN) { const int kb = r / 144, c = 64 * (r % 144); const int d = win_row(c);
                p0_transpose64(w_in, INCOLS, 64 * kb, c, WT_IN, 1024, d, 0, scrb, F.lane); continue; } r -= I_IN;
            if (r < I_B) { p0_transpose64(w_bh, 1024, 64 * (r / 16), 64 * (r % 16), WT_CAT, 2048, 64 * (r % 16), 0, scrb, F.lane); continue; } r -= I_B;
            if (r < I_B) { p0_transpose64(w_ba, 1024, 64 * (r / 16), 64 * (r % 16), WT_CAT, 2048, 64 * (r % 16), 1024, scrb, F.lane); continue; } r -= I_B;
            if (r < I_B) { p0_transpose64(w_out, 1024, 64 * (r / 16), 64 * (r % 16), WT_OUT, 1024, 64 * (r % 16), 0, scrb, F.lane); continue; } r -= I_B;
            rms_row_to_bf16(x + (size_t)(2 * r) * DM, attn_g, HB + (size_t)(2 * r) * DM, F.lane);
            rms_row_to_bf16(x + (size_t)(2 * r + 1) * DM, attn_g, HB + (size_t)(2 * r + 1) * DM, F.lane);
        }
#if PROBE_P0 & 1
        for (int m = gw; m < MTOK; m += NGW) rms_row_to_bf16(x + (size_t)m * DM, attn_g, HB + (size_t)m * DM, F.lane);
#endif
#if PROBE_P0 & 2
        for (int it = gw; it < I_IN; it += NGW) { const int r = it, kb = r / 144, c = 64 * (r % 144); const int d = win_row(c);
            p0_transpose64(w_in, INCOLS, 64 * kb, c, WT_IN, 1024, d, 0, scrb, F.lane); }
#endif
        { const int gt = blockIdx.x * (NWAVES * 64) + F.tid; if (gt < 1024) LB[gt] = 1.f / (1.f + __expf(lb_gamma[1024 + gt] - lb_gamma[gt])); }
        if (BOTH(0)) GRID_BAR();
        TEND(0);
    }
#if (PROBE_DUP >> 0) & 1
    }
#endif
#if (PROBE_DUP >> 2) & 1
    for (int rep_2 = 0; rep_2 < 2; ++rep_2) {
#endif
#if (PROBE_DUP >> 1) & 1
    for (int rep_1 = 0; rep_1 < 2; ++rep_1) {
#endif
    if (IN(1)) { TSTART(1);
        pg8::Gemm g{HB, WT_IN, MTOK, 3072, 1024}; pg8::StaticOrder S; S.init(MTOK, 3072, F.G, (int)blockIdx.x, MK_WGM_P1B);
        pg8::EpiProj E{0, QQ, AK, AV, HLF, HSG, GATES, KMEAN, KMEANB, LB, q_g, k_g, (PG8_LAS unsigned char*)(F.lds + EPI_SCR_OFF)};
        pg8::gemm_phase<pg8::EpiProj, pg8::StaticOrder, true, MK_SP2>(F.lds + RING_OFF, g, S, E);
        if (BOTH(1)) GRID_BAR();
        TEND(1);
    }
#if (PROBE_DUP >> 1) & 1
    }
#endif
#if (PROBE_DUP >> 11) & 1
    {
        pg8::Gemm g{HB, WT_IN, MTOK, 2048, 1024}; pg8::StaticOrder S; S.init(MTOK, 2048, F.G, (int)blockIdx.x);
        pg8::EpiPlain E{(bf16*)(ws + WS_HLF), 2048};
        pg8::gemm_phase<pg8::EpiPlain, pg8::StaticOrder, true, MK_SP2>(F.lds + RING_OFF, g, S, E);
        GRID_BAR();
    }
#endif
#if (PROBE_DUP >> 12) & 1
    {
        pg8::Gemm g{HB, WT_IN, MTOK, 1024, 1024}; pg8::StaticOrder S; S.init(MTOK, 1024, F.G, (int)blockIdx.x);
        pg8::EpiPlain E{(bf16*)(ws + WS_HLF), 2048};
        pg8::gemm_phase<pg8::EpiPlain, pg8::StaticOrder, true, MK_SP2>(F.lds + RING_OFF, g, S, E);
        GRID_BAR();
    }
#endif
#if (PROBE_DUP >> 13) & 1
    {
        pg8::Gemm g{HB, WT_IN, MTOK, 1024, 1024}; pg8::StaticOrder S; S.init(MTOK, 1024, F.G, (int)blockIdx.x);
        pg8::EpiProj E{0, QQ, AK, AV, HLF, HSG, GATES, KMEAN, KMEANB, LB, q_g, k_g, (PG8_LAS unsigned char*)(F.lds + EPI_SCR_OFF)};
        pg8::gemm_phase<pg8::EpiProj, pg8::StaticOrder, true, MK_SP2>(F.lds + RING_OFF, g, S, E);
        GRID_BAR();
    }
#endif
#if (PROBE_DUP >> 14) & 1
    {
        pg8::Gemm g{HB, WT_IN, MTOK, 3072, 1024}; pg8::StaticOrder S; S.init(MTOK, 3072, F.G, (int)blockIdx.x);
        pg8::EpiProj E{0, QQ, AK, AV, HLF, HSG, GATES, KMEAN, KMEANB, LB, q_g, k_g, (PG8_LAS unsigned char*)(F.lds + EPI_SCR_OFF)};
        pg8::gemm_phase<pg8::EpiProj, pg8::StaticOrder, true, MK_SP2>(F.lds + RING_OFF, g, S, E);
        GRID_BAR();
    }
#endif
#if (PROBE_DUP >> 15) & 1
    {
        pg8::Gemm g{HB, WT_IN, MTOK, 3072, 1024}; pg8::StaticOrder S; S.init(MTOK, 3072, F.G, (int)blockIdx.x);
        pg8::EpiPlain E{(bf16*)(ws + WS_HLF), 4096};
        pg8::gemm_phase<pg8::EpiPlain, pg8::StaticOrder, true, MK_SP2>(F.lds + RING_OFF, g, S, E);
        GRID_BAR();
    }
#endif
    if (IN(2)) { TSTART(2);
#if MK_NAIVE_ATTN
        { const int half = F.tid >> 8, ht = F.tid & 255; LAS float* sm = (LAS float*)(F.lds + RING_OFF) + half * 2048;
          const int total = BATCH * NH * SEQ, iters = (total + 2 * F.G - 1) / (2 * F.G);
          for (int i = 0; i < iters; ++i) { int r = i * 2 * F.G + blockIdx.x * 2 + half; const bool act = r < total; if (!act) r = total - 1;
              naive_attn_row(r, act, ht, sm, AK, AV, QQ, KMEAN, rel_tab); } }
#else
        {
            moba::Seam S;
            for (int L = F.vcu; L < BATCH * NH * 8; L += F.G) {
                const int bh = L >> 3, xq = L & 7, bb = bh / NH, hh = bh % NH;
                const bf16* kbase = AK + (size_t)bb * SEQ * 1024 + hh * 128; const bf16* vbase = AV + (size_t)bb * SEQ * 1024 + hh * 128;
                bf16* q0 = QQ + ((size_t)bb * SEQ + xq * 256) * 2048 + 1024 + hh * 128; bf16* q1 = QQ + ((size_t)bb * SEQ + (15 - xq) * 256) * 2048 + 1024 + hh * 128;
                const moba::BlockRef c0{q0, kbase, vbase, q0, KMEANB + (size_t)bh * NBLK * HD, rel_tab + hh, q_g, k_g, xq * 256};
                const moba::BlockRef c1{q1, kbase, vbase, q1, KMEANB + (size_t)bh * NBLK * HD, rel_tab + hh, q_g, k_g, (15 - xq) * 256};
                moba::moba_prime(MK_ATT_HEAVY_FIRST ? c1 : c0, (char*)lds + RING_OFF, S);
#pragma unroll 1

#if MK_ATT_HEAVY_FIRST
                for (int pass = 0; pass < 2; ++pass) { const moba::BlockRef cu = pass ? c0 : c1; moba::moba_block(cu, c0, (char*)lds + RING_OFF, S); }
#else
                for (int pass = 0; pass < 2; ++pass) { const moba::BlockRef cu = pass ? c1 : c0; moba::moba_block(cu, c1, (char*)lds + RING_OFF, S); }
#endif
            }
        }
#endif
        if (BOTH(2)) GRID_BAR();
        TEND(2);
    }
#if (PROBE_DUP >> 2) & 1
    }
#endif
#if (PROBE_DUP >> 3) & 1
    for (int rep_3 = 0; rep_3 < 2; ++rep_3) {
#endif
    if (IN(3)) { TSTART(3);
        pg8::Gemm g{HB, WT_IN + (size_t)3072 * 1024, MTOK, 6144, 1024}; pg8::StaticOrder S; S.init(MTOK, 6144, F.G, (int)blockIdx.x, MK_WGM_P1A);
        pg8::EpiProj E{1, QQ, AK, AV, HLF, HSG, GATES, KMEAN, KMEANB, LB, q_g, k_g, (PG8_LAS unsigned char*)(F.lds + EPI_SCR_OFF)};
        pg8::gemm_phase<pg8::EpiProj, pg8::StaticOrder, MK_ALIGN_P1A, MK_SP2>(F.lds + RING_OFF, g, S, E);
        if (BOTH(3)) GRID_BAR();
        TEND(3);
    }
#if (PROBE_DUP >> 3) & 1
    }
#endif
#if (PROBE_DUP >> 4) & 1
    for (int rep_4 = 0; rep_4 < 2; ++rep_4) {
#endif
    if (IN(4)) { TSTART(4);
        constexpr int I_G = 16 * 44, I_D = 44 * 16;
        const bool down_later = (F.G == 256);
        for (int it = gw; it < 2 * I_G + (down_later ? 0 : I_D); it += NGW) {
            int r = it;
            if (r < 2 * I_G) { const int up = r >= I_G; if (up) r -= I_G; const int kb = r / 44, c = 64 * (r % 44);
                p0_transpose64(up ? w_up : w_gate, DFF, 64 * kb, c, WT_FIN, 1024, 256 * (c / 128) + (c % 128) + (up ? 128 : 0), 0, scrb, F.lane, ffn_g); continue; } r -= 2 * I_G;
            p0_transpose64(w_down, 1024, 64 * (r / 16), 64 * (r % 16), WT_DOWN, DFF, 64 * (r % 16), 0, scrb, F.lane);
        }
#if !MK_NAIVE_HGRN
        __syncthreads();
        {
#if MK_HG2A
          namespace hga = hg2;
#else
          namespace hga = hgrn;
#endif
          const hga::Ptrs HP{QQ, AK, AV, HLF, HSG};
          for (int L = F.vcu; L < BATCH * NH * 8; L += F.G) { const int bh = L >> 3, gg = L & 7;
        if (PROBE_T == 34) pt0 = __builtin_amdgcn_s_memrealtime();
              hga::run_item<false>((char*)lds + RING_OFF, HP, QQ, hg_out_g, LST, DST, L, gg, (size_t)(bh / NH) * SEQ + gg * 512, bh % NH); } }
        if (PROBE_T == 24 || PROBE_T == 34) pt1 = __builtin_amdgcn_s_memrealtime();
#endif
        if (BOTH(4)) GRID_BAR();
        TEND(4);
    }
#if (PROBE_DUP >> 4) & 1
    }
#endif
    if (IN(5)) { TSTART(5);
#if MK_NAIVE_HGRN
        if (blockIdx.x < 8) {
            const int grp = F.tid >> 7, v = F.tid & 127, bh = blockIdx.x * 4 + grp, h = bh % NH, b = bh / NH; const float g = hg_out_g[v];
            LAS float* qs = (LAS float*)(F.lds + RING_OFF) + grp * 512; LAS float* ks = qs + 128; LAS float* fs = qs + 256; LAS float* red = qs + 384;
            float S[128];
#pragma unroll
            for (int k = 0; k < 128; ++k) S[k] = 0.f;
            for (int t = 0; t < SEQ; ++t) { const size_t m = (size_t)b * SEQ + t;
                qs[v] = bf2f(QQ[m * 2048 + h * 128 + v]); ks[v] = bf2f(AK[m * 1024 + h * 128 + v]);
                { const unsigned short hb = HLF[m * 1024 + h * 128 + v]; _Float16 hf = __builtin_bit_cast(_Float16, hb); fs[v] = exp2f((float)hf); }
                const float vv = bf2f(AV[m * 1024 + h * 128 + v]), sg = bf2f(HSG[m * 1024 + h * 128 + v]);
                __syncthreads();
                float o = 0.f;
#pragma unroll
                for (int k = 0; k < 128; ++k) { S[k] = fs[k] * S[k] + ks[k] * vv; o += qs[k] * S[k]; }
                const float ss = wave_sum(o * o); if ((v & 63) == 0) red[v >> 6] = ss;
                __syncthreads();
                const float rstd = 1.f / sqrtf((red[0] + red[1]) * (1.f / 128.f) + NORM_EPS);
                QQ[m * 2048 + h * 128 + v] = (bf16)f2bf(o * rstd * g * sg);
            }
        }
#else
        {
#if MK_HG2B
          namespace hgb = hg2;
#else
          namespace hgb = hgrn;
#endif
          const hgb::Ptrs HP{QQ, AK, AV, HLF, HSG};
          for (int L = F.vcu; L < BATCH * NH * 8; L += F.G) { const int bh = L >> 3, gg = L & 7;
#if defined(DBG_MIX)
              if (!(DBG_MIX)) { const hgrn::Ptrs HP1{QQ, AK, AV, HLF, HSG}; hgrn::run_item<true>((char*)lds + RING_OFF, HP1, QQ, hg_out_g, LST, DST, L, gg, (size_t)(bh / NH) * SEQ + gg * 512, bh % NH); } else
#endif
              hgb::run_item<true>((char*)lds + RING_OFF, HP, QQ, hg_out_g, LST, DST, L, gg, (size_t)(bh / NH) * SEQ + gg * 512, bh % NH); } }
        if (PROBE_T == 25) pt1 = __builtin_amdgcn_s_memrealtime();
#endif
        if (BOTH(5)) GRID_BAR();
        TEND(5);
    }
#if (PROBE_DUP >> 6) & 1
    for (int rep_6 = 0; rep_6 < 2; ++rep_6) {
#endif
    if (IN(6)) { TSTART(6);
        pg8::Gemm g{QQ, WT_CAT, MTOK, 1024, 2048}; pg8::StaticOrder S; S.init(MTOK, 1024, F.G, (int)blockIdx.x, MK_WGM_1U);
        pg8::EpiMerge E{GATES, MERGED};
        pg8::gemm_phase<pg8::EpiMerge, pg8::StaticOrder, MK_ALIGN_1U, MK_SP2>(F.lds + RING_OFF, g, S, E);
        if (BOTH(6)) GRID_BAR();
        TEND(6);
    }
#if (PROBE_DUP >> 6) & 1
    }
#endif
#if (PROBE_DUP >> 7) & 1
    for (int rep_7 = 0; rep_7 < 2; ++rep_7) {
#endif
    if (IN(7)) { TSTART(7);
        pg8::Gemm g{MERGED, WT_OUT, MTOK, 1024, 1024}; pg8::StaticOrder S; S.init(MTOK, 1024, F.G, (int)blockIdx.x, MK_WGM_1U);
        pg8::EpiOut E{x, X1B, SSQ};
        pg8::gemm_phase<pg8::EpiOut, pg8::StaticOrder, MK_ALIGN_1U, MK_SP2>(F.lds + RING_OFF, g, S, E);
        if (BOTH(7)) GRID_BAR();
        TEND(7);
    }
#if (PROBE_DUP >> 7) & 1
    }
#endif
#if (PROBE_DUP >> 8) & 1
    for (int rep_8 = 0; rep_8 < 2; ++rep_8) {
#endif
    if (IN(8)) { TSTART(8);
        pg8::Gemm g{X1B, WT_FIN, MTOK, 2 * DFF, 1024}; pg8::StaticOrder S; S.init(MTOK, 2 * DFF, F.G, (int)blockIdx.x, MK_WGM_P8);
        pg8::EpiFfnIn E{SSQ, ACT};
        pg8::gemm_phase<pg8::EpiFfnIn, pg8::StaticOrder, MK_ALIGN_P8, MK_SP2>(F.lds + RING_OFF, g, S, E);
        if (F.G == 256 && blockIdx.x >= 128) {
            for (int it = ((int)blockIdx.x - 128) * NWAVES + F.wave; it < 44 * 16; it += 128 * NWAVES)
                p0_transpose64(w_down, 1024, 64 * (it / 16), 64 * (it % 16), WT_DOWN, DFF, 64 * (it % 16), 0, scrb, F.lane);
        }
        if (BOTH(8)) GRID_BAR();
        TEND(8);
    }
#if (PROBE_DUP >> 8) & 1
    }
#endif
#if (PROBE_DUP >> 9) & 1
    for (int rep_9 = 0; rep_9 < 2; ++rep_9) {
#endif
    if (IN(9)) { TSTART(9);
        pg8::Gemm g{ACT, WT_DOWN, MTOK, 1024, DFF}; pg8::StaticOrder S; S.init(MTOK, 1024, F.G, (int)blockIdx.x, MK_WGM_1U);
        pg8::EpiDown E{X1B, args.out};
        pg8::gemm_phase<pg8::EpiDown, pg8::StaticOrder, MK_ALIGN_1U, MK_SP2>(F.lds + RING_OFF, g, S, E);
        TEND(9);
    }
#if (PROBE_DUP >> 9) & 1
    }
#endif
    if ((PROBE_DUP >> 10) & 1) { for (int e = 0; e < 10; ++e) GRID_BAR(); }
    if (PROBE_T >= 0 && blockIdx.x == PROBE_BLK && F.tid == 0) { const unsigned long long tgt = __builtin_amdgcn_s_memrealtime() + 4ull * (pt1 - pt0); while (__builtin_amdgcn_s_memrealtime() < tgt) __builtin_amdgcn_s_sleep(16); }
#undef IN
#undef BOTH
#undef GRID_BAR
}

extern "C" void kernel_launch(void* const* d_in, const int* in_sizes, int n_in, void* d_out, int out_size, void* d_ws, size_t ws_size, hipStream_t stream) {
    static int grid = 0;
    if (grid == 0) {
        if (n_in != 15 || in_sizes[0] != MTOK * DM || out_size != MTOK * DM || ws_size < WS_END) {
            fprintf(stderr, "kernel_launch: shape/workspace mismatch (n_in %d, in0 %d, out %d, ws %zu); nothing launched\n", n_in, n_in > 0 ? in_sizes[0] : -1, out_size, ws_size); grid = -1; return; }
        int dev = 0, cus = 0, per_cu = 0;
        if (hipGetDevice(&dev) != hipSuccess || hipDeviceGetAttribute(&cus, hipDeviceAttributeMultiprocessorCount, dev) != hipSuccess) { grid = -1; return; }
        if (hipFuncSetAttribute((const void*)mk_fwd, hipFuncAttributeMaxDynamicSharedMemorySize, LDS_BYTES) != hipSuccess) { fprintf(stderr, "kernel_launch: hipFuncSetAttribute failed\n"); grid = -1; return; }
        if (hipOccupancyMaxActiveBlocksPerMultiprocessor(&per_cu, (const void*)mk_fwd, NWAVES * 64, LDS_BYTES) != hipSuccess || per_cu < 1) { fprintf(stderr, "kernel_launch: occupancy query says %d\n", per_cu); per_cu = 1; }
        (void)hipGetLastError();
        grid = cus;
    }
    if (grid < 0) return;
    (void)hipMemsetAsync((char*)d_ws + WS_CTL, 0, CTL_ZERO_BYTES, stream);
    Args a{};
    for (int i = 0; i < 15; ++i) a.in[i] = (const float*)d_in[i];
    a.out = (float*)d_out; a.ws = (unsigned char*)d_ws;
    unsigned char* ws = (unsigned char*)d_ws;
#define FRAME(lo_, hi_) do { a.ph_lo = (lo_); a.ph_hi = (hi_); hipLaunchKernelGGL(mk_fwd, dim3(grid), dim3(NWAVES * 64), LDS_BYTES, stream, a); } while (0)
    FRAME(0, 10);
#undef FRAME
    const hipError_t le = hipPeekAtLastError();
    if (le != hipSuccess) fprintf(stderr, "kernel_launch: launch failed: %s\n", hipGetErrorName(le));
}
```

```cpp
#include <hip/hip_runtime.h>
#include <cstdio>
#include <cstdint>

#ifndef MK_ATT_QS
#define MK_ATT_QS 1
#endif
constexpr int BATCH = 4, SEQ = 4096, DM = 1024, MTOK = BATCH * SEQ;
constexpr int NH = 8, HD = 128;
constexpr int DFF = 2816, INCOLS = 9216;
constexpr int MBLK = 256, NBLK = SEQ / MBLK, TOPK = 3;
constexpr float NORM_EPS = 1e-6f;
constexpr float ATT_SCALE = 0.08838834764831845f;
constexpr float LOG2E = 1.4426950408889634f;


namespace pg8 {
#define PG8_LAS __attribute__((address_space(3)))
typedef unsigned short bf16_t;
typedef short bf16x8 __attribute__((ext_vector_type(8)));
typedef float f32x4 __attribute__((ext_vector_type(4)));
typedef unsigned u32x4 __attribute__((ext_vector_type(4)));
constexpr int BM = 256, BK = 64, HALF = 128, HTB = HALF * BK * 2  , STAGE_BYTES = 8 * HTB, NXCD = 8;

__host__ __device__ __forceinline__ int lds_byte(int r, int c) { const int st = (r >> 4) * 2 + (c >> 5), rr = r & 15, cc = c & 31, ob = rr * 64 + cc * 2; return st * 1024 + (ob ^ (((ob >> 9) & 1) << 5)); }
__host__ __device__ __forceinline__ void stage_rc(int b, int& R, int& C) { const int st = b / 1024, sb = b % 1024, swz = sb ^ (((sb >> 9) & 1) << 5); R = (st >> 1) * 16 + swz / 64; C = (st & 1) * 32 + (swz % 64) / 2; }
__host__ __device__ __forceinline__ int perm32(int rho) { const int n = rho >> 4, i = rho & 15; return 8 * (i >> 2) + 4 * n + (i & 3); }

struct Unit { int pm, pn; };
struct Gemm { const bf16_t* A; const bf16_t* Bt; int M, N, K; };

struct StaticOrder {
    int nM, nN, nwg, G, c, WGM;
    __host__ __device__ void init(int M, int N, int G_, int c_, int wgm = 4) { nM = M / BM; nN = N / BM; nwg = nM * nN; G = G_; c = c_; WGM = wgm; }
    __host__ __device__ bool next(int i, Unit& u) const {
        const long L = (long)i * G + c; if (L >= nwg) return false;
        int wgid = (int)L; { const int q = nwg / NXCD, r = nwg % NXCD, xcd = wgid % NXCD, off = wgid / NXCD; wgid = (xcd < r ? xcd * (q + 1) : r * (q + 1) + (xcd - r) * q) + off; }
        const int nig = WGM * nN, gid = wgid / nig, fm = gid * WGM, gsz = (nM - fm) < WGM ? (nM - fm) : WGM;
        u.pm = fm + ((wgid % nig) % gsz); u.pn = (wgid % nig) / gsz; return true;
    }
    __device__ __forceinline__ void a_ready(const Unit&) const {}
    __device__ __forceinline__ void done(const Unit&) const {}
};

__device__ __forceinline__ unsigned cvt_pk_bf16(float lo, float hi) { unsigned r; asm volatile("v_cvt_pk_bf16_f32 %0, %1, %2" : "=v"(r) : "v"(lo), "v"(hi)); return r; }
typedef float f32x2 __attribute__((ext_vector_type(2)));

typedef unsigned u32x2 __attribute__((ext_vector_type(2)));
typedef _Float16 f16x8 __attribute__((ext_vector_type(8)));
__device__ __forceinline__ float bf2f(unsigned short b) { return __uint_as_float((unsigned)b << 16); }
__device__ __forceinline__ u32x4 pack8bf(f32x4 a, f32x4 b) { u32x4 w; w.x = cvt_pk_bf16(a[0], a[1]); w.y = cvt_pk_bf16(a[2], a[3]); w.z = cvt_pk_bf16(b[0], b[1]); w.w = cvt_pk_bf16(b[2], b[3]); return w; }
__device__ __forceinline__ void unpack8bf(u32x4 w, f32x4& a, f32x4& b) {
    a[0] = __uint_as_float(w.x << 16); a[1] = __uint_as_float(w.x & 0xffff0000u); a[2] = __uint_as_float(w.y << 16); a[3] = __uint_as_float(w.y & 0xffff0000u);
    b[0] = __uint_as_float(w.z << 16); b[1] = __uint_as_float(w.z & 0xffff0000u); b[2] = __uint_as_float(w.w << 16); b[3] = __uint_as_float(w.w & 0xffff0000u); }
__device__ __forceinline__ float fsigmoid(float x) { return __builtin_amdgcn_rcpf(1.f + __builtin_amdgcn_exp2f(-x * 1.4426950408889634f)); }
template <int CTRL> __device__ __forceinline__ float dpp_mov(float v) { return __int_as_float(__builtin_amdgcn_update_dpp(0, __float_as_int(v), CTRL, 0xf, 0xf, true)); }
__device__ __forceinline__ float row16_sum(float s) { s += dpp_mov<0xB1>(s); s += dpp_mov<0x4E>(s); s += dpp_mov<0x141>(s); s += dpp_mov<0x140>(s); return s; }
__device__ __forceinline__ float rows4_sum(float s) {
    auto r16 = __builtin_amdgcn_permlane16_swap(__float_as_uint(s), __float_as_uint(s), false, false);
    const float pr = __uint_as_float(r16[0]) + __uint_as_float(r16[1]);
    auto r32 = __builtin_amdgcn_permlane32_swap(__float_as_uint(pr), __float_as_uint(pr), false, false);
    return __uint_as_float(r32[0]) + __uint_as_float(r32[1]);
}
#define PG8_EPI_BAR() do { asm volatile("s_waitcnt lgkmcnt(0)" ::: "memory"); __builtin_amdgcn_s_barrier(); asm volatile("" ::: "memory"); } while (0)

struct EpiProj {
    static constexpr bool PERM = true, AFTER_DRAIN = false, MIDK = false;
    int mode;
    bf16_t* QQ; bf16_t* AK; bf16_t* AV; unsigned short* HLF; bf16_t* HSG; bf16_t* GATES; float* KMEAN; bf16_t* KMEANB;
    const float* lb; const float* qg; const float* kg;
    PG8_LAS unsigned char* scr;
    __device__ __forceinline__ void midk(f32x4 (&)[2][2][4][2], const Unit&, int, int, int, int) const {}
    __device__ __forceinline__ void operator()(const f32x4 (&acc)[2][2][4][2], const Unit& u, int wr, int wc, int fr, int fq) const {
        const int row0 = u.pm * BM + wr * 64 + fr;
        const int cw = wc * 32 + 8 * fq;
        int kind, c0;
        if (mode == 0) { kind = u.pn >> 2; c0 = (u.pn & 3) * 256; }
        else if (u.pn < 16) { kind = 3 + (u.pn >> 2); c0 = (u.pn & 3) * 256; }
        else { kind = 7; c0 = (u.pn - 16) * 256; }
        if (kind <= 1) {
            PG8_LAS float* P = (PG8_LAS float*)scr; PG8_LAS float* CS = (PG8_LAS float*)(scr + 8192);
#pragma unroll
            for (int ai = 0; ai < 2; ++ai)
#pragma unroll
                for (int m = 0; m < 4; ++m)
#pragma unroll
                    for (int bj = 0; bj < 2; ++bj) { const f32x4 a = acc[ai][bj][m][0], b = acc[ai][bj][m][1];
                        float s = (a[0] * a[0] + a[1] * a[1]) + (a[2] * a[2] + a[3] * a[3]) + (b[0] * b[0] + b[1] * b[1]) + (b[2] * b[2] + b[3] * b[3]);
                        s = rows4_sum(s);
                        if (fq == 0) P[((ai * 128 + wr * 64 + m * 16 + fr) * 2 + bj) * 4 + wc] = s; }
            PG8_EPI_BAR();
            const float* gp = (kind == 0 ? qg : kg) + cw;
            const float qsc = (kind == 0 && MK_ATT_QS) ? 1.4426950408889634f * ATT_SCALE : 1.f;
            const f32x4 g0 = *(const f32x4*)gp * qsc, g1 = *(const f32x4*)(gp + 4) * qsc;
            f32x4 cs[2][2];
#pragma unroll
            for (int bj = 0; bj < 2; ++bj) { cs[bj][0] = (f32x4){0.f, 0.f, 0.f, 0.f}; cs[bj][1] = (f32x4){0.f, 0.f, 0.f, 0.f}; }
            bf16_t* dst = (kind == 0) ? (QQ + 1024 + c0 + cw) : (AK + c0 + cw); const int ld = (kind == 0) ? 2048 : 1024;
#pragma unroll
            for (int ai = 0; ai < 2; ++ai)
#pragma unroll
                for (int m = 0; m < 4; ++m) { const int row = row0 + ai * 128 + m * 16;
#pragma unroll
                    for (int bj = 0; bj < 2; ++bj) { const f32x4 p4 = *(const PG8_LAS f32x4*)&P[((ai * 128 + wr * 64 + m * 16 + fr) * 2 + bj) * 4];
                        const float rstd = __builtin_amdgcn_rsqf(((p4[0] + p4[1]) + (p4[2] + p4[3])) * (1.f / 128.f) + NORM_EPS);
                        const f32x4 y0 = acc[ai][bj][m][0] * rstd * g0, y1 = acc[ai][bj][m][1] * rstd * g1;
                        cs[bj][0] += y0; cs[bj][1] += y1;
                        *(u32x4*)(dst + (size_t)row * ld + bj * 128) = pack8bf(y0, y1); } }
            if (kind == 1) {
#pragma unroll
                for (int bj = 0; bj < 2; ++bj)
#pragma unroll
                    for (int n = 0; n < 2; ++n)
#pragma unroll
                        for (int j = 0; j < 4; ++j) { const float v = row16_sum(cs[bj][n][j]);
                            if (fr == 0) CS[wr * 256 + bj * 128 + cw + 4 * n + j] = v; }
                PG8_EPI_BAR();
                const int t = threadIdx.x;
                if (t < 256) { const float km = (CS[t] + CS[256 + t]) * (1.f / 256.f);
                    const int bb = u.pm >> 4, nb = u.pm & 15, head = (c0 + t) >> 7, d = t & 127;
                    const size_t o = ((size_t)((bb * NH + head) * NBLK + nb)) * HD + d;
                    KMEAN[o] = km; KMEANB[o] = (bf16_t)(cvt_pk_bf16(km, 0.f) & 0xffffu); }
            }
            return;
        }
        if (kind == 4) {
#pragma unroll
            for (int bj = 0; bj < 2; ++bj) { const int col = c0 + bj * 128 + cw;
                const f32x4 l0 = *(const f32x4*)(lb + col), l1 = *(const f32x4*)(lb + col + 4);
#pragma unroll
                for (int ai = 0; ai < 2; ++ai)
#pragma unroll
                    for (int m = 0; m < 4; ++m) { const int row = row0 + ai * 128 + m * 16;
                        f32x4 k0, k1; f16x8 lf;
#pragma unroll
                        for (int j = 0; j < 4; ++j) { const float ka = (1.f - l0[j]) * fsigmoid(-acc[ai][bj][m][0][j]), kb = (1.f - l1[j]) * fsigmoid(-acc[ai][bj][m][1][j]);
                            k0[j] = ka; k1[j] = kb; lf[j] = (_Float16)__builtin_amdgcn_logf(1.f - ka); lf[4 + j] = (_Float16)__builtin_amdgcn_logf(1.f - kb); }
                        *(u32x4*)(AK + (size_t)row * 1024 + col) = pack8bf(k0, k1);
                        *(f16x8*)(HLF + (size_t)row * 1024 + col) = lf; } }
            return;
        }
        if (kind == 7) {
            bf16_t* RT = GATES + (c0 >> 1) + cw; bf16_t* G1 = RT + (size_t)MTOK * 1024;
#pragma unroll
            for (int ai = 0; ai < 2; ++ai)
#pragma unroll
                for (int m = 0; m < 4; ++m) { const int row = row0 + ai * 128 + m * 16; f32x4 r0, r1, s0, s1;
#pragma unroll
                    for (int j = 0; j < 4; ++j) { const float e0a = __builtin_amdgcn_exp2f(-acc[ai][0][m][0][j] * 1.4426950408889634f), e1a = __builtin_amdgcn_exp2f(-acc[ai][1][m][0][j] * 1.4426950408889634f);
                        const float e0b = __builtin_amdgcn_exp2f(-acc[ai][0][m][1][j] * 1.4426950408889634f), e1b = __builtin_amdgcn_exp2f(-acc[ai][1][m][1][j] * 1.4426950408889634f);
                        r0[j] = (1.f + e1a) * __builtin_amdgcn_rcpf(1.f + e0a); r1[j] = (1.f + e1b) * __builtin_amdgcn_rcpf(1.f + e0b);
                        s0[j] = __builtin_amdgcn_rcpf(1.f + e1a); s1[j] = __builtin_amdgcn_rcpf(1.f + e1b); }
                    *(u32x4*)(RT + (size_t)row * 1024) = pack8bf(r0, r1); *(u32x4*)(G1 + (size_t)row * 1024) = pack8bf(s0, s1); }
            return;
        }
        bf16_t* dst; int ld;
        if (kind == 2) { dst = AV; ld = 1024; } else if (kind == 3) { dst = QQ; ld = 2048; } else if (kind == 5) { dst = AV; ld = 1024; } else { dst = HSG; ld = 1024; }
        dst += c0 + cw;
#pragma unroll
        for (int ai = 0; ai < 2; ++ai)
#pragma unroll
            for (int m = 0; m < 4; ++m) { const int row = row0 + ai * 128 + m * 16;
#pragma unroll
                for (int bj = 0; bj < 2; ++bj) { f32x4 v0 = acc[ai][bj][m][0], v1 = acc[ai][bj][m][1];
                    if (kind == 3) { v0 = v0 * ATT_SCALE; v1 = v1 * ATT_SCALE; }
                    else if (kind == 6) {
#pragma unroll
                        for (int j = 0; j < 4; ++j) { v0[j] = v0[j] * fsigmoid(v0[j]); v1[j] = v1[j] * fsigmoid(v1[j]); } }
                    *(u32x4*)(dst + (size_t)row * ld + bj * 128) = pack8bf(v0, v1); } }
    }
};

struct EpiPlain {
    static constexpr bool PERM = true, AFTER_DRAIN = false, MIDK = false;
    bf16_t* O; int ldc;
    __device__ __forceinline__ void midk(f32x4 (&)[2][2][4][2], const Unit&, int, int, int, int) const {}
    __device__ __forceinline__ void operator()(const f32x4 (&acc)[2][2][4][2], const Unit& u, int wr, int wc, int fr, int fq) const {
        const int row0 = u.pm * BM + wr * 64 + fr, col0 = u.pn * BM + wc * 32 + 8 * fq;
#pragma unroll
        for (int ai = 0; ai < 2; ++ai)
#pragma unroll
            for (int m = 0; m < 4; ++m) { bf16_t* rowp = O + (size_t)(row0 + ai * 128 + m * 16) * ldc + col0;
#pragma unroll
                for (int bj = 0; bj < 2; ++bj) *(u32x4*)(rowp + bj * 128) = pack8bf(acc[ai][bj][m][0], acc[ai][bj][m][1]); }
    }
};

struct EpiMerge {
    static constexpr bool PERM = true, AFTER_DRAIN = false, MIDK = true;
    const bf16_t* G; bf16_t* O;
    __device__ __forceinline__ void midk(f32x4 (&acc)[2][2][4][2], const Unit& u, int wr, int wc, int fr, int fq) const {
        int row0 = u.pm * BM + wr * 64 + fr, col0 = u.pn * BM + wc * 32 + 8 * fq;
        asm volatile("" : "+v"(row0), "+v"(col0));
#pragma unroll
        for (int ai = 0; ai < 2; ++ai)
#pragma unroll
            for (int m = 0; m < 4; ++m) { const bf16_t* gp = G + (size_t)(row0 + ai * 128 + m * 16) * 1024 + col0;
#pragma unroll
                for (int bj = 0; bj < 2; ++bj) { const u32x4 w0 = *(const u32x4*)(gp + bj * 128); f32x4 a0, a1; unpack8bf(w0, a0, a1);
                    acc[ai][bj][m][0] *= a0; acc[ai][bj][m][1] *= a1; }
                asm volatile("" ::: "memory"); }
    }
    __device__ __forceinline__ void operator()(const f32x4 (&acc)[2][2][4][2], const Unit& u, int wr, int wc, int fr, int fq) const {
        const int row0 = u.pm * BM + wr * 64 + fr, col0 = u.pn * BM + wc * 32 + 8 * fq;
#pragma unroll
        for (int ai = 0; ai < 2; ++ai)
#pragma unroll
            for (int m = 0; m < 4; ++m) { const int row = row0 + ai * 128 + m * 16; const bf16_t* gp = G + (size_t)MTOK * 1024 + (size_t)row * 1024 + col0;
#pragma unroll
                for (int bj = 0; bj < 2; ++bj) { const u32x4 w1 = *(const u32x4*)(gp + bj * 128); f32x4 b0, b1; unpack8bf(w1, b0, b1);
                    *(u32x4*)(O + (size_t)row * 1024 + col0 + bj * 128) = pack8bf(acc[ai][bj][m][0] * b0, acc[ai][bj][m][1] * b1); }
                asm volatile("" ::: "memory"); }
    }
};

struct EpiOut {
    static constexpr bool PERM = true, AFTER_DRAIN = false, MIDK = false;
    const float* X; bf16_t* X1B; float* SSQ;
    __device__ __forceinline__ void midk(f32x4 (&)[2][2][4][2], const Unit&, int, int, int, int) const {}
    __device__ __forceinline__ void operator()(const f32x4 (&acc)[2][2][4][2], const Unit& u, int wr, int wc, int fr, int fq) const {
        const int row0 = u.pm * BM + wr * 64 + fr, col0 = u.pn * BM + wc * 32 + 8 * fq;
#pragma unroll
        for (int ai = 0; ai < 2; ++ai)
#pragma unroll
            for (int m = 0; m < 4; ++m) { const int row = row0 + ai * 128 + m * 16; const size_t off = (size_t)row * 1024 + col0; float s = 0.f;
#pragma unroll
                for (int bj = 0; bj < 2; ++bj) { const f32x4 v0 = acc[ai][bj][m][0] + *(const f32x4*)(X + off + bj * 128), v1 = acc[ai][bj][m][1] + *(const f32x4*)(X + off + bj * 128 + 4);
                    s += (v0[0] * v0[0] + v0[1] * v0[1]) + (v0[2] * v0[2] + v0[3] * v0[3]) + (v1[0] * v1[0] + v1[1] * v1[1]) + (v1[2] * v1[2] + v1[3] * v1[3]);
                    *(u32x4*)(X1B + off + bj * 128) = pack8bf(v0, v1); }
                s = rows4_sum(s);
                if (fq == 0) SSQ[(size_t)row * 16 + u.pn * 4 + wc] = s;
                asm volatile("" ::: "memory"); }
    }
};

struct EpiFfnIn {
    static constexpr bool PERM = true, AFTER_DRAIN = false, MIDK = false;
    const float* SSQ; bf16_t* ACT;
    __device__ __forceinline__ void midk(f32x4 (&)[2][2][4][2], const Unit&, int, int, int, int) const {}
    __device__ __forceinline__ void operator()(const f32x4 (&acc)[2][2][4][2], const Unit& u, int wr, int wc, int fr, int fq) const {
        const int row0 = u.pm * BM + wr * 64 + fr, col0 = u.pn * 128 + wc * 32 + 8 * fq;
#pragma unroll
        for (int ai = 0; ai < 2; ++ai)
#pragma unroll
            for (int m = 0; m < 4; ++m) { const int row = row0 + ai * 128 + m * 16; const f32x4* sp = (const f32x4*)(SSQ + (size_t)row * 16);
                const f32x4 s0 = sp[0], s1 = sp[1], s2 = sp[2], s3 = sp[3];
                const float tot = ((s0[0] + s0[1]) + (s0[2] + s0[3])) + ((s1[0] + s1[1]) + (s1[2] + s1[3])) + ((s2[0] + s2[1]) + (s2[2] + s2[3])) + ((s3[0] + s3[1]) + (s3[2] + s3[3]));
                const float rstd = __builtin_amdgcn_rsqf(tot * (1.f / 1024.f) + NORM_EPS);
                f32x4 o0, o1;
#pragma unroll
                for (int j = 0; j < 4; ++j) { const float ga = acc[ai][0][m][0][j] * rstd, gb = acc[ai][0][m][1][j] * rstd;
                    o0[j] = ga * fsigmoid(ga) * (acc[ai][1][m][0][j] * rstd); o1[j] = gb * fsigmoid(gb) * (acc[ai][1][m][1][j] * rstd); }
                *(u32x4*)(ACT + (size_t)row * DFF + col0) = pack8bf(o0, o1);
                asm volatile("" ::: "memory"); }
    }
};

struct EpiDown {
    static constexpr bool PERM = true, AFTER_DRAIN = false, MIDK = false;
    const bf16_t* X1B; float* OUT;
    __device__ __forceinline__ void midk(f32x4 (&)[2][2][4][2], const Unit&, int, int, int, int) const {}
    __device__ __forceinline__ void operator()(const f32x4 (&acc)[2][2][4][2], const Unit& u, int wr, int wc, int fr, int fq) const {
        const int row0 = u.pm * BM + wr * 64 + fr, col0 = u.pn * BM + wc * 32 + 8 * fq;
#pragma unroll
        for (int ai = 0; ai < 2; ++ai)
#pragma unroll
            for (int m = 0; m < 4; ++m) { const size_t off = (size_t)(row0 + ai * 128 + m * 16) * 1024 + col0;
#pragma unroll
                for (int bj = 0; bj < 2; ++bj) { f32x4 r0, r1; unpack8bf(*(const u32x4*)(X1B + off + bj * 128), r0, r1);
                    *(f32x4*)(OUT + off + bj * 128) = acc[ai][bj][m][0] + r0; *(f32x4*)(OUT + off + bj * 128 + 4) = acc[ai][bj][m][1] + r1; }
                asm volatile("" ::: "memory"); }
    }
};


template <class Epi, class Sched, bool ALIGN_EPI = false, bool SP2 = false>
__device__ __forceinline__ void gemm_phase(PG8_LAS unsigned char* lds, const Gemm g, const Sched& S, const Epi& E) {
    int tid = threadIdx.x; asm volatile("" : "+v"(tid));
    const int wid = __builtin_amdgcn_readfirstlane(tid >> 6), lane = tid & 63, wr = wid >> 2, wc = wid & 3, fr = lane & 15, fq = lane >> 4;
    const int K = g.K, nt = K / BK;
    unsigned voffA[2], voffB[2];
#pragma unroll
    for (int i = 0; i < 2; ++i) { int R, C; stage_rc(tid * 16 + i * 8192, R, C); const int Rb = Epi::PERM ? ((R & ~31) + perm32(R & 31)) : R;
        voffA[i] = (unsigned)(R * K + C) * 2u; voffB[i] = (unsigned)(Rb * K + C) * 2u; }
    const size_t kstep = (size_t)(BK * 2);
    const size_t hstep = (size_t)HALF * K * 2;
    const size_t tstep = 2 * hstep;
    const unsigned ldsw = (unsigned)wid * 1024u;
    const int aoff = lds_byte(wr * 64 + fr, fq * 8), boff = lds_byte(wc * 32 + fr, fq * 8);
#define PG8_SA(b, h) (((b) * 2 + (h)) * HTB)
#define PG8_SB(b, h) ((4 + (b) * 2 + (h)) * HTB)
#define PG8_STAGE(bufoff, gbase, voff) do { _Pragma("unroll") for (int _i = 0; _i < 2; ++_i) \
        __builtin_amdgcn_global_load_lds((const unsigned*)((const char*)(gbase) + (voff)[_i]), (PG8_LAS unsigned*)(lds + (bufoff) + ldsw + _i * 8192), 16, 0, 0); } while (0)
#define PG8_LDA(dst, b, h) do { _Pragma("unroll") for (int m = 0; m < 4; ++m) _Pragma("unroll") for (int k = 0; k < 2; ++k) dst[m][k] = *(const PG8_LAS bf16x8*)(lds + PG8_SA(b, h) + aoff + m * 2048 + k * 1024); } while (0)
#define PG8_LDB(dst, b, h) do { _Pragma("unroll") for (int n = 0; n < 2; ++n) _Pragma("unroll") for (int k = 0; k < 2; ++k) dst[n][k] = *(const PG8_LAS bf16x8*)(lds + PG8_SB(b, h) + boff + n * 2048 + k * 1024); } while (0)
#define PG8_MMA(ai, bj, At, Bt) do { __builtin_amdgcn_s_setprio(1); _Pragma("unroll") for (int m = 0; m < 4; ++m) _Pragma("unroll") for (int n = 0; n < 2; ++n) _Pragma("unroll") for (int k = 0; k < 2; ++k) \
        acc[ai][bj][m][n] = __builtin_amdgcn_mfma_f32_16x16x32_bf16(Bt[n][k], At[m][k], acc[ai][bj][m][n], 0, 0, 0); __builtin_amdgcn_s_setprio(0); } while (0)
#define PG8_WAIT_V(n) asm volatile("s_waitcnt vmcnt(" #n ")" ::: "memory")
#define PG8_WAIT_L(n) asm volatile("s_waitcnt lgkmcnt(" #n ")" ::: "memory")
#define PG8_BAR __builtin_amdgcn_s_barrier()
#define PG8_SCHED __builtin_amdgcn_sched_barrier(0)
    Unit cur, nxt; int ui = 0;
    if (!S.next(0, cur)) return;
    f32x4 acc[2][2][4][2];
#pragma unroll
    for (int a = 0; a < 2; ++a)
#pragma unroll
        for (int b = 0; b < 2; ++b)
#pragma unroll
            for (int m = 0; m < 4; ++m)
#pragma unroll
                for (int n = 0; n < 2; ++n) acc[a][b][m][n] = (f32x4){0.f, 0.f, 0.f, 0.f};
    bf16x8 At[4][2], B0[2][2], B1[2][2];
    const char* cA = (const char*)g.A + (size_t)cur.pm * tstep; const char* cB = (const char*)g.Bt + (size_t)cur.pn * tstep;
    S.a_ready(cur);
    if constexpr (SP2) {
        PG8_STAGE(PG8_SB(0, 0), cB, voffB); PG8_STAGE(PG8_SB(0, 1), cB + hstep, voffB); PG8_STAGE(PG8_SA(0, 0), cA, voffA); PG8_STAGE(PG8_SA(0, 1), cA + hstep, voffA);
        if (wr == 1) PG8_BAR;
        PG8_WAIT_V(2); PG8_BAR;
        PG8_STAGE(PG8_SB(1, 0), cB + kstep, voffB); PG8_STAGE(PG8_SA(1, 0), cA + kstep, voffA); PG8_STAGE(PG8_SB(1, 1), cB + hstep + kstep, voffB);
        PG8_WAIT_V(6); PG8_BAR;
    } else {
        PG8_STAGE(PG8_SB(0, 0), cB, voffB); PG8_STAGE(PG8_SA(0, 0), cA, voffA); PG8_STAGE(PG8_SB(0, 1), cB + hstep, voffB); PG8_STAGE(PG8_SA(0, 1), cA + hstep, voffA);
        if (wr == 1) PG8_BAR;
        PG8_WAIT_V(4); PG8_BAR;
        PG8_STAGE(PG8_SB(1, 0), cB + kstep, voffB); PG8_STAGE(PG8_SA(1, 0), cA + kstep, voffA); PG8_STAGE(PG8_SB(1, 1), cB + hstep + kstep, voffB);
        PG8_WAIT_V(6); PG8_BAR;
    }
    for (;;) {
        const bool has_next = S.next(ui + 1, nxt);
        const char* nA = has_next ? (const char*)g.A + (size_t)nxt.pm * tstep : cA; const char* nB = has_next ? (const char*)g.Bt + (size_t)nxt.pn * tstep : cB;
        for (int t = 0; t < nt; t += 2) {
            if constexpr (Epi::MIDK) { if (t == (nt >> 1)) E.midk(acc, cur, wr, wc, fr, fq); }
            const bool last = (t == nt - 2);
            const char* a1 = cA + (size_t)(t + 1) * kstep;
            const char* a2 = last ? nA : cA + (size_t)(t + 2) * kstep; const char* b2 = last ? nB : cB + (size_t)(t + 2) * kstep;
            const char* a3 = a2 + kstep; const char* b3 = b2 + kstep;
            if (last && has_next) S.a_ready(nxt);
            if constexpr (SP2) {
            PG8_LDB(B0, 0, 0); PG8_LDB(B1, 0, 1); PG8_SCHED; PG8_LDA(At, 0, 0); PG8_STAGE(PG8_SA(1, 1), a1 + hstep, voffA);
            PG8_WAIT_V(8); PG8_WAIT_L(0); PG8_BAR; PG8_MMA(0, 0, At, B0); PG8_MMA(0, 1, At, B1); PG8_BAR; PG8_SCHED;
            PG8_LDA(At, 0, 1); PG8_STAGE(PG8_SB(0, 0), b2, voffB); PG8_STAGE(PG8_SB(0, 1), b2 + hstep, voffB); PG8_STAGE(PG8_SA(0, 0), a2, voffA);
            PG8_WAIT_V(8); PG8_WAIT_L(0); PG8_BAR; PG8_MMA(1, 0, At, B0); PG8_MMA(1, 1, At, B1); PG8_BAR; PG8_SCHED;
            PG8_LDB(B0, 1, 0); PG8_LDB(B1, 1, 1); PG8_SCHED; PG8_LDA(At, 1, 0); PG8_STAGE(PG8_SA(0, 1), a2 + hstep, voffA);
            PG8_WAIT_V(8); PG8_WAIT_L(0); PG8_BAR; PG8_MMA(0, 0, At, B0); PG8_MMA(0, 1, At, B1); PG8_BAR; PG8_SCHED;
            PG8_LDA(At, 1, 1); PG8_STAGE(PG8_SB(1, 0), b3, voffB); PG8_STAGE(PG8_SB(1, 1), b3 + hstep, voffB); PG8_STAGE(PG8_SA(1, 0), a3, voffA);
            PG8_WAIT_V(8); PG8_WAIT_L(0); PG8_BAR; PG8_MMA(1, 0, At, B0); PG8_MMA(1, 1, At, B1); PG8_BAR; PG8_SCHED;
            } else {
            PG8_LDB(B0, 0, 0); PG8_SCHED; PG8_LDA(At, 0, 0); PG8_STAGE(PG8_SA(1, 1), a1 + hstep, voffA);
            PG8_WAIT_L(8); PG8_BAR; PG8_WAIT_L(0); PG8_MMA(0, 0, At, B0); PG8_BAR; PG8_SCHED;
            PG8_LDB(B1, 0, 1); PG8_STAGE(PG8_SB(0, 0), b2, voffB);
            PG8_BAR; PG8_WAIT_L(0); PG8_MMA(0, 1, At, B1); PG8_BAR;
            PG8_LDA(At, 0, 1); PG8_STAGE(PG8_SA(0, 0), a2, voffA);
            PG8_BAR; PG8_WAIT_L(0); PG8_MMA(1, 0, At, B0); PG8_BAR; PG8_SCHED;
            PG8_STAGE(PG8_SB(0, 1), b2 + hstep, voffB);
            PG8_WAIT_V(6); PG8_BAR; PG8_MMA(1, 1, At, B1); PG8_BAR;
            PG8_LDB(B0, 1, 0); PG8_SCHED; PG8_LDA(At, 1, 0); PG8_STAGE(PG8_SA(0, 1), a2 + hstep, voffA);
            PG8_WAIT_L(8); PG8_BAR; PG8_WAIT_L(0); PG8_MMA(0, 0, At, B0); PG8_BAR; PG8_SCHED;
            PG8_LDB(B1, 1, 1); PG8_STAGE(PG8_SB(1, 0), b3, voffB);
            PG8_BAR; PG8_WAIT_L(0); PG8_MMA(0, 1, At, B1); PG8_BAR;
            PG8_LDA(At, 1, 1); PG8_STAGE(PG8_SA(1, 0), a3, voffA);
            PG8_BAR; PG8_WAIT_L(0); PG8_MMA(1, 0, At, B0); PG8_BAR; PG8_SCHED;
            PG8_STAGE(PG8_SB(1, 1), b3 + hstep, voffB);
            PG8_WAIT_V(6); PG8_BAR; PG8_MMA(1, 1, At, B1); PG8_BAR;
            }
        }
        if constexpr (ALIGN_EPI) { if (wr == 0) PG8_BAR; }
        if constexpr (!Epi::AFTER_DRAIN) { E(acc, cur, wr, wc, fr, fq); S.done(cur); }
        if (!has_next) break;
#pragma unroll
        for (int a = 0; a < 2; ++a)
#pragma unroll
            for (int b = 0; b < 2; ++b)
#pragma unroll
                for (int m = 0; m < 4; ++m)
#pragma unroll
                    for (int n = 0; n < 2; ++n) acc[a][b][m][n] = (f32x4){0.f, 0.f, 0.f, 0.f};
        cur = nxt; cA = nA; cB = nB; ++ui;
        if constexpr (ALIGN_EPI) { if (wr == 1) PG8_BAR; }
    }
    PG8_WAIT_V(0);
    if constexpr (!ALIGN_EPI) { if (wr == 0) PG8_BAR; }
    PG8_BAR;
    if constexpr (Epi::AFTER_DRAIN) { E.fused(acc, cur, wr, wc, fr, fq, lds, wid, lane); S.done(cur); }
#undef PG8_SA
#undef PG8_SB
#undef PG8_STAGE
#undef PG8_LDA
#undef PG8_LDB
#undef PG8_MMA
#undef PG8_WAIT_V
#undef PG8_WAIT_L
#undef PG8_BAR
#undef PG8_SCHED
}
}

constexpr size_t MiB = 1u << 20;
constexpr size_t WS_CTL = 0, CTL_ZERO_BYTES = 64 * 1024;
constexpr size_t WS_WT_IN = 1 * MiB;
constexpr size_t WS_LST = 1 * MiB, WS_DST = 17 * MiB;
constexpr size_t WS_WT_CAT = 19 * MiB;
constexpr size_t WS_WT_OUT = 23 * MiB;
constexpr size_t WS_H = 25 * MiB;
constexpr size_t WS_WT_FIN = 25 * MiB;
constexpr size_t WS_WT_DOWN = 36 * MiB;
constexpr size_t WS_QQ = 57 * MiB;
constexpr size_t WS_AK = 121 * MiB, WS_AV = 153 * MiB;
constexpr size_t WS_HLF = 185 * MiB, WS_HSG = 217 * MiB;
constexpr size_t WS_KMEAN = 249 * MiB, WS_KMEANB = 249 * MiB + 512 * 1024, WS_LB = 250 * MiB, WS_SSQ = 251 * MiB;
constexpr size_t WS_MERGED = 121 * MiB;
constexpr size_t WS_X1 = 153 * MiB;
constexpr size_t WS_A2 = 217 * MiB;
constexpr size_t WS_ACT = 57 * MiB;
constexpr size_t WS_END = 256 * MiB;
static_assert(WS_ACT + (size_t)MTOK * DFF * 2 <= WS_X1 && WS_SSQ + (size_t)MTOK * 16 * 4 <= WS_END, "d_ws map");
constexpr int CW_TMO = 0, CW_BAR = 4096;

constexpr int RING_OFF = 0, RING_BYTES = 131072;
constexpr int EPI_SCR_OFF = RING_BYTES;
constexpr int LDSCTL_OFF = RING_BYTES + 12288, MISC_OFF = LDSCTL_OFF + 320;
constexpr int LDS_BYTES = 147456;
static_assert(MISC_OFF + 128 <= LDS_BYTES, "LDS map");
constexpr int NWAVES = 8;

__device__ __forceinline__ float bf2f(unsigned short b) { return __uint_as_float((unsigned)b << 16); }


#define GAS __attribute__((address_space(1)))
#define LAS __attribute__((address_space(3)))
typedef unsigned short bf16;
typedef unsigned v4u __attribute__((ext_vector_type(4)));
typedef float f32x4 __attribute__((ext_vector_type(4)));
typedef short bf16x8 __attribute__((ext_vector_type(8)));
typedef GAS unsigned gu32;
typedef GAS unsigned long long gu64;
#define RLX_AGENT __ATOMIC_RELAXED, __HIP_MEMORY_SCOPE_AGENT
#define LDS_WAIT() asm volatile("s_waitcnt lgkmcnt(0)" ::: "memory")
#define VM_WAIT() asm volatile("s_waitcnt vmcnt(0)" ::: "memory")
__device__ __forceinline__ unsigned long long rt() { return __builtin_amdgcn_s_memrealtime(); }
__device__ __forceinline__ unsigned f2bf(float f) { unsigned u = __builtin_bit_cast(unsigned, f); return (u + 0x7fffu + ((u >> 16) & 1u)) >> 16; }
__device__ __forceinline__ unsigned pk2(float lo, float hi) { return f2bf(lo) | (f2bf(hi) << 16); }

#define XB_TMO      128
#define XB_XCNT(j)  (256  + 64 * (j))
#define XB_XSUB(j)  (1280 + 64 * (j))
#define XB_XGEN(j)  (2304 + 64 * (j))
#define XB_TOP      3328
#define XB_TOPGEN   3392
#define XCD_BAR_WORDS 3456
#define XB_SPIN_CAP (1u << 18)

__device__ __forceinline__ unsigned xb_ld(unsigned* p)              { return __hip_atomic_load(p, __ATOMIC_RELAXED, __HIP_MEMORY_SCOPE_AGENT); }
__device__ __forceinline__ unsigned xb_add(unsigned* p, unsigned v) { return __hip_atomic_fetch_add(p, v, __ATOMIC_RELAXED, __HIP_MEMORY_SCOPE_AGENT); }
__device__ __forceinline__ unsigned xb_xcc_id() { return (unsigned)__builtin_amdgcn_s_getreg((3 << 11) | 20) & 0xFu; }
#define XB_SPIN(cond, bar) do { unsigned _sp = 0; while (cond) { __builtin_amdgcn_s_sleep(1); \
    if ((++_sp & 255u) == 0u) { if (xb_ld(&(bar)[XB_TMO])) break; if (_sp > XB_SPIN_CAP) { atomicAdd(&(bar)[XB_TMO], 1u); break; } } } } while (0)

struct XcdBarrier {
    unsigned* bar; unsigned x;
    volatile LAS unsigned* st;
};

__device__ __forceinline__ XcdBarrier xcd_barrier_post(unsigned* bar, volatile LAS unsigned* st) {
    XcdBarrier b; b.bar = bar; b.x = xb_xcc_id(); b.st = st;
    if (threadIdx.x == 0) (void)xb_add(&bar[XB_XCNT(b.x)], 1u);
    return b;
}
__device__ __forceinline__ void xcd_barrier_complete(unsigned* bar, unsigned x, unsigned& nloc, unsigned& nx) {
    const unsigned G = gridDim.x * gridDim.y * gridDim.z;
    unsigned sum, cnt, mine, sp = 0u;
    for (;;) {
        sum = 0u; cnt = 0u; mine = 0u;
#pragma unroll
        for (unsigned j = 0; j < 16; ++j) { const unsigned c = xb_ld(&bar[XB_XCNT(j)]); sum += c; cnt += (c > 0u) ? 1u : 0u; mine = (j == x) ? c : mine; }
        if (sum == G) break;
        __builtin_amdgcn_s_sleep(1);
        if ((++sp & 255u) == 0u) { if (xb_ld(&bar[XB_TMO])) break; if (sp > XB_SPIN_CAP) { atomicAdd(&bar[XB_TMO], 1u); break; } }
    }
    nloc = mine > 0u ? mine : 1u; nx = cnt > 0u ? cnt : 1u;
}

__device__ __forceinline__ void xcd_barrier(const XcdBarrier& b) {
    asm volatile("s_waitcnt vmcnt(0)" ::: "memory");
    __syncthreads();
    if (threadIdx.x == 0) {
        unsigned* bar = b.bar;
        __builtin_amdgcn_s_waitcnt(0);
        unsigned nloc = b.st[0], nx = b.st[1];
        if (nloc == 0u) { xcd_barrier_complete(bar, b.x, nloc, nx); b.st[0] = nloc; b.st[1] = nx; }
        const unsigned old = xb_add(&bar[XB_XSUB(b.x)], 1u);
        const unsigned gen = old / nloc;
        if (old + 1u == (gen + 1u) * nloc) {
            __builtin_amdgcn_fence(__ATOMIC_RELEASE, "agent");
            asm volatile("s_waitcnt vmcnt(0)" ::: "memory");
            const unsigned og = xb_add(&bar[XB_TOP], 1u);
            const unsigned tg = og / nx;
            if (og + 1u == (tg + 1u) * nx) xb_add(&bar[XB_TOPGEN], 1u);
            else XB_SPIN(xb_ld(&bar[XB_TOPGEN]) == tg, bar);
            __builtin_amdgcn_fence(__ATOMIC_ACQUIRE, "agent");
            xb_add(&bar[XB_XGEN(b.x)], 1u);
            asm volatile("s_waitcnt vmcnt(0)" ::: "memory");
        } else {
            XB_SPIN(xb_ld(&bar[XB_XGEN(b.x)]) == gen, bar);
            __builtin_amdgcn_fence(__ATOMIC_ACQUIRE, "agent");
            asm volatile("s_waitcnt vmcnt(0)" ::: "memory");
        }
    }
    __syncthreads();
}

namespace moba {
typedef unsigned short bf16;
typedef short bf16x8 __attribute__((ext_vector_type(8)));
typedef short s16x4 __attribute__((ext_vector_type(4)));
typedef float f32x16 __attribute__((ext_vector_type(16)));
typedef float f32x4 __attribute__((ext_vector_type(4)));
typedef unsigned u32x4 __attribute__((ext_vector_type(4)));
constexpr float SCALE = 0.08838834764831845f;
constexpr float THR = 8.f;
constexpr int NW = 8, QBLK = 32, KVBLK = 64, QB = NW * QBLK, D = 128;
constexpr int QP = 2048, KP = 1024;
constexpr int SHM_V = KVBLK * D * 2, SHM_K = KVBLK * D * 2;
constexpr int OFF_WS = 2 * SHM_V + 2 * SHM_K, OFF_BIAS = OFF_WS + NW * 64 * 4, LDS_BYTES = OFF_BIAS + 512;
#define KSWZ(row, colB) ((row) * 256 + ((colB) ^ (((row) & 7) << 4)))
#define SBAR() __builtin_amdgcn_sched_barrier(0)
__device__ __forceinline__ int v_st(int k, int c) { const int kk = (k & ~0xC) | ((k & 4) << 1) | ((k & 8) >> 1); return ((kk >> 3) * 4 + (c >> 5)) * 512 + ((kk & 7) * 32 + (c & 31)) * 2; }
__device__ __forceinline__ int v_rd_base(int lane) { return ((lane & 3) << 3) | (((lane >> 2) & 3) << 6) | (((lane >> 4) & 1) << 5) | (((lane >> 5) & 1) << 8); }
constexpr int v_rd_off(int d0, int ks, int half) { return d0 * 512 + ks * 4096 + half * 2048; }
__device__ __forceinline__ int crow(int r, int hi) { return (r & 3) + 8 * (r >> 2) + 4 * hi; }
__device__ __forceinline__ unsigned cvtpk(float lo, float hi) { unsigned r; asm volatile("v_cvt_pk_bf16_f32 %0, %1, %2" : "=v"(r) : "v"(lo), "v"(hi)); return r; }
template <int CTRL> __device__ __forceinline__ float dpp_mov(float v) { return __int_as_float(__builtin_amdgcn_update_dpp(0, __float_as_int(v), CTRL, 0xf, 0xf, true)); }
__device__ __forceinline__ bf16x8 load8(const bf16* p) { return *reinterpret_cast<const bf16x8*>(p); }

__device__ __forceinline__ void partialSM(f32x16& p0, f32x16& p1, float& m_reg, float& mn, float& alpha) {
    float pmax = p0[0]; for (int r = 1; r < 16; ++r) pmax = fmaxf(pmax, p0[r]); for (int r = 0; r < 16; ++r) pmax = fmaxf(pmax, p1[r]);
    { auto rr = __builtin_amdgcn_permlane32_swap(__float_as_uint(pmax), __float_as_uint(pmax), false, false);
      pmax = fmaxf(__uint_as_float(rr[0]), __uint_as_float(rr[1])); }
    constexpr float C2 = 1.4426950408889634f * SCALE;
    if (__builtin_expect(__all((pmax - m_reg) * SCALE <= THR), 1)) { mn = m_reg; alpha = 1.f; }
    else { mn = fmaxf(m_reg, pmax); alpha = __builtin_amdgcn_exp2f((m_reg - mn) * C2); m_reg = mn; }
    const float mnL = -mn * C2;
    for (int r = 0; r < 16; ++r) p0[r] = fmaf(p0[r], C2, mnL); for (int r = 0; r < 16; ++r) p1[r] = fmaf(p1[r], C2, mnL);
    for (int r = 0; r < 16; ++r) p0[r] = __builtin_amdgcn_exp2f(p0[r]);
}
__device__ __forceinline__ void finishSM(f32x16& p0, f32x16& p1, float alpha, float& l_reg, bf16x8& pa0, bf16x8& pa1, bf16x8& pa2, bf16x8& pa3) {
    for (int r = 0; r < 16; ++r) p1[r] = __builtin_amdgcn_exp2f(p1[r]);
    float ps = 0; for (int r = 0; r < 16; ++r) ps += p0[r]; for (int r = 0; r < 16; ++r) ps += p1[r];
    { auto rr = __builtin_amdgcn_permlane32_swap(__float_as_uint(ps), __float_as_uint(ps), false, false);
      ps = __uint_as_float(rr[0]) + __uint_as_float(rr[1]); }
    l_reg = l_reg * alpha + ps;
#define PK4(P, B_, OUT) do { unsigned a0 = cvtpk(P[B_+0], P[B_+1]), a1 = cvtpk(P[B_+2], P[B_+3]);                          \
        unsigned b0 = cvtpk(P[B_+4], P[B_+5]), b1 = cvtpk(P[B_+6], P[B_+7]);                                             \
        auto r0 = __builtin_amdgcn_permlane32_swap(a0, b0, false, false); auto r1 = __builtin_amdgcn_permlane32_swap(a1, b1, false, false); \
        u32x4 w = {r0[0], r1[0], r0[1], r1[1]}; OUT = *reinterpret_cast<bf16x8*>(&w); } while (0)
    PK4(p0, 0, pa0); PK4(p0, 8, pa1); PK4(p1, 0, pa2); PK4(p1, 8, pa3);
#undef PK4
}
__device__ __forceinline__ void expA(f32x16& p0, f32x16& p1, float negMC) {
    constexpr float C2 = 1.4426950408889634f * SCALE;
    for (int r = 0; r < 16; ++r) p0[r] = fmaf(p0[r], C2, negMC); for (int r = 0; r < 16; ++r) p1[r] = fmaf(p1[r], C2, negMC);
    for (int r = 0; r < 16; ++r) p0[r] = __builtin_amdgcn_exp2f(p0[r]);
}
__device__ __forceinline__ void finishFS(f32x16& p0, f32x16& p1, bool keep, float& l_reg, bf16x8& pa0, bf16x8& pa1, bf16x8& pa2, bf16x8& pa3) {
    for (int r = 0; r < 16; ++r) p1[r] = __builtin_amdgcn_exp2f(p1[r]);
    float ps = 0; for (int r = 0; r < 16; ++r) ps += p0[r]; for (int r = 0; r < 16; ++r) ps += p1[r];
    { auto rr = __builtin_amdgcn_permlane32_swap(__float_as_uint(ps), __float_as_uint(ps), false, false);
      ps = __uint_as_float(rr[0]) + __uint_as_float(rr[1]); }
    l_reg += keep ? ps : 0.f;
    const unsigned km = keep ? 0xffffffffu : 0u;
#define PK4(P, B_, OUT) do { unsigned a0 = cvtpk(P[B_+0], P[B_+1]) & km, a1 = cvtpk(P[B_+2], P[B_+3]) & km;                 \
        unsigned b0 = cvtpk(P[B_+4], P[B_+5]) & km, b1 = cvtpk(P[B_+6], P[B_+7]) & km;                                     \
        auto r0 = __builtin_amdgcn_permlane32_swap(a0, b0, false, false); auto r1 = __builtin_amdgcn_permlane32_swap(a1, b1, false, false); \
        u32x4 w = {r0[0], r1[0], r0[1], r1[1]}; OUT = *reinterpret_cast<bf16x8*>(&w); } while (0)
    PK4(p0, 0, pa0); PK4(p0, 8, pa1); PK4(p1, 0, pa2); PK4(p1, 8, pa3);
#undef PK4
}
template <int KB>
__device__ __forceinline__ void qkt(f32x16& p0, f32x16& p1, const char* K_lds, int r32, int hi, const bf16x8* qr) {
    p0 = f32x16{}; p1 = f32x16{};
    const char* kb[4];
#pragma unroll
    for (int dd = 0; dd < 4; ++dd) kb[dd] = K_lds + KB * SHM_K + KSWZ(r32, (dd * 16 + hi * 8) * 2);
#pragma unroll
    for (int d0 = 0; d0 < 8; ++d0) { const char* a = kb[d0 & 3] + (d0 >> 2) * 128;
        bf16x8 b0 = *reinterpret_cast<const bf16x8*>(a);
        bf16x8 b1 = *reinterpret_cast<const bf16x8*>(a + 32 * 256);
        p0 = __builtin_amdgcn_mfma_f32_32x32x16_bf16(b0, qr[d0], p0, 0, 0, 0);
        p1 = __builtin_amdgcn_mfma_f32_32x32x16_bf16(b1, qr[d0], p1, 0, 0, 0); }
}
template <int VB>
__device__ __forceinline__ void pv_tile(f32x16* o, int vb0, bf16x8 pa0, bf16x8 pa1, bf16x8 pa2, bf16x8 pa3) {
#define TRRD(dst, off) asm volatile("ds_read_b64_tr_b16 %0, %1 offset:%2" : "=&v"(dst) : "v"(vb0), "i"(off) : "memory")
#define PV_D0(d0) do { s16x4 l0, l1, l2, l3, h0, h1, h2, h3; constexpr int b_ = VB * SHM_V + v_rd_off(d0, 0, 0); \
        TRRD(l0, b_); TRRD(h0, b_ + 2048); TRRD(l1, b_ + 4096); TRRD(h1, b_ + 6144); TRRD(l2, b_ + 8192); TRRD(h2, b_ + 10240); TRRD(l3, b_ + 12288); TRRD(h3, b_ + 14336); \
        asm volatile("s_waitcnt lgkmcnt(0)" ::: "memory"); SBAR();   \
        o[d0] = __builtin_amdgcn_mfma_f32_32x32x16_bf16(pa0, (bf16x8){l0[0], l0[1], l0[2], l0[3], h0[0], h0[1], h0[2], h0[3]}, o[d0], 0, 0, 0);   \
        o[d0] = __builtin_amdgcn_mfma_f32_32x32x16_bf16(pa1, (bf16x8){l1[0], l1[1], l1[2], l1[3], h1[0], h1[1], h1[2], h1[3]}, o[d0], 0, 0, 0);   \
        o[d0] = __builtin_amdgcn_mfma_f32_32x32x16_bf16(pa2, (bf16x8){l2[0], l2[1], l2[2], l2[3], h2[0], h2[1], h2[2], h2[3]}, o[d0], 0, 0, 0);   \
        o[d0] = __builtin_amdgcn_mfma_f32_32x32x16_bf16(pa3, (bf16x8){l3[0], l3[1], l3[2], l3[3], h3[0], h3[1], h3[2], h3[3]}, o[d0], 0, 0, 0); } while (0)
    PV_D0(0); PV_D0(1); PV_D0(2); PV_D0(3);
#undef PV_D0
#undef TRRD
}
__device__ __forceinline__ void mask_all(f32x16& p0, f32x16& p1, bool keep) {
    const float NEG = -__builtin_inff();
#pragma unroll
    for (int r = 0; r < 16; ++r) { p0[r] = keep ? p0[r] : NEG; p1[r] = keep ? p1[r] : NEG; }
}
__device__ __forceinline__ void mask_bias(f32x16& p0, f32x16& p1, int dq, const float* biasL, bool causal) {
    const float NEG = -__builtin_inff();
#pragma unroll
    for (int g = 0; g < 4; ++g) {
#pragma unroll
        for (int j = 0; j < 4; ++j) { const int r = 4 * g + j;
            const int c = (r & 3) + 8 * (r >> 2); const int d0 = dq - c, d1 = d0 - 32;
            const int i0 = d0 < 0 ? 0 : (d0 > 113 ? 113 : d0), i1 = d1 < 0 ? 0 : (d1 > 113 ? 113 : d1);
            const float v0 = p0[r] + biasL[i0], v1 = p1[r] + biasL[i1];
            p0[r] = (causal && d0 < 0) ? NEG : v0; p1[r] = (causal && d1 < 0) ? NEG : v1; }
        SBAR();
    }
}

struct BlockRef { const bf16* Q; const bf16* K; const bf16* V; bf16* O; const bf16* KM; const float* BT; const float* QG; const float* KG; int P0; };
struct Seam { bf16x8 qr[8]; bf16x8 st_v0, st_v1, st_k0, st_k1; int vs; };
#define ROWK(p, k0, rr) ((p) + (size_t)((k0) + (rr)) * KP + sc)
#define VMW() asm volatile("s_waitcnt vmcnt(0)" ::: "memory")
#define VMWN(n) asm volatile("s_waitcnt vmcnt(%0)" :: "i"(n) : "memory")
#define SLOAD_H(Kp, Vp, k0) do { S.st_v0 = load8(ROWK(Vp, k0, sr)); S.st_v1 = load8(ROWK(Vp, k0, 32 + sr));              \
                         S.st_k0 = load8(ROWK(Kp, k0, sr)); S.st_k1 = load8(ROWK(Kp, k0, 32 + sr)); } while (0)
#define SWRITE_HK(bf) do { *(bf16x8*)(K_lds + (bf) * SHM_K + kws) = S.st_k0; *(bf16x8*)(K_lds + (bf) * SHM_K + kws + 32 * 256) = S.st_k1; } while (0)
#define SWRITE_HV(bf) do { *(bf16x8*)(V_lds + (bf) * SHM_V + vst0) = S.st_v0; *(bf16x8*)(V_lds + (bf) * SHM_V + vst1) = S.st_v1; } while (0)
#define SWRITE_H(bf) do { SWRITE_HV(bf); SWRITE_HK(bf); } while (0)
__device__ __forceinline__ void moba_prime(const BlockRef& cur, char* lds, Seam& S) {
    int tid = threadIdx.x; asm volatile("" : "+v"(tid));
    const int wid = __builtin_amdgcn_readfirstlane(tid >> 6), lane = tid & 63, r32 = lane & 31, hi = lane >> 5;
    const int sr = tid >> 4, sc = (tid & 15) * 8, kws = KSWZ(sr, sc * 2); char* K_lds = lds + 2 * SHM_V;
    for (int d0 = 0; d0 < 8; ++d0) S.qr[d0] = load8(cur.Q + (size_t)(wid * QBLK + r32) * QP + d0 * 16 + hi * 8);
    SLOAD_H(cur.K, cur.V, 0); VMW(); SWRITE_HK(0);
    __syncthreads();
}
__device__ __forceinline__ void moba_block(const BlockRef& cur, const BlockRef& nxt, char* lds, Seam& S) {
    int tid = threadIdx.x; asm volatile("" : "+v"(tid));
    const int wid = __builtin_amdgcn_readfirstlane(tid >> 6), lane = tid & 63, r32 = lane & 31, hi = lane >> 5;
    const int cblk = cur.P0 >> 8;
    const int NT = 4 * (cblk + 1);
    const int qlo = cur.P0 + wid * QBLK, qm = qlo + r32 - 4 * hi;
    char* V_lds = lds; char* K_lds = lds + 2 * SHM_V;
    float* ws = (float*)(lds + OFF_WS) + wid * 64; float* li_l = ws; float* biasL = (float*)(lds + OFF_BIAS);
    float l_reg = 0; f32x16 o[4];
    const int sr = tid >> 4, sc = (tid & 15) * 8, vst0 = v_st(sr, sc), vst1 = v_st(32 + sr, sc), kws = KSWZ(sr, sc * 2);
    const int vb0 = (int)(uintptr_t)V_lds + v_rd_base(lane);
    const bf16* Kh = cur.K; const bf16* Vh = cur.V;
    f32x16 pA0, pA1, pB0, pB1; bf16x8 pa0, pa1, pa2, pa3;
    if (tid < 128) { const int d = tid < 113 ? tid : 113; int bk = d;
        if (d >= 16) { bk = 15; bk += d >= 16; bk += d >= 19; bk += d >= 21; bk += d >= 24; bk += d >= 27; bk += d >= 31; bk += d >= 35; bk += d >= 40;
            bk += d >= 46; bk += d >= 52; bk += d >= 59; bk += d >= 67; bk += d >= 77; bk += d >= 87; bk += d >= 99; bk += d >= 113; }
        biasL[tid] = (cur.BT[bk * 8] - cur.BT[31 * 8]) * (1.f / SCALE); }
    if (tid < 256) { const bf16x8 kmv = load8(cur.KM + (size_t)(tid >> 4) * 128 + (tid & 15) * 8); *(bf16x8*)(K_lds + SHM_K + KSWZ(tid >> 4, (tid & 15) * 16)) = kmv; }
    __syncthreads();
    unsigned selmask = 0u;
#ifndef ATT_NOGATE
    { qkt<1>(pA0, pA1, K_lds, r32, hi, S.qr);
      float G[16];
#pragma unroll
      for (int r = 0; r < 8; ++r) { auto rr = __builtin_amdgcn_permlane32_swap(__float_as_uint(pA0[r]), __float_as_uint(pA0[r]), false, false);
          const int n0 = (r & 3) + 8 * (r >> 2); G[n0] = __uint_as_float(rr[0]); G[n0 + 4] = __uint_as_float(rr[1]); }
#pragma unroll
      for (int s = 0; s < 3; ++s) { float bv = 0.f; int bi = -1;
#pragma unroll
          for (int n = 0; n < 16; ++n) { const bool ok = (n < cblk) && !((selmask >> n) & 1u); const bool take = ok && (bi < 0 || G[n] > bv); bv = take ? G[n] : bv; bi = take ? n : bi; }
          selmask |= (bi >= 0) ? (1u << bi) : 0u; }
    }
#endif
    __syncthreads();
    o[0] = f32x16{}; o[1] = f32x16{}; o[2] = f32x16{}; o[3] = f32x16{};
#define KBASE(t) ((t) * KVBLK)
    float negMC;
    { float mq = fmaxf(fabsf(cur.QG[lane]), fabsf(cur.QG[lane + 64])), mk = fmaxf(fabsf(cur.KG[lane]), fabsf(cur.KG[lane + 64])), mb = fmaxf(biasL[lane], biasL[lane + 64]);
#pragma unroll
      for (int s = 1; s < 64; s <<= 1) { mq = fmaxf(mq, __shfl_xor(mq, s)); mk = fmaxf(mk, __shfl_xor(mk, s)); mb = fmaxf(mb, __shfl_xor(mb, s)); }
      negMC = -(1.02f * 128.f * mq * mk + fmaxf(mb, 0.f)) * (1.4426950408889634f * SCALE); }
#define MASKT(P0_, P1_, t) do { const int kb_ = KBASE(t), nb_ = (t) >> 2; \
        if (qlo - (kb_ + KVBLK - 1) < 113) mask_bias(P0_, P1_, qm - kb_, biasL, nb_ == cblk); } while (0)
#define KEEP(t) ((((t) >> 2) >= cblk) || ((selmask >> ((t) >> 2)) & 1u))
    constexpr int NQL = 8;
#define SEAM_K0() do { VMWN(NQL); SWRITE_HK(0); SBAR(); } while (0)
    SWRITE_HV(0); SBAR();
    SLOAD_H(Kh, Vh, KBASE(1));
    SBAR(); qkt<0>(pA0, pA1, K_lds, r32, hi, S.qr);
    MASKT(pA0, pA1, 0); expA(pA0, pA1, negMC);
    VMW(); SWRITE_H(1);
    __syncthreads();
#define HALF_STEP(PX0, PX1, PY0, PY1, t, KB, VB, SB) do {                                                                     \
        SBAR(); qkt<KB>(PX0, PX1, K_lds, r32, hi, S.qr);                                                                      \
        finishFS(PY0, PY1, KEEP((t) - 1), l_reg, pa0, pa1, pa2, pa3); SBAR();                                                 \
        if ((t) + 1 < NT) { SLOAD_H(Kh, Vh, KBASE((t) + 1)); SBAR(); }                                                        \
        pv_tile<VB>(o, vb0, pa0, pa1, pa2, pa3); MASKT(PX0, PX1, (t)); expA(PX0, PX1, negMC);                                 \
        __syncthreads();                                                                                                      \
        if ((t) + 1 < NT) { VMW(); SWRITE_H(SB); }                                                                            \
        __syncthreads(); } while (0)
    for (int t = 1; t + 1 < NT; t += 2) {
        HALF_STEP(pB0, pB1, pA0, pA1, t, 1, 0, 0);
        HALF_STEP(pA0, pA1, pB0, pB1, t + 1, 0, 1, 1);
    }
    SBAR(); qkt<1>(pB0, pB1, K_lds, r32, hi, S.qr); SBAR();
    SLOAD_H(nxt.K, nxt.V, 0); SBAR();
#pragma unroll
    for (int d0 = 0; d0 < 8; ++d0) S.qr[d0] = load8(nxt.Q + (size_t)(wid * QBLK + r32) * QP + d0 * 16 + hi * 8);
    SBAR();
    finishFS(pA0, pA1, true, l_reg, pa0, pa1, pa2, pa3); SBAR();
    pv_tile<0>(o, vb0, pa0, pa1, pa2, pa3);
    MASKT(pB0, pB1, NT - 1); expA(pB0, pB1, negMC); __syncthreads();
    finishFS(pB0, pB1, true, l_reg, pa0, pa1, pa2, pa3); SBAR(); pv_tile<1>(o, vb0, pa0, pa1, pa2, pa3);
    SBAR(); SEAM_K0();
    if (hi == 0) li_l[r32] = l_reg; asm volatile("s_waitcnt lgkmcnt(0)" ::: "memory");
    float rli[16];
#pragma unroll
    for (int r = 0; r < 16; ++r) rli[r] = __builtin_amdgcn_rcpf(li_l[crow(r, hi)]);
    bf16* Ow = cur.O + (size_t)(wid * QBLK) * QP;
#pragma unroll
    for (int r = 0; r < 16; ++r) { const int orow = crow(r, hi);
#pragma unroll
        for (int d0 = 0; d0 < 4; ++d0) { const float v = o[d0][r] * rli[r];
            const float vn = dpp_mov<0xB1>(v);
            if ((r32 & 1) == 0) *(unsigned*)(Ow + (size_t)orow * QP + d0 * 32 + r32) = cvtpk(v, vn); } }
    __syncthreads();
#undef KBASE
#undef MASKT
#undef KEEP
#undef SEAM_K0
#undef HALF_STEP
}

typedef float f32x2_t __attribute__((ext_vector_type(2)));
typedef __bf16 bf16x2_t __attribute__((ext_vector_type(2)));
__device__ __forceinline__ unsigned cvtpk2(float lo, float hi) { f32x2_t v = {lo, hi}; bf16x2_t b = __builtin_convertvector(v, bf16x2_t); return __builtin_bit_cast(unsigned, b); }
__device__ __forceinline__ void sm_tile(f32x16& p0, f32x16& p1, bf16x8* pa) {
#pragma unroll
    for (int r = 0; r < 16; ++r) { p0[r] = __builtin_amdgcn_exp2f(p0[r]); p1[r] = __builtin_amdgcn_exp2f(p1[r]); }
#define PK4(P, B_, OUT) do { unsigned a0 = cvtpk2(P[B_+0], P[B_+1]), a1 = cvtpk2(P[B_+2], P[B_+3]);                         \
        unsigned b0 = cvtpk2(P[B_+4], P[B_+5]), b1 = cvtpk2(P[B_+6], P[B_+7]);                                             \
        auto r0 = __builtin_amdgcn_permlane32_swap(a0, b0, false, false); auto r1 = __builtin_amdgcn_permlane32_swap(a1, b1, false, false); \
        u32x4 w = {r0[0], r1[0], r0[1], r1[1]}; OUT = *reinterpret_cast<bf16x8*>(&w); } while (0)
    PK4(p0, 0, pa[0]); PK4(p0, 8, pa[1]); PK4(p1, 0, pa[2]); PK4(p1, 8, pa[3]);
#undef PK4
}
#define A2_TR(dst, off) asm volatile("ds_read_b64_tr_b16 %0, %1 offset:%2" : "=&v"(dst) : "v"(vb0), "i"(off) : "memory")
#define A2_KR(dst, areg, off) asm volatile("ds_read_b128 %0, %1 offset:%2" : "=&v"(dst) : "v"(areg), "i"(off) : "memory")
#define A2_RPV(T, VB, k, ks) do { constexpr int b_ = (VB) * SHM_V + (2 * (k)) * 512 + (ks) * 4096; A2_TR(T[0], b_); A2_TR(T[1], b_ + 2048); A2_TR(T[2], b_ + 512); A2_TR(T[3], b_ + 512 + 2048); } while (0)
#define A2_RQK(Kf, KB, d0) do { constexpr int o_ = (KB) * SHM_K + ((d0) >> 2) * 128; A2_KR(Kf[0], kbv[(d0) & 3], o_); A2_KR(Kf[1], kbv[(d0) & 3], o_ + 8192); } while (0)
#define A2_WPV(N, T) asm volatile("s_waitcnt lgkmcnt(" #N ")" : "+v"(T[0]), "+v"(T[1]), "+v"(T[2]), "+v"(T[3]) :: "memory")
#define A2_WQK(N, Kf) asm volatile("s_waitcnt lgkmcnt(" #N ")" : "+v"(Kf[0]), "+v"(Kf[1]) :: "memory")
#define A2_CAT(a, b) ((bf16x8){a[0], a[1], a[2], a[3], b[0], b[1], b[2], b[3]})
#define A2_MPV(T, k, ks) do { if constexpr (!(ABL & 1)) { o[2 * (k)] = __builtin_amdgcn_mfma_f32_32x32x16_bf16(pa[ks], A2_CAT(T[0], T[1]), o[2 * (k)], 0, 0, 0);            \
                              o[2 * (k) + 1] = __builtin_amdgcn_mfma_f32_32x32x16_bf16(pa[ks], A2_CAT(T[2], T[3]), o[2 * (k) + 1], 0, 0, 0);            \
                              if constexpr ((k) == 0) ol = __builtin_amdgcn_mfma_f32_32x32x16_bf16(pa[ks], ones, ol, 0, 0, 0); } SBAR(); } while (0)
#define A2_MQK(Kf, d0) do { if constexpr (!(ABL & 1)) { p0 = __builtin_amdgcn_mfma_f32_32x32x16_bf16(Kf[0], S.qr[d0], p0, 0, 0, 0);                                    \
                            p1 = __builtin_amdgcn_mfma_f32_32x32x16_bf16(Kf[1], S.qr[d0], p1, 0, 0, 0); } SBAR(); } while (0)
template <int VB, int KB, bool DO_PV, bool DO_QK, int ABL = 0>
__device__ __forceinline__ void mstretch(f32x16* o, f32x16& ol, f32x16& p0, f32x16& p1, const bf16x8* pa, const Seam& S, int vb0, const int* kbv, const f32x16& negm, const bf16x8 ones) {
    s16x4 T0[4], T1[4], T2[4], T3[4], T4[4], T5[4], T6[4], T7[4]; bf16x8 Q0[2], Q1[2], Q2[2], Q3[2], Q4[2], Q5[2], Q6[2], Q7[2];
    if constexpr (DO_PV && DO_QK) {
        A2_RPV(T0, VB, 0, 0); A2_RPV(T1, VB, 0, 1); A2_RPV(T2, VB, 0, 2);
        A2_WPV(8, T0); A2_RPV(T3, VB, 0, 3); A2_MPV(T0, 0, 0);
        A2_WPV(8, T1); A2_RPV(T4, VB, 1, 0); A2_MPV(T1, 0, 1);
        A2_WPV(8, T2); A2_RPV(T5, VB, 1, 1); A2_MPV(T2, 0, 2);
        A2_WPV(8, T3); A2_RPV(T6, VB, 1, 2); A2_MPV(T3, 0, 3);
        A2_WPV(8, T4); A2_RPV(T7, VB, 1, 3); A2_MPV(T4, 1, 0);
        A2_WPV(8, T5); A2_RQK(Q0, KB, 0);    A2_MPV(T5, 1, 1);
        A2_WPV(6, T6); A2_RQK(Q1, KB, 1);    A2_MPV(T6, 1, 2);
        A2_WPV(4, T7); A2_RQK(Q2, KB, 2);    A2_MPV(T7, 1, 3);
        p0 = negm; p1 = negm;
        A2_WQK(4, Q0); A2_RQK(Q3, KB, 3);    A2_MQK(Q0, 0);
        A2_WQK(4, Q1); A2_RQK(Q4, KB, 4);    A2_MQK(Q1, 1);
        A2_WQK(4, Q2); A2_RQK(Q5, KB, 5);    A2_MQK(Q2, 2);
        A2_WQK(4, Q3); A2_RQK(Q6, KB, 6);    A2_MQK(Q3, 3);
        A2_WQK(4, Q4); A2_RQK(Q7, KB, 7);    A2_MQK(Q4, 4);
        A2_WQK(4, Q5);                       A2_MQK(Q5, 5);
        A2_WQK(2, Q6);                       A2_MQK(Q6, 6);
        A2_WQK(0, Q7);                       A2_MQK(Q7, 7);
    } else if constexpr (DO_PV) {
        A2_RPV(T0, VB, 0, 0); A2_RPV(T1, VB, 0, 1); A2_RPV(T2, VB, 0, 2);
        A2_WPV(8, T0); A2_RPV(T3, VB, 0, 3); A2_MPV(T0, 0, 0);
        A2_WPV(8, T1); A2_RPV(T4, VB, 1, 0); A2_MPV(T1, 0, 1);
        A2_WPV(8, T2); A2_RPV(T5, VB, 1, 1); A2_MPV(T2, 0, 2);
        A2_WPV(8, T3); A2_RPV(T6, VB, 1, 2); A2_MPV(T3, 0, 3);
        A2_WPV(8, T4); A2_RPV(T7, VB, 1, 3); A2_MPV(T4, 1, 0);
        A2_WPV(8, T5);                       A2_MPV(T5, 1, 1);
        A2_WPV(4, T6);                       A2_MPV(T6, 1, 2);
        A2_WPV(0, T7);                       A2_MPV(T7, 1, 3);
    } else {
        A2_RQK(Q0, KB, 0); A2_RQK(Q1, KB, 1); A2_RQK(Q2, KB, 2);
        p0 = negm; p1 = negm;
        A2_WQK(4, Q0); A2_RQK(Q3, KB, 3);    A2_MQK(Q0, 0);
        A2_WQK(4, Q1); A2_RQK(Q4, KB, 4);    A2_MQK(Q1, 1);
        A2_WQK(4, Q2); A2_RQK(Q5, KB, 5);    A2_MQK(Q2, 2);
        A2_WQK(4, Q3); A2_RQK(Q6, KB, 6);    A2_MQK(Q3, 3);
        A2_WQK(4, Q4); A2_RQK(Q7, KB, 7);    A2_MQK(Q4, 4);
        A2_WQK(4, Q5);                       A2_MQK(Q5, 5);
        A2_WQK(2, Q6);                       A2_MQK(Q6, 6);
        A2_WQK(0, Q7);                       A2_MQK(Q7, 7);
    }
}
template <int ABL>
__device__ __forceinline__ void moba_block2(const BlockRef& cur, const BlockRef& nxt, char* lds, Seam& S) {
    int tid = threadIdx.x; asm volatile("" : "+v"(tid));
    const int wid = __builtin_amdgcn_readfirstlane(tid >> 6), lane = tid & 63, r32 = lane & 31, hi = lane >> 5;
#ifndef MK_ATT2_ROLE
#define MK_ATT2_ROLE 0
#endif
    const bool roleB = MK_ATT2_ROLE == 0 ? wid >= 4 : (MK_ATT2_ROLE == 2 ? (wid & 1) != 0 : false);
    const int cblk = cur.P0 >> 8;
    const int NT = 4 * (cblk + 1);
    const int qlo = cur.P0 + wid * QBLK, qm = qlo + r32 - 4 * hi;
    char* V_lds = lds; char* K_lds = lds + 2 * SHM_V;
    float* ws = (float*)(lds + OFF_WS) + wid * 64; float* li_l = ws; float* biasL = (float*)(lds + OFF_BIAS);
    f32x16 o[4], ol, negm;
    const bf16x8 ones = {0x3F80, 0x3F80, 0x3F80, 0x3F80, 0x3F80, 0x3F80, 0x3F80, 0x3F80};
    const int sr = tid >> 4, sc = (tid & 15) * 8, vst0 = v_st(sr, sc), vst1 = v_st(32 + sr, sc), kws = KSWZ(sr, sc * 2);
    const int vb0 = (int)(uintptr_t)V_lds + v_rd_base(lane);
    int kbv[4];
#pragma unroll
    for (int dd = 0; dd < 4; ++dd) kbv[dd] = (int)(uintptr_t)K_lds + KSWZ(r32, (dd * 16 + hi * 8) * 2);
    const bf16* Kh = cur.K; const bf16* Vh = cur.V;
    f32x16 p0, p1; bf16x8 pa[4];
    if constexpr (ABL != 0) { pa[0] = bf16x8{}; pa[1] = bf16x8{}; pa[2] = bf16x8{}; pa[3] = bf16x8{}; }
    if (tid < 128) { const int d = tid < 113 ? tid : 113; int bk = d;
        if (d >= 16) { bk = 15; bk += d >= 16; bk += d >= 19; bk += d >= 21; bk += d >= 24; bk += d >= 27; bk += d >= 31; bk += d >= 35; bk += d >= 40;
            bk += d >= 46; bk += d >= 52; bk += d >= 59; bk += d >= 67; bk += d >= 77; bk += d >= 87; bk += d >= 99; bk += d >= 113; }
        biasL[tid] = (cur.BT[bk * 8] - cur.BT[31 * 8]) * 1.4426950408889634f; }
    if (tid < 256) { const bf16x8 kmv = load8(cur.KM + (size_t)(tid >> 4) * 128 + (tid & 15) * 8); *(bf16x8*)(K_lds + SHM_K + KSWZ(tid >> 4, (tid & 15) * 16)) = kmv; }
    __syncthreads();
    unsigned selmask = 0u;
    { qkt<1>(p0, p1, K_lds, r32, hi, S.qr);
      float G[16];
#pragma unroll
      for (int r = 0; r < 8; ++r) { auto rr = __builtin_amdgcn_permlane32_swap(__float_as_uint(p0[r]), __float_as_uint(p0[r]), false, false);
          const int n0 = (r & 3) + 8 * (r >> 2); G[n0] = __uint_as_float(rr[0]); G[n0 + 4] = __uint_as_float(rr[1]); }
#pragma unroll
      for (int s = 0; s < 3; ++s) { float bv = 0.f; int bi = -1;
#pragma unroll
          for (int n = 0; n < 16; ++n) { const bool ok = (n < cblk) && !((selmask >> n) & 1u); const bool take = ok && (bi < 0 || G[n] > bv); bv = take ? G[n] : bv; bi = take ? n : bi; }
          selmask |= (bi >= 0) ? (1u << bi) : 0u; }
    }
    __syncthreads();
    o[0] = f32x16{}; o[1] = f32x16{}; o[2] = f32x16{}; o[3] = f32x16{}; ol = f32x16{};
#define KBASE(t) ((t) * KVBLK)
    float negMC;
    { float mq = fmaxf(fabsf(cur.QG[lane]), fabsf(cur.QG[lane + 64])), mk = fmaxf(fabsf(cur.KG[lane]), fabsf(cur.KG[lane + 64])), mb = fmaxf(biasL[lane], biasL[lane + 64]);
#pragma unroll
      for (int s = 1; s < 64; s <<= 1) { mq = fmaxf(mq, __shfl_xor(mq, s)); mk = fmaxf(mk, __shfl_xor(mk, s)); mb = fmaxf(mb, __shfl_xor(mb, s)); }
      negMC = -(1.02f * 128.f * mq * mk * (1.4426950408889634f * SCALE) + fmaxf(mb, 0.f)); }
#define MASKT(t) do { const int kb_ = KBASE(t), nb_ = (t) >> 2; \
        if (qlo - (kb_ + KVBLK - 1) < 113) mask_bias(p0, p1, qm - kb_, biasL, nb_ == cblk); } while (0)
#define KEEP(t) ((((t) >> 2) >= cblk) || ((selmask >> ((t) >> 2)) & 1u))
#define SMT(t) do { if constexpr (!(ABL & 2)) { MASKT(t); sm_tile(p0, p1, pa); } SBAR(); } while (0)
#define NEGM(t) do { const float nm_ = KEEP(t) ? negMC : -__builtin_inff(); _Pragma("unroll") for (int r_ = 0; r_ < 16; ++r_) negm[r_] = nm_; } while (0)
    constexpr int NQL = 8;
    SWRITE_HV(0); SBAR();
    SLOAD_H(Kh, Vh, KBASE(1)); SBAR();
    NEGM(0);
    mstretch<0, 0, false, true, ABL>(o, ol, p0, p1, pa, S, vb0, kbv, negm, ones);
    if (!roleB) SMT(0);
    VMW(); SWRITE_H(1);
    __syncthreads();
#define IV(VB, KB, t) do {                                                                                     \
        if constexpr (!(ABL & 32)) { SLOAD_H(Kh, Vh, KBASE((t) + 1)); SBAR(); }                                \
        if (roleB) SMT((t) - 1);                                                                               \
        if constexpr (!(ABL & 8)) mstretch<VB, KB, true, true, ABL>(o, ol, p0, p1, pa, S, vb0, kbv, negm, ones);               \
        if (!roleB) SMT(t);                                                                                    \
        if constexpr (!(ABL & 16)) __syncthreads();                                                            \
        if constexpr (!(ABL & 4)) { VMW(); SWRITE_H(VB); __syncthreads(); } } while (0)
    for (int t = 1; t + 1 < NT; t += 2) { IV(0, 1, t); if (((t + 1) & 3) == 0) NEGM(t + 1); IV(1, 0, t + 1); }
#undef IV
    if (roleB) SMT(NT - 2);
    mstretch<0, 1, true, true, ABL>(o, ol, p0, p1, pa, S, vb0, kbv, negm, ones);
    SLOAD_H(nxt.K, nxt.V, 0); SBAR();
#pragma unroll
    for (int d0 = 0; d0 < 8; ++d0) S.qr[d0] = load8(nxt.Q + (size_t)(wid * QBLK + r32) * QP + d0 * 16 + hi * 8);
    SBAR();
    SMT(NT - 1);
    mstretch<1, 0, true, false, ABL>(o, ol, p0, p1, pa, S, vb0, kbv, negm, ones);
    SBAR(); VMWN(NQL); SWRITE_HK(0); SBAR();
    float rli[16];
#pragma unroll
    for (int r = 0; r < 16; ++r) rli[r] = __builtin_amdgcn_rcpf(ol[r]);
    bf16* Ow = cur.O + (size_t)(wid * QBLK) * QP;
#pragma unroll
    for (int r = 0; r < 16; ++r) { const int orow = crow(r, hi);
#pragma unroll
        for (int d0 = 0; d0 < 4; ++d0) { const float v = o[d0][r] * rli[r];
            const float vn = dpp_mov<0xB1>(v);
            if ((r32 & 1) == 0) *(unsigned*)(Ow + (size_t)orow * QP + d0 * 32 + r32) = cvtpk2(v, vn); } }
    __syncthreads();
#undef KBASE
#undef MASKT
#undef KEEP
#undef SMT
#undef NEGM
}

constexpr int V3_V = 0, V3_K = 3 * SHM_V, V3_KM = V3_K + 2 * SHM_K, V3_BIAS = V3_KM + 4096, V3_BYTES = V3_BIAS + 512;
#define A3_GLDS(g, l) __builtin_amdgcn_global_load_lds((const unsigned*)(g), (PG8_LAS unsigned*)(l), 16, 0, 0)
#define A3_DMA(Kp, Vp, k0, kslot, vslot) do { const bf16* kp_ = (Kp) + (size_t)(k0) * KP; const bf16* vp_ = (Vp) + (size_t)(k0) * KP;                         \
        PG8_LAS unsigned char* kd_ = ldsL + V3_K + (kslot) * SHM_K + wid * 2048; PG8_LAS unsigned char* vd_ = ldsL + V3_V + (vslot) * SHM_V + wid * 2048;       \
        A3_GLDS(kp_ + koff0, kd_); A3_GLDS(kp_ + koff1, kd_ + 1024); A3_GLDS(vp_ + voff0, vd_); A3_GLDS(vp_ + voff1, vd_ + 1024); } while (0)
#define A3_OFFS()                                                                                                                                             \
    const int krow0_ = 8 * wid + (lane >> 4), krow1_ = krow0_ + 4;                                                                                             \
    const int koff0 = krow0_ * KP + (((lane & 15) ^ (krow0_ & 7)) << 3), koff1 = krow1_ * KP + (((lane & 15) ^ (krow1_ & 7)) << 3);                           \
    const int vkk_ = wid * 8 + ((lane & 31) >> 2), vk_ = (vkk_ & ~0xC) | ((vkk_ & 4) << 1) | ((vkk_ & 8) >> 1);                                                \
    const int voff0 = vk_ * KP + (lane >> 5) * 32 + (lane & 3) * 8, voff1 = voff0 + 64;
__device__ __forceinline__ void moba_prime3(const BlockRef& cur, PG8_LAS unsigned char* ldsL, Seam& S) {
    int tid = threadIdx.x; asm volatile("" : "+v"(tid));
    const int wid = __builtin_amdgcn_readfirstlane(tid >> 6), lane = tid & 63, r32 = lane & 31, hi = lane >> 5;
    A3_OFFS();
    const int vs = __builtin_amdgcn_readfirstlane(S.vs);
    A3_DMA(cur.K, cur.V, 0, 0, vs);
    for (int d0 = 0; d0 < 8; ++d0) S.qr[d0] = load8(cur.Q + (size_t)(wid * QBLK + r32) * QP + d0 * 16 + hi * 8);
    VMW();
    __syncthreads();
}
template <int ABL>
__device__ __forceinline__ void moba_block3(const BlockRef& cur, const BlockRef& nxt, PG8_LAS unsigned char* ldsL, Seam& S) {
    int tid = threadIdx.x; asm volatile("" : "+v"(tid));
    const int wid = __builtin_amdgcn_readfirstlane(tid >> 6), lane = tid & 63, r32 = lane & 31, hi = lane >> 5;
    char* lds = (char*)ldsL;
    const bool roleB = MK_ATT2_ROLE == 0 ? wid >= 4 : (MK_ATT2_ROLE == 2 ? (wid & 1) != 0 : false);
    const int cblk = cur.P0 >> 8;
    const int NT = 4 * (cblk + 1);
    const int qlo = cur.P0 + wid * QBLK, qm = qlo + r32 - 4 * hi;
    char* V_lds = lds + V3_V; char* K_lds = lds + V3_K;
    float* biasL = (float*)(lds + V3_BIAS);
    f32x16 o[4], ol, negm;
    const bf16x8 ones = {0x3F80, 0x3F80, 0x3F80, 0x3F80, 0x3F80, 0x3F80, 0x3F80, 0x3F80};
    A3_OFFS();
    const int vbase = (int)(uintptr_t)V_lds + v_rd_base(lane);
    int kbv[4];
#pragma unroll
    for (int dd = 0; dd < 4; ++dd) kbv[dd] = (int)(uintptr_t)K_lds + KSWZ(r32, (dd * 16 + hi * 8) * 2);
    const bf16* Kh = cur.K; const bf16* Vh = cur.V;
    f32x16 p0, p1; bf16x8 pa[4];
    if constexpr (ABL != 0) { pa[0] = bf16x8{}; pa[1] = bf16x8{}; pa[2] = bf16x8{}; pa[3] = bf16x8{}; }
    int sv = __builtin_amdgcn_readfirstlane(S.vs);
#define SV_NEXT(s) ((s) == 2 ? 0 : (s) + 1)
    A3_DMA(Kh, Vh, KVBLK, 1, SV_NEXT(sv));
    if (tid < 128) { const int d = tid < 113 ? tid : 113; int bk = d;
        if (d >= 16) { bk = 15; bk += d >= 16; bk += d >= 19; bk += d >= 21; bk += d >= 24; bk += d >= 27; bk += d >= 31; bk += d >= 35; bk += d >= 40;
            bk += d >= 46; bk += d >= 52; bk += d >= 59; bk += d >= 67; bk += d >= 77; bk += d >= 87; bk += d >= 99; bk += d >= 113; }
        biasL[tid] = (cur.BT[bk * 8] - cur.BT[31 * 8]) * 1.4426950408889634f; }
    if (tid < 256) { const bf16x8 kmv = load8(cur.KM + (size_t)(tid >> 4) * 128 + (tid & 15) * 8); *(bf16x8*)(lds + V3_KM + KSWZ(tid >> 4, (tid & 15) * 16)) = kmv; }
    __syncthreads();
    unsigned selmask = 0u;
    { qkt<0>(p0, p1, lds + V3_KM, r32, hi, S.qr);
      float G[16];
#pragma unroll
      for (int r = 0; r < 8; ++r) { auto rr = __builtin_amdgcn_permlane32_swap(__float_as_uint(p0[r]), __float_as_uint(p0[r]), false, false);
          const int n0 = (r & 3) + 8 * (r >> 2); G[n0] = __uint_as_float(rr[0]); G[n0 + 4] = __uint_as_float(rr[1]); }
#pragma unroll
      for (int s = 0; s < 3; ++s) { float bv = 0.f; int bi = -1;
#pragma unroll
          for (int n = 0; n < 16; ++n) { const bool ok = (n < cblk) && !((selmask >> n) & 1u); const bool take = ok && (bi < 0 || G[n] > bv); bv = take ? G[n] : bv; bi = take ? n : bi; }
          selmask |= (bi >= 0) ? (1u << bi) : 0u; }
    }
    o[0] = f32x16{}; o[1] = f32x16{}; o[2] = f32x16{}; o[3] = f32x16{}; ol = f32x16{};
#define KBASE(t) ((t) * KVBLK)
    float negMC;
    { float mq = fmaxf(fabsf(cur.QG[lane]), fabsf(cur.QG[lane + 64])), mk = fmaxf(fabsf(cur.KG[lane]), fabsf(cur.KG[lane + 64])), mb = fmaxf(biasL[lane], biasL[lane + 64]);
#pragma unroll
      for (int s = 1; s < 64; s <<= 1) { mq = fmaxf(mq, __shfl_xor(mq, s)); mk = fmaxf(mk, __shfl_xor(mk, s)); mb = fmaxf(mb, __shfl_xor(mb, s)); }
      negMC = -(1.02f * 128.f * mq * mk * (1.4426950408889634f * SCALE) + fmaxf(mb, 0.f)); }
#define MASKT(t) do { const int kb_ = KBASE(t), nb_ = (t) >> 2; \
        if (qlo - (kb_ + KVBLK - 1) < 113) mask_bias(p0, p1, qm - kb_, biasL, nb_ == cblk); } while (0)
#define KEEP(t) ((((t) >> 2) >= cblk) || ((selmask >> ((t) >> 2)) & 1u))
#define SMT(t) do { if constexpr (!(ABL & 2)) { MASKT(t); sm_tile(p0, p1, pa); } SBAR(); } while (0)
#define NEGM(t) do { const float nm_ = KEEP(t) ? negMC : -__builtin_inff(); _Pragma("unroll") for (int r_ = 0; r_ < 16; ++r_) negm[r_] = nm_; } while (0)
    NEGM(0);
    mstretch<0, 0, false, true, ABL>(o, ol, p0, p1, pa, S, vbase, kbv, negm, ones);
    if (!roleB) SMT(0);
    VMW(); __syncthreads();
#define IV(KB, t, Kn, Vn, kn) do {                                                                             \
        if constexpr (!(ABL & 32)) A3_DMA(Kn, Vn, kn, 1 - (KB), SV_NEXT(SV_NEXT(sv)));                         \
        if (roleB) SMT((t) - 1);                                                                               \
        if constexpr (!(ABL & 8)) mstretch<0, KB, true, true, ABL>(o, ol, p0, p1, pa, S, vbase + sv * SHM_V, kbv, negm, ones);   \
        if (!roleB) SMT(t);                                                                                    \
        VMW(); if constexpr (!(ABL & 16)) __syncthreads(); sv = SV_NEXT(sv); } while (0)
    for (int t = 1; t + 1 < NT; t += 2) { IV(1, t, Kh, Vh, KBASE(t + 1)); if (((t + 1) & 3) == 0) NEGM(t + 1); IV(0, t + 1, Kh, Vh, KBASE(t + 2)); }
    if constexpr (!(ABL & 32)) A3_DMA(nxt.K, nxt.V, 0, 0, SV_NEXT(SV_NEXT(sv)));
    if (roleB) SMT(NT - 2);
    mstretch<0, 1, true, true, ABL>(o, ol, p0, p1, pa, S, vbase + sv * SHM_V, kbv, negm, ones);
#pragma unroll
    for (int d0 = 0; d0 < 8; ++d0) S.qr[d0] = load8(nxt.Q + (size_t)(wid * QBLK + r32) * QP + d0 * 16 + hi * 8);
    SBAR();
    SMT(NT - 1);
    sv = SV_NEXT(sv);
    mstretch<0, 0, true, false, ABL>(o, ol, p0, p1, pa, S, vbase + sv * SHM_V, kbv, negm, ones);
    S.vs = SV_NEXT(sv);
#undef IV
    VMW();
    float rli[16];
#pragma unroll
    for (int r = 0; r < 16; ++r) rli[r] = __builtin_amdgcn_rcpf(ol[r]);
    bf16* Ow = cur.O + (size_t)(wid * QBLK) * QP;
#pragma unroll
    for (int r = 0; r < 16; ++r) { const int orow = crow(r, hi);
#pragma unroll
        for (int d0 = 0; d0 < 4; ++d0) { const float v = o[d0][r] * rli[r];
            const float vn = dpp_mov<0xB1>(v);
            if ((r32 & 1) == 0) *(unsigned*)(Ow + (size_t)orow * QP + d0 * 32 + r32) = cvtpk2(v, vn); } }
    __syncthreads();
#undef KBASE
#undef MASKT
#undef KEEP
#undef SMT
#undef NEGM
#undef SV_NEXT
}
#undef ROWK
#undef VMW
#undef VMWN
#undef SLOAD_H
#undef SWRITE_HK
#undef SWRITE_HV
#undef SWRITE_H
#undef KSWZ
#undef SBAR
}


namespace hgrn {
typedef short s16x4 __attribute__((ext_vector_type(4)));
typedef short bf16x8 __attribute__((ext_vector_type(8)));
typedef float f32x4 __attribute__((ext_vector_type(4)));
typedef unsigned u32x2 __attribute__((ext_vector_type(2)));
typedef unsigned u32x4 __attribute__((ext_vector_type(4)));
constexpr int QROW = 272, TROW = 40;
constexpr int OFF_QH = 0, OFF_KH = 16 * QROW, OFF_KDT = 2 * 16 * QROW, OFF_VT = OFF_KDT + 128 * TROW, OFF_DV = OFF_VT + 128 * TROW, SET_BYTES = OFF_DV + 512;
constexpr int OFF_PART = 2 * SET_BYTES, OFF_RAW = 40960, RAW_T = 16 * QROW  , RAW_SLOT = 5 * RAW_T, OFF_OBUF = OFF_RAW + 3 * RAW_SLOT, LDS_BYTES = OFF_OBUF + 64 * QROW;
static_assert(SET_BYTES % 16 == 0 && OFF_KDT % 16 == 0 && OFF_VT % 8 == 0 && OFF_DV % 16 == 0 && OFF_PART + 1024 <= OFF_RAW && LDS_BYTES <= 131072, "hgrn LDS map");
typedef float f32x2_t __attribute__((ext_vector_type(2))); typedef __bf16 bf16x2_t __attribute__((ext_vector_type(2)));
__device__ __forceinline__ unsigned cvtpk(float lo, float hi) { f32x2_t v = {lo, hi}; bf16x2_t b = __builtin_convertvector(v, bf16x2_t); return __builtin_bit_cast(unsigned, b); }
__device__ __forceinline__ float bf2f(unsigned short b) { return __uint_as_float((unsigned)b << 16); }
__device__ __forceinline__ s16x4 pack4(f32x4 v) { u32x2 w; w.x = cvtpk(v[0], v[1]); w.y = cvtpk(v[2], v[3]); return __builtin_bit_cast(s16x4, w); }

template <int CTRL> __device__ __forceinline__ float dpp_mov(float v) { return __int_as_float(__builtin_amdgcn_update_dpp(0, __float_as_int(v), CTRL, 0xf, 0xf, true)); }
__device__ __forceinline__ float row16_sum(float s) { s += dpp_mov<0xB1>(s); s += dpp_mov<0x4E>(s); s += dpp_mov<0x141>(s); s += dpp_mov<0x140>(s); return s; }
__device__ __forceinline__ void quarter_scan(float T, int qt, float& pre, float& post, float& tot) {
    auto r16 = __builtin_amdgcn_permlane16_swap(__float_as_uint(T), __float_as_uint(T), false, false);
    const float a = __uint_as_float(r16[0]), b = __uint_as_float(r16[1]);
    const float pr = a + b;
    auto r32 = __builtin_amdgcn_permlane32_swap(__float_as_uint(pr), __float_as_uint(pr), false, false);
    const float c = __uint_as_float(r32[0]), d = __uint_as_float(r32[1]);
    pre = qt == 0 ? 0.f : qt == 1 ? a : qt == 2 ? c : c + a;
    post = qt == 0 ? b + d : qt == 1 ? d : qt == 2 ? b : 0.f;
    tot = c + d;
}
struct Ptrs { const unsigned short* QQ; const unsigned short* HK; const unsigned short* HV; const unsigned short* HLF; const unsigned short* HSG; };
struct RawRegs { u32x4 a, b, c; };

template <bool OUT> __device__ __forceinline__ void g_load(RawRegs& R, const Ptrs& P, size_t row0, int hcol, int w, int lane) {
    const bool lo = w < 4; const size_t r = row0 + 4 * (w & 3) + (lane >> 4); const int c = hcol + 8 * (lane & 15);
    R.a = *(const u32x4*)((lo ? P.HLF : P.HK) + r * 1024 + c);
    if constexpr (OUT) { R.b = *(const u32x4*)((lo ? P.HV + r * 1024 : P.QQ + r * 2048) + c); if (lo) R.c = *(const u32x4*)(P.HSG + r * 1024 + c); }
    else { if (lo) R.b = *(const u32x4*)(P.HV + r * 1024 + c); }
}
template <bool OUT> __device__ __forceinline__ void raw_write(const RawRegs& R, char* slot, int w, int lane) {
    const bool lo = w < 4; const int d = (4 * (w & 3) + (lane >> 4)) * QROW + 16 * (lane & 15);
    *(u32x4*)(slot + (lo ? 0 : RAW_T) + d) = R.a;
    if constexpr (OUT) { *(u32x4*)(slot + (lo ? 2 * RAW_T : 3 * RAW_T) + d) = R.b; if (lo) *(u32x4*)(slot + 4 * RAW_T + d) = R.c; }
    else { if (lo) *(u32x4*)(slot + 2 * RAW_T + d) = R.b; }
}
template <bool OUT>
__device__ __forceinline__ float stage(const char* raw, char* set, int ch, int qt, float run, float (&sg)[4]) {
    float lf[4], kk[4], vv4[4], qq[4];
#pragma unroll
    for (int j = 0; j < 4; ++j) { const int o = (4 * qt + j) * QROW + ch * 2;
        lf[j] = (float)__builtin_bit_cast(_Float16, *(const unsigned short*)(raw + o));
        kk[j] = bf2f(*(const unsigned short*)(raw + RAW_T + o)); vv4[j] = bf2f(*(const unsigned short*)(raw + 2 * RAW_T + o));
        if constexpr (OUT) { qq[j] = bf2f(*(const unsigned short*)(raw + 3 * RAW_T + o)); sg[j] = bf2f(*(const unsigned short*)(raw + 4 * RAW_T + o)); } }
    float pre, post, tot;
    f32x4 kd, vv;
    if constexpr (OUT) {
        float c[4]; c[0] = lf[0]; c[1] = c[0] + lf[1]; c[2] = c[1] + lf[2]; c[3] = c[2] + lf[3];
        quarter_scan(c[3], qt, pre, post, tot);
#pragma unroll
        for (int j = 0; j < 4; ++j) { const float b = pre + c[j]; const int t = 4 * qt + j;
            kd[j] = kk[j] * __builtin_amdgcn_exp2f(tot - b); vv[j] = vv4[j];
            *(unsigned short*)(set + OFF_QH + t * QROW + ch * 2) = (unsigned short)(cvtpk(qq[j] * __builtin_amdgcn_exp2f(b), 0.f) & 0xffffu);
            *(unsigned short*)(set + OFF_KH + t * QROW + ch * 2) = (unsigned short)(cvtpk(kk[j] * __builtin_amdgcn_exp2f(fminf(-b, 100.f)), 0.f) & 0xffffu); }
        if (qt == 0) *(float*)(set + OFF_DV + ch * 4) = __builtin_amdgcn_exp2f(tot);
    } else {
        float e[4]; e[3] = 0.f; e[2] = lf[3]; e[1] = e[2] + lf[2]; e[0] = e[1] + lf[1];
        quarter_scan(e[0] + lf[0], qt, pre, post, tot);
#pragma unroll
        for (int j = 0; j < 4; ++j) { kd[j] = kk[j] * __builtin_amdgcn_exp2f(e[j] + post + run); vv[j] = vv4[j]; }
    }
    *(s16x4*)(set + OFF_KDT + ch * TROW + 8 * qt) = pack4(kd);
    *(s16x4*)(set + OFF_VT + ch * TROW + 8 * qt) = pack4(vv);
    return tot;
}

template <bool OUT>
__device__ __forceinline__ void run_item(char* lds, const Ptrs& P, unsigned short* OUTQ  , const float* gout, float* LST, float* DST, int item, int g, size_t m0, int h) {
    int tid = threadIdx.x; asm volatile("" : "+v"(tid));
    const int w = __builtin_amdgcn_readfirstlane(tid >> 6), lane = tid & 63, c16 = lane & 15, q = lane >> 4;
    const int ch = 16 * w + c16, hcol = h * 128;
    float* part = (float*)(lds + OFF_PART); char* rawb = lds + OFF_RAW; char* obuf = lds + OFF_OBUF; (void)obuf;
    constexpr int NSUB = 32;
#define HG_ROW(s) (m0 + 16 * (OUT ? (s) : (NSUB - 1 - (s))))
    RawRegs RA, RB; RA.a = RA.b = RA.c = RB.a = RB.b = RB.c = (u32x4){0u, 0u, 0u, 0u};
    g_load<OUT>(RA, P, HG_ROW(0), hcol, w, lane); g_load<OUT>(RB, P, HG_ROW(1), hcol, w, lane);
    f32x4 S[8];
#pragma unroll
    for (int kb = 0; kb < 8; ++kb) S[kb] = (f32x4){0.f, 0.f, 0.f, 0.f};
    if constexpr (OUT) {
        int gp = 0;
        for (; gp + 1 < g; gp += 2) { const int it0 = item - g + gp, it1 = it0 + 1;
#pragma unroll
            for (int kb = 0; kb < 8; ++kb) { const f32x4 d0 = *(const f32x4*)(DST + (size_t)it0 * 128 + 16 * kb + 4 * q), d1 = *(const f32x4*)(DST + (size_t)it1 * 128 + 16 * kb + 4 * q);
                const f32x4 l0 = *(const f32x4*)(LST + ((size_t)(it0 * 8 + w) * 8 + kb) * 256 + lane * 4), l1 = *(const f32x4*)(LST + ((size_t)(it1 * 8 + w) * 8 + kb) * 256 + lane * 4);
#pragma unroll
                for (int r = 0; r < 4; ++r) S[kb][r] = __builtin_amdgcn_exp2f(d1[r]) * (__builtin_amdgcn_exp2f(d0[r]) * S[kb][r] + l0[r]) + l1[r]; } }
        if (gp < g) { const int itp = item - g + gp;
#pragma unroll
            for (int kb = 0; kb < 8; ++kb) { const f32x4 dl = *(const f32x4*)(DST + (size_t)itp * 128 + 16 * kb + 4 * q);
                const f32x4 l4 = *(const f32x4*)(LST + ((size_t)(itp * 8 + w) * 8 + kb) * 256 + lane * 4);
#pragma unroll
                for (int r = 0; r < 4; ++r) S[kb][r] = __builtin_amdgcn_exp2f(dl[r]) * S[kb][r] + l4[r]; } }
    }
    float gv = 0.f; if constexpr (OUT) gv = gout[ch];
    float dsum = 0.f;
    raw_write<OUT>(RA, rawb, w, lane); raw_write<OUT>(RB, rawb + RAW_SLOT, w, lane);
    g_load<OUT>(RA, P, HG_ROW(2), hcol, w, lane); g_load<OUT>(RB, P, HG_ROW(3), hcol, w, lane);
    __syncthreads();
    float sgc[4] = {0.f, 0.f, 0.f, 0.f};
    dsum += stage<OUT>(rawb, lds, ch, q, dsum, sgc);
    __syncthreads();
#define HG_STEP(i, RX) do { \
        char* set = lds + ((i) & 1) * SET_BYTES; char* setn = lds + (((i) + 1) & 1) * SET_BYTES; \
        if ((i) + 2 < NSUB) { raw_write<OUT>(RX, rawb + (((i) + 2) % 3) * RAW_SLOT, w, lane); if ((i) + 4 < NSUB) g_load<OUT>(RX, P, HG_ROW((i) + 4), hcol, w, lane); } \
        const s16x4 vb = *(const s16x4*)(set + OFF_VT + ch * TROW + 8 * q); \
        f32x4 o = (f32x4){0.f, 0.f, 0.f, 0.f}; \
        if constexpr (OUT) { \
            f32x4 at = (f32x4){0.f, 0.f, 0.f, 0.f}; \
            _Pragma("unroll") for (int ks = 0; ks < 4; ++ks) { const bf16x8 a = *(const bf16x8*)(set + OFF_KH + c16 * QROW + (32 * ks + 8 * q) * 2), b = *(const bf16x8*)(set + OFF_QH + c16 * QROW + (32 * ks + 8 * q) * 2); \
                at = __builtin_amdgcn_mfma_f32_16x16x32_bf16(a, b, at, 0, 0, 0); } \
            _Pragma("unroll") for (int r = 0; r < 4; ++r) at[r] = (4 * q + r > c16) ? 0.f : at[r]; \
            _Pragma("unroll") for (int kb = 0; kb < 8; ++kb) { const s16x4 a = *(const s16x4*)(set + OFF_QH + c16 * QROW + (16 * kb + 4 * q) * 2); \
                o = __builtin_amdgcn_mfma_f32_16x16x16bf16_1k(a, pack4(S[kb]), o, 0, 0, 0); } \
            o = __builtin_amdgcn_mfma_f32_16x16x16bf16_1k(pack4(at), vb, o, 0, 0, 0); \
        } \
        _Pragma("unroll") for (int kb = 0; kb < 8; ++kb) { const s16x4 a = *(const s16x4*)(set + OFF_KDT + (16 * kb + c16) * TROW + 8 * q); \
            if constexpr (OUT) { const f32x4 dv = *(const f32x4*)(set + OFF_DV + (16 * kb + 4 * q) * 4); S[kb] = __builtin_amdgcn_mfma_f32_16x16x16bf16_1k(a, vb, S[kb] * dv, 0, 0, 0); } \
            else S[kb] = __builtin_amdgcn_mfma_f32_16x16x16bf16_1k(a, vb, S[kb], 0, 0, 0); } \
        if constexpr (OUT) { \
            _Pragma("unroll") for (int r = 0; r < 4; ++r) { const float s = row16_sum(o[r] * o[r]); \
                if (c16 == 0) part[(((i) & 1) * 8 + w) * 16 + 4 * q + r] = s; } \
        } \
        float sgn[4] = {0.f, 0.f, 0.f, 0.f}; \
        if ((i) + 1 < NSUB) dsum += stage<OUT>(rawb + (((i) + 1) % 3) * RAW_SLOT, setn, ch, q, dsum, sgn); \
        __syncthreads(); \
        if constexpr (OUT) { \
            _Pragma("unroll") for (int r = 0; r < 4; ++r) { float tot = 0.f; \
                _Pragma("unroll") for (int ww = 0; ww < 8; ++ww) tot += part[(((i) & 1) * 8 + ww) * 16 + 4 * q + r]; \
                const float rstd = __builtin_amdgcn_rsqf(tot * (1.f / 128.f) + NORM_EPS); \
                *(unsigned short*)(obuf + ((((i) & 3) * 16) + 4 * q + r) * QROW + ch * 2) = (unsigned short)(cvtpk(o[r] * rstd * gv * sgc[r], 0.f) & 0xffffu); } \
            _Pragma("unroll") for (int j = 0; j < 4; ++j) sgc[j] = sgn[j]; \
            if (((i) & 3) == 3) { __syncthreads();            \
                _Pragma("unroll") for (int k2 = 0; k2 < 2; ++k2) { const int id = tid + 512 * k2, row = id >> 4, c8 = id & 15; \
                    *(u32x4*)(OUTQ + (m0 + 16 * ((i) - 3) + row) * 2048 + hcol + 8 * c8) = *(const u32x4*)(obuf + row * QROW + 16 * c8); } } \
        } } while (0)
#pragma unroll 1
    for (int i = 0; i < NSUB; i += 2) { HG_STEP(i, RA); HG_STEP(i + 1, RB); }
#undef HG_STEP
#undef HG_ROW
    if constexpr (!OUT) {
#pragma unroll
        for (int kb = 0; kb < 8; ++kb) *(f32x4*)(LST + ((size_t)(item * 8 + w) * 8 + kb) * 256 + lane * 4) = S[kb];
        if (q == 0) DST[(size_t)item * 128 + ch] = dsum;
    }
    __syncthreads();
}
}


#ifndef H2_DEFER
#define H2_DEFER 1
#endif
namespace hg2 {
typedef short s16x4 __attribute__((ext_vector_type(4)));
typedef short bf16x8 __attribute__((ext_vector_type(8)));
typedef float f32x4 __attribute__((ext_vector_type(4)));
typedef unsigned u32x2 __attribute__((ext_vector_type(2)));
typedef unsigned u32x4 __attribute__((ext_vector_type(4)));
constexpr int C = 32, NCH = 16;
constexpr int QROW = 272, TROW = 80;
constexpr int OFF_QH = 0, OFF_KH = C * QROW, OFF_KDT = 2 * C * QROW, OFF_VT = OFF_KDT + 128 * TROW, OFF_DV = OFF_VT + 128 * TROW, OFF_ER = OFF_DV + 512, SET_BYTES = OFF_ER + 512;
constexpr int RAW_T = 16 * QROW, RAW_SLOT = 5 * RAW_T;
constexpr int OFF_RAW = SET_BYTES, OFF_PART = OFF_RAW + 3 * RAW_SLOT, OFF_OBUF = OFF_PART + 2 * 4 * C * 4, OFF_SG = OFF_OBUF + 64 * QROW  , LDS_BYTES = OFF_SG + 2 * C * QROW;
static_assert(SET_BYTES % 16 == 0 && OFF_KDT % 16 == 0 && OFF_VT % 16 == 0 && OFF_DV % 16 == 0 && OFF_RAW % 16 == 0 && OFF_PART % 16 == 0 && OFF_OBUF % 16 == 0 && LDS_BYTES <= 143360, "hg2 LDS map");
typedef float f32x2_t __attribute__((ext_vector_type(2))); typedef __bf16 bf16x2_t __attribute__((ext_vector_type(2)));
__device__ __forceinline__ unsigned cvtpk(float lo, float hi) { f32x2_t v = {lo, hi}; bf16x2_t b = __builtin_convertvector(v, bf16x2_t); return __builtin_bit_cast(unsigned, b); }
__device__ __forceinline__ float bf2f(unsigned short b) { return __uint_as_float((unsigned)b << 16); }
__device__ __forceinline__ s16x4 pack4(f32x4 v) { u32x2 w; w.x = cvtpk(v[0], v[1]); w.y = cvtpk(v[2], v[3]); return __builtin_bit_cast(s16x4, w); }
template <int CTRL> __device__ __forceinline__ float dpp_mov(float v) { return __int_as_float(__builtin_amdgcn_update_dpp(0, __float_as_int(v), CTRL, 0xf, 0xf, true)); }
__device__ __forceinline__ float row16_sum(float s) { s += dpp_mov<0xB1>(s); s += dpp_mov<0x4E>(s); s += dpp_mov<0x141>(s); s += dpp_mov<0x140>(s); return s; }

struct Ptrs { const unsigned short* QQ; const unsigned short* HK; const unsigned short* HV; const unsigned short* HLF; const unsigned short* HSG; };
#define U4(x) __builtin_bit_cast(u32x4, (x))
#define F4(x) __builtin_bit_cast(f32x4, (x))
template <bool OUT> __device__ __forceinline__ void g_load(f32x4* R, const Ptrs& P, size_t row0, int hcol, int sw, int lane) {
    const size_t r = row0 + 4 * sw + (lane >> 4); const int c = hcol + 8 * (lane & 15);
    R[0] = *(const f32x4*)(P.HLF + r * 1024 + c); R[1] = *(const f32x4*)(P.HK + r * 1024 + c); R[2] = *(const f32x4*)(P.HV + r * 1024 + c);
    if constexpr (OUT) { R[3] = *(const f32x4*)(P.QQ + r * 2048 + c); R[4] = *(const f32x4*)(P.HSG + r * 1024 + c); }
}
template <bool OUT> __device__ __forceinline__ void raw_write(const f32x4* R, char* slot, int sw, int lane) {
    const int d = (4 * sw + (lane >> 4)) * QROW + 16 * (lane & 15);
    *(f32x4*)(slot + d) = R[0]; *(f32x4*)(slot + RAW_T + d) = R[1]; *(f32x4*)(slot + 2 * RAW_T + d) = R[2];
    if constexpr (OUT) { *(f32x4*)(slot + 3 * RAW_T + d) = R[3]; *(f32x4*)(slot + 4 * RAW_T + d) = R[4]; }
}
template <bool OUT>
__device__ __forceinline__ float stage_compute(f32x4* Zr, float& zdv, float& zer, const char* raw, int ch, int hf, float run) {
    const char* rp = raw + ch * 2;
    float c[16];
    float tot, pre = 0.f, bref = 0.f, post = 0.f;
    if constexpr (OUT) {
        c[0] = (float)__builtin_bit_cast(_Float16, *(const unsigned short*)rp);
#pragma unroll
        for (int j = 1; j < 16; ++j) c[j] = c[j - 1] + (float)__builtin_bit_cast(_Float16, *(const unsigned short*)(rp + j * QROW));
        auto rr = __builtin_amdgcn_permlane32_swap(__float_as_uint(c[15]), __float_as_uint(c[15]), false, false);
        const float t0 = __uint_as_float(rr[0]), t1 = __uint_as_float(rr[1]);
        tot = t0 + t1; bref = t0; pre = hf ? t0 : 0.f;
        zdv = __builtin_amdgcn_exp2f(tot); zer = __builtin_amdgcn_exp2f(bref);
    } else {
        c[15] = 0.f;
#pragma unroll
        for (int j = 14; j >= 0; --j) c[j] = c[j + 1] + (float)__builtin_bit_cast(_Float16, *(const unsigned short*)(rp + (j + 1) * QROW));
        const float T = c[0] + (float)__builtin_bit_cast(_Float16, *(const unsigned short*)rp);
        auto rr = __builtin_amdgcn_permlane32_swap(__float_as_uint(T), __float_as_uint(T), false, false);
        const float t0 = __uint_as_float(rr[0]), t1 = __uint_as_float(rr[1]);
        tot = t0 + t1; post = (hf ? 0.f : t1) + run;
        zdv = 0.f; zer = 0.f;
    }
#pragma unroll
    for (int hh = 0; hh < 2; ++hh) {
        u32x4 qh, kh, sg, kd, vv;
#pragma unroll
        for (int jj = 0; jj < 4; ++jj) { const int j = 4 * hh + jj; const char* r0 = rp + 2 * j * QROW; const char* r1 = r0 + QROW;
            const float k0 = bf2f(*(const unsigned short*)(r0 + RAW_T)), k1 = bf2f(*(const unsigned short*)(r1 + RAW_T));
            vv[jj] = (unsigned)*(const unsigned short*)(r0 + 2 * RAW_T) | ((unsigned)*(const unsigned short*)(r1 + 2 * RAW_T) << 16);
            if constexpr (OUT) {
                const float q0 = bf2f(*(const unsigned short*)(r0 + 3 * RAW_T)), q1 = bf2f(*(const unsigned short*)(r1 + 3 * RAW_T));
                sg[jj] = (unsigned)*(const unsigned short*)(r0 + 4 * RAW_T) | ((unsigned)*(const unsigned short*)(r1 + 4 * RAW_T) << 16);
                const float b0 = pre + c[2 * j], b1 = pre + c[2 * j + 1];
                kd[jj] = cvtpk(k0 * __builtin_amdgcn_exp2f(tot - b0), k1 * __builtin_amdgcn_exp2f(tot - b1));
                qh[jj] = cvtpk(q0 * __builtin_amdgcn_exp2f(fminf(b0 - bref, 100.f)), q1 * __builtin_amdgcn_exp2f(fminf(b1 - bref, 100.f)));
                kh[jj] = cvtpk(k0 * __builtin_amdgcn_exp2f(fminf(bref - b0, 100.f)), k1 * __builtin_amdgcn_exp2f(fminf(bref - b1, 100.f)));
            } else {
                kd[jj] = cvtpk(k0 * __builtin_amdgcn_exp2f(c[2 * j] + post), k1 * __builtin_amdgcn_exp2f(c[2 * j + 1] + post));
            } }
        if constexpr (OUT) { Zr[hh] = F4(qh); Zr[2 + hh] = F4(kh); Zr[4 + hh] = F4(sg); }
        Zr[6 + hh] = F4(kd); Zr[8 + hh] = F4(vv);
        __builtin_amdgcn_sched_barrier(0);
    }
    return tot;
}
template <bool OUT>
__device__ __forceinline__ void stage_write(const f32x4* Zr, float zdv, float zer, char* set, char* sgb, int ch, int hf) {
    *(f32x4*)(set + OFF_KDT + ch * TROW + 32 * hf) = Zr[6]; *(f32x4*)(set + OFF_KDT + ch * TROW + 32 * hf + 16) = Zr[7];
    *(f32x4*)(set + OFF_VT + ch * TROW + 32 * hf) = Zr[8]; *(f32x4*)(set + OFF_VT + ch * TROW + 32 * hf + 16) = Zr[9];
    if constexpr (OUT) {
#pragma unroll
        for (int j = 0; j < 8; ++j) { const int o = (16 * hf + 2 * j) * QROW + ch * 2;
            const unsigned qw = U4(Zr[j >> 2])[j & 3], kw = U4(Zr[2 + (j >> 2)])[j & 3], sw_ = U4(Zr[4 + (j >> 2)])[j & 3];
            *(unsigned short*)(set + OFF_QH + o) = (unsigned short)(qw & 0xffffu); *(unsigned short*)(set + OFF_QH + o + QROW) = (unsigned short)(qw >> 16);
            *(unsigned short*)(set + OFF_KH + o) = (unsigned short)(kw & 0xffffu); *(unsigned short*)(set + OFF_KH + o + QROW) = (unsigned short)(kw >> 16);
            *(unsigned short*)(sgb + o) = (unsigned short)(sw_ & 0xffffu); *(unsigned short*)(sgb + o + QROW) = (unsigned short)(sw_ >> 16); }
        if (hf == 0) { *(float*)(set + OFF_DV + ch * 4) = zdv; *(float*)(set + OFF_ER + ch * 4) = zer; }
    }
}

template <bool OUT>
__device__ __forceinline__ void run_item(char* lds, const Ptrs& P, unsigned short* OUTQ, const float* gout, float* LST, float* DST, int item, int g, size_t m0, int h) {
    int tid = threadIdx.x; asm volatile("" : "+v"(tid));
    const int w = __builtin_amdgcn_readfirstlane(tid >> 6), lane = tid & 63, c16 = lane & 15, q = lane >> 4;
    const bool stager = w >= 4; const int cw = w & 3;
    const int hcol = h * 128;
    char* set = lds; char* rawb = lds + OFF_RAW; float* part = (float*)(lds + OFF_PART); char* obuf = lds + OFF_OBUF;
    const int ch = 32 * cw + (lane & 31), hf = lane >> 5;
#define H2_ROW(vh) (m0 + 16 * (OUT ? (vh) : (2 * (NCH - 1 - ((vh) >> 1)) + ((vh) & 1))))
    f32x4 U[20];
#pragma unroll
    for (int k = 0; k < 20; ++k) U[k] = (f32x4){0.f, 0.f, 0.f, 0.f};
#define S_(vt, kb) U[8 * (vt) + (kb)]
#define O_(vt, tt) U[16 + 2 * (vt) + (tt)]
    float gv[2] = {0.f, 0.f};
    if constexpr (OUT) {
        if (!stager) {
            gv[0] = gout[32 * cw + c16]; gv[1] = gout[32 * cw + 16 + c16];
            for (int gp = 0; gp < g; ++gp) { const int itp = item - g + gp;
#pragma unroll
                for (int kb = 0; kb < 8; ++kb) { const f32x4 dl = *(const f32x4*)(DST + (size_t)itp * 128 + 16 * kb + 4 * q);
                    f32x4 e4; e4[0] = __builtin_amdgcn_exp2f(dl[0]); e4[1] = __builtin_amdgcn_exp2f(dl[1]); e4[2] = __builtin_amdgcn_exp2f(dl[2]); e4[3] = __builtin_amdgcn_exp2f(dl[3]);
#pragma unroll
                    for (int vt = 0; vt < 2; ++vt) { const f32x4 l4 = *(const f32x4*)(LST + ((size_t)((itp * 4 + cw) * 2 + vt) * 8 + kb) * 256 + lane * 4);
                        S_(vt, kb) = e4 * S_(vt, kb) + l4; } } }
        }
    }
    f32x4* const GA = U; f32x4* const GB = U + 5; f32x4* const Z = U + 10;
    float dsum = 0.f, zdv = 0.f, zer = 0.f;
    if (stager) { g_load<OUT>(GA, P, H2_ROW(0), hcol, cw, lane); g_load<OUT>(GB, P, H2_ROW(1), hcol, cw, lane);
        raw_write<OUT>(GA, rawb, cw, lane); raw_write<OUT>(GB, rawb + RAW_SLOT, cw, lane);
        g_load<OUT>(GA, P, H2_ROW(2), hcol, cw, lane); g_load<OUT>(GB, P, H2_ROW(3), hcol, cw, lane); }
    __syncthreads();
    if (stager) { dsum += stage_compute<OUT>(Z, zdv, zer, rawb + hf * RAW_SLOT, ch, hf, dsum);
        raw_write<OUT>(GA, rawb + 2 * RAW_SLOT, cw, lane); g_load<OUT>(GA, P, H2_ROW(4), hcol, cw, lane); }
    __syncthreads();
    if (stager) { stage_write<OUT>(Z, zdv, zer, set, lds + OFF_SG, ch, hf);
        raw_write<OUT>(GB, rawb, cw, lane); g_load<OUT>(GB, P, H2_ROW(5), hcol, cw, lane); }
    __syncthreads();
#pragma unroll 1
    for (int i = 0; i < NCH; ++i) {
        if (stager) {
            if (2 * i + 4 < 2 * NCH) { raw_write<OUT>(GA, rawb + ((2 * i + 4) % 3) * RAW_SLOT, cw, lane); if (2 * i + 6 < 2 * NCH) g_load<OUT>(GA, P, H2_ROW(2 * i + 6), hcol, cw, lane); }
            if (i + 1 < NCH) dsum += stage_compute<OUT>(Z, zdv, zer, rawb + ((2 * i + 2 + hf) % 3) * RAW_SLOT, ch, hf, dsum);
        } else {
            if constexpr (OUT) {
                f32x4 a00 = (f32x4){0.f, 0.f, 0.f, 0.f}, a01 = a00, a11 = a00;
#pragma unroll
                for (int ks = 0; ks < 4; ++ks) { const int ko = (32 * ks + 8 * q) * 2;
                    const bf16x8 k0 = *(const bf16x8*)(set + OFF_KH + c16 * QROW + ko), k1 = *(const bf16x8*)(set + OFF_KH + (16 + c16) * QROW + ko);
                    const bf16x8 q0 = *(const bf16x8*)(set + OFF_QH + c16 * QROW + ko), q1 = *(const bf16x8*)(set + OFF_QH + (16 + c16) * QROW + ko);
                    a00 = __builtin_amdgcn_mfma_f32_16x16x32_bf16(k0, q0, a00, 0, 0, 0); a01 = __builtin_amdgcn_mfma_f32_16x16x32_bf16(k0, q1, a01, 0, 0, 0); a11 = __builtin_amdgcn_mfma_f32_16x16x32_bf16(k1, q1, a11, 0, 0, 0); }
#pragma unroll
                for (int r = 0; r < 4; ++r) { const bool drop = 4 * q + r > c16; a00[r] = drop ? 0.f : a00[r]; a11[r] = drop ? 0.f : a11[r]; }
                const s16x4 p00 = pack4(a00), p01 = pack4(a01), p11 = pack4(a11);
#pragma unroll
                for (int vt = 0; vt < 2; ++vt) { O_(vt, 0) = (f32x4){0.f, 0.f, 0.f, 0.f}; O_(vt, 1) = (f32x4){0.f, 0.f, 0.f, 0.f}; }
#pragma unroll
                for (int kb = 0; kb < 8; ++kb) { const f32x4 er = *(const f32x4*)(set + OFF_ER + (16 * kb + 4 * q) * 4);
                    const s16x4 qa0 = *(const s16x4*)(set + OFF_QH + c16 * QROW + (16 * kb + 4 * q) * 2), qa1 = *(const s16x4*)(set + OFF_QH + (16 + c16) * QROW + (16 * kb + 4 * q) * 2);
#pragma unroll
                    for (int vt = 0; vt < 2; ++vt) {
#if defined(DBG_NO_ER)
                        const s16x4 sb = pack4(S_(vt, kb));
#elif defined(DBG_ZERO_S)
                        const s16x4 sb = pack4(S_(vt, kb) * 0.f + er * 1e-3f);
#else
                        const s16x4 sb = pack4(S_(vt, kb) * er);
#endif

#ifndef DBG_NO_INTER
                        O_(vt, 0) = __builtin_amdgcn_mfma_f32_16x16x16bf16_1k(qa0, sb, O_(vt, 0), 0, 0, 0); O_(vt, 1) = __builtin_amdgcn_mfma_f32_16x16x16bf16_1k(qa1, sb, O_(vt, 1), 0, 0, 0);
#endif
                    } }
#pragma unroll
                for (int vt = 0; vt < 2; ++vt) { const char* vr = set + OFF_VT + (32 * cw + 16 * vt + c16) * TROW + 8 * q;
                    const s16x4 va = *(const s16x4*)vr, vbh = *(const s16x4*)(vr + 32);
#ifndef DBG_NO_INTRA
                    O_(vt, 0) = __builtin_amdgcn_mfma_f32_16x16x16bf16_1k(p00, va, O_(vt, 0), 0, 0, 0);
                    O_(vt, 1) = __builtin_amdgcn_mfma_f32_16x16x16bf16_1k(p01, va, O_(vt, 1), 0, 0, 0);
                    O_(vt, 1) = __builtin_amdgcn_mfma_f32_16x16x16bf16_1k(p11, vbh, O_(vt, 1), 0, 0, 0);
#endif
                }
            }
            __builtin_amdgcn_sched_barrier(0);
            const bf16x8 vb0 = *(const bf16x8*)(set + OFF_VT + (32 * cw + c16) * TROW + 16 * q), vb1 = *(const bf16x8*)(set + OFF_VT + (32 * cw + 16 + c16) * TROW + 16 * q);
#pragma unroll
            for (int kb = 0; kb < 8; ++kb) { const bf16x8 a = *(const bf16x8*)(set + OFF_KDT + (16 * kb + c16) * TROW + 16 * q);
                if constexpr (OUT) { const f32x4 dv = *(const f32x4*)(set + OFF_DV + (16 * kb + 4 * q) * 4);
                    S_(0, kb) = __builtin_amdgcn_mfma_f32_16x16x32_bf16(a, vb0, S_(0, kb) * dv, 0, 0, 0); S_(1, kb) = __builtin_amdgcn_mfma_f32_16x16x32_bf16(a, vb1, S_(1, kb) * dv, 0, 0, 0); }
                else { S_(0, kb) = __builtin_amdgcn_mfma_f32_16x16x32_bf16(a, vb0, S_(0, kb), 0, 0, 0); S_(1, kb) = __builtin_amdgcn_mfma_f32_16x16x32_bf16(a, vb1, S_(1, kb), 0, 0, 0); } }
#ifdef DBG_CHECK_S
            if constexpr (OUT) { bool bad = false;
#pragma unroll
                for (int vt = 0; vt < 2; ++vt)
#pragma unroll
                    for (int kb = 0; kb < 8; ++kb)
#pragma unroll
                        for (int r = 0; r < 4; ++r) bad |= !(fabsf(S_(vt, kb)[r]) < 1e30f);
                if (bad) { O_(0, 0)[0] = __builtin_nanf(""); } }
#endif
            if constexpr (OUT) {
#pragma unroll
                for (int tt = 0; tt < 2; ++tt)
#pragma unroll
                    for (int r = 0; r < 4; ++r) { const float s = row16_sum(O_(0, tt)[r] * O_(0, tt)[r] + O_(1, tt)[r] * O_(1, tt)[r]);
                        if (c16 == 0) part[((i & 1) * 4 + cw) * C + 16 * tt + 4 * q + r] = s;
#if H2_DEFER
#pragma unroll
                        for (int vt = 0; vt < 2; ++vt) *(unsigned short*)(obuf + ((i & 1) * C + 16 * tt + 4 * q + r) * QROW + (32 * cw + 16 * vt + c16) * 2) = (unsigned short)(cvtpk(O_(vt, tt)[r] * gv[vt], 0.f) & 0xffffu);
#endif
                    }
            }
        }
        __syncthreads();
        if (stager) {
            if (i + 1 < NCH) stage_write<OUT>(Z, zdv, zer, set, lds + OFF_SG + ((i + 1) & 1) * C * QROW, ch, hf);
            if (2 * i + 5 < 2 * NCH) { raw_write<OUT>(GB, rawb + ((2 * i + 5) % 3) * RAW_SLOT, cw, lane); if (2 * i + 7 < 2 * NCH) g_load<OUT>(GB, P, H2_ROW(2 * i + 7), hcol, cw, lane); }
        }
#if H2_DEFER
        if constexpr (OUT) {
            const int row = tid >> 4, c8 = tid & 15;
            const float tot = (part[((i & 1) * 4 + 0) * C + row] + part[((i & 1) * 4 + 1) * C + row]) + (part[((i & 1) * 4 + 2) * C + row] + part[((i & 1) * 4 + 3) * C + row]);
            const float rstd = __builtin_amdgcn_rsqf(tot * (1.f / 128.f) + NORM_EPS);
            const u32x4 o8 = *(const u32x4*)(obuf + ((i & 1) * C + row) * QROW + 16 * c8), s8 = *(const u32x4*)(lds + OFF_SG + (i & 1) * C * QROW + row * QROW + 16 * c8);
            u32x4 w;
#pragma unroll
            for (int j = 0; j < 4; ++j) w[j] = cvtpk(__uint_as_float(o8[j] << 16) * rstd * __uint_as_float(s8[j] << 16), __uint_as_float(o8[j] & 0xffff0000u) * rstd * __uint_as_float(s8[j] & 0xffff0000u));
            *(u32x4*)(OUTQ + (m0 + 32 * i + row) * 2048 + hcol + 8 * c8) = w;
        }
#else
        else if constexpr (OUT) {
#pragma unroll
            for (int tt = 0; tt < 2; ++tt)
#pragma unroll
                for (int r = 0; r < 4; ++r) { const int t = 16 * tt + 4 * q + r;
                    const float tot = (part[((i & 1) * 4 + 0) * C + t] + part[((i & 1) * 4 + 1) * C + t]) + (part[((i & 1) * 4 + 2) * C + t] + part[((i & 1) * 4 + 3) * C + t]);
                    const float rstd = __builtin_amdgcn_rsqf(tot * (1.f / 128.f) + NORM_EPS);
#pragma unroll
                    for (int vt = 0; vt < 2; ++vt) { const float sgx = bf2f(*(const unsigned short*)(lds + OFF_SG + (i & 1) * C * QROW + t * QROW + (32 * cw + 16 * vt + c16) * 2));
                        *(unsigned short*)(obuf + ((i & 1) * C + t) * QROW + (32 * cw + 16 * vt + c16) * 2) = (unsigned short)(cvtpk(O_(vt, tt)[r] * rstd * gv[vt] * sgx, 0.f) & 0xffffu); } }
        }
#endif
        __syncthreads();
#if !H2_DEFER
        if constexpr (OUT) {
            if (i & 1) {
#pragma unroll
                for (int k2 = 0; k2 < 2; ++k2) { const int id = tid + 512 * k2, row = id >> 4, c8 = id & 15;
                    *(u32x4*)(OUTQ + (m0 + 32 * (i - 1) + row) * 2048 + hcol + 8 * c8) = *(const u32x4*)(obuf + row * QROW + 16 * c8); } }
        }
#endif
    }
#undef H2_ROW
    if constexpr (!OUT) {
        if (!stager) {
#pragma unroll
            for (int vt = 0; vt < 2; ++vt)
#pragma unroll
                for (int kb = 0; kb < 8; ++kb) *(f32x4*)(LST + ((size_t)((item * 4 + cw) * 2 + vt) * 8 + kb) * 256 + lane * 4) = S_(vt, kb);
        } else if (hf == 0) DST[(size_t)item * 128 + ch] = dsum;
    }
    __syncthreads();
#undef S_
#undef O_
}
#undef U4
#undef F4
}


struct Frame {
    LAS unsigned char* lds;
    volatile LAS unsigned* MISC;
    gu32* ctl;
    int tid, lane, wave;
    int vcu, G;
};

__device__ __forceinline__ float wave_sum(float v) { return pg8::rows4_sum(pg8::row16_sum(v)); }
__device__ __forceinline__ void p0_transpose64(const float* W, int ldw, int k0, int ncol0, bf16* WT, int ldt, int drow, int dk0, LAS unsigned char* scr, int lane, const float* ksc = nullptr) {
    const int n4 = lane & 15, qk = lane >> 4;
    const GAS f32x4* src = (const GAS f32x4*)(W + (size_t)(k0 + 2 * qk) * ldw + ncol0 + 4 * n4);
    f32x4 v[16];
#pragma unroll
    for (int p = 0; p < 8; ++p) { v[2 * p] = src[(size_t)(8 * p) * ldw / 4]; v[2 * p + 1] = src[(size_t)(8 * p + 1) * ldw / 4]; }
    if (ksc) {
#pragma unroll
        for (int p = 0; p < 8; ++p) { const float s0 = ksc[k0 + 2 * qk + 8 * p], s1 = ksc[k0 + 2 * qk + 8 * p + 1]; v[2 * p] = v[2 * p] * s0; v[2 * p + 1] = v[2 * p + 1] * s1; } }
#pragma unroll
    for (int p = 0; p < 8; ++p)
#pragma unroll
        for (int j = 0; j < 4; ++j) *(LAS unsigned*)(scr + (4 * n4 + j) * 132 + 16 * p + 4 * qk) = pk2(v[2 * p][j], v[2 * p + 1][j]);
    LDS_WAIT(); asm volatile("" ::: "memory");
    const int c = lane & 7;
#pragma unroll
    for (int j = 0; j < 8; ++j) { const int n = (lane >> 3) + 8 * j; const LAS unsigned* s = (const LAS unsigned*)(scr + n * 132 + 16 * c);
        v4u o; o.x = s[0]; o.y = s[1]; o.z = s[2]; o.w = s[3];
        *(GAS v4u*)(WT + (size_t)(drow + n) * ldt + dk0 + k0 + 8 * c) = o; }
    LDS_WAIT(); asm volatile("" ::: "memory");
}
__device__ __forceinline__ void rms_row_to_bf16(const float* xrow, const float* g, bf16* orow, int lane) {
    const GAS f32x4* xr = (const GAS f32x4*)xrow + lane; const GAS f32x4* gr = (const GAS f32x4*)g + lane;
    f32x4 v[4]; float s = 0.f;
#pragma unroll
    for (int j = 0; j < 4; ++j) { v[j] = xr[64 * j]; s += (v[j].x * v[j].x + v[j].y * v[j].y) + (v[j].z * v[j].z + v[j].w * v[j].w); }
    const float rstd = 1.f / sqrtf(wave_sum(s) * (1.f / DM) + NORM_EPS);
    GAS unsigned long long* o8 = (GAS unsigned long long*)orow + lane;
#pragma unroll
    for (int j = 0; j < 4; ++j) { const f32x4 gg = gr[64 * j];
        o8[64 * j] = (unsigned long long)pk2(v[j].x * rstd * gg.x, v[j].y * rstd * gg.y) | ((unsigned long long)pk2(v[j].z * rstd * gg.z, v[j].w * rstd * gg.w) << 32); }
}

__host__ __device__ __forceinline__ int win_row(int c) { if (c >= 4096 && c < 7168) return c - 4096; if (c < 4096) return 3072 + c; const int gi = c - 7168, hi = gi >= 1024, g2 = gi & 1023; return 7168 + 256 * (g2 >> 7) + 128 * hi + (g2 & 127); }
struct TrDesc { const float* W; int ldw, k0, ncol0; bf16* WT; int ldt, drow, dk0; };
__device__ __forceinline__ void tr_load(f32x4 (&v)[16], const TrDesc& d, int lane) {
    const int n4 = lane & 15, qk = lane >> 4;
    const GAS f32x4* src = (const GAS f32x4*)(d.W + (size_t)(d.k0 + 2 * qk) * d.ldw + d.ncol0 + 4 * n4);
#pragma unroll
    for (int p = 0; p < 8; ++p) { v[2 * p] = src[(size_t)(8 * p) * d.ldw / 4]; v[2 * p + 1] = src[(size_t)(8 * p + 1) * d.ldw / 4]; }
}
__device__ __forceinline__ void tr_store(const f32x4 (&v)[16], const TrDesc& d, LAS unsigned char* scr, int lane) {
    const int n4 = lane & 15, qk = lane >> 4;
#pragma unroll
    for (int p = 0; p < 8; ++p)
#pragma unroll
        for (int j = 0; j < 4; ++j) *(LAS unsigned*)(scr + (4 * n4 + j) * 132 + 16 * p + 4 * qk) = pk2(v[2 * p][j], v[2 * p + 1][j]);
    LDS_WAIT(); asm volatile("" ::: "memory");
    const int c = lane & 7;
#pragma unroll
    for (int j = 0; j < 8; ++j) { const int n = (lane >> 3) + 8 * j; const LAS unsigned* s = (const LAS unsigned*)(scr + n * 132 + 16 * c);
        v4u o; o.x = s[0]; o.y = s[1]; o.z = s[2]; o.w = s[3];
        *(GAS v4u*)(d.WT + (size_t)(d.drow + n) * d.ldt + d.dk0 + d.k0 + 8 * c) = o; }
    LDS_WAIT(); asm volatile("" ::: "memory");
}
__device__ __forceinline__ void h2_load(f32x4 (&v)[16], const float* x, int row, int lane) {
    const GAS f32x4* xr = (const GAS f32x4*)(x + (size_t)row * DM) + lane;
#pragma unroll
    for (int j = 0; j < 4; ++j) { v[j] = xr[64 * j]; v[4 + j] = xr[256 + 64 * j]; }
}
__device__ __forceinline__ void h2_store(const f32x4 (&v)[16], const float* g, bf16* HBp, int row, int lane) {
    const GAS f32x4* gr = (const GAS f32x4*)g + lane;
#pragma unroll
    for (int rr = 0; rr < 2; ++rr) { float s = 0.f;
#pragma unroll
        for (int j = 0; j < 4; ++j) { const f32x4 t = v[4 * rr + j]; s += (t.x * t.x + t.y * t.y) + (t.z * t.z + t.w * t.w); }
        const float rstd = 1.f / sqrtf(wave_sum(s) * (1.f / DM) + NORM_EPS);
        GAS unsigned long long* o8 = (GAS unsigned long long*)(HBp + (size_t)(row + rr) * DM) + lane;
#pragma unroll
        for (int j = 0; j < 4; ++j) { const f32x4 gg = gr[64 * j]; const f32x4 t = v[4 * rr + j];
            o8[64 * j] = (unsigned long long)pk2(t.x * rstd * gg.x, t.y * rstd * gg.y) | ((unsigned long long)pk2(t.z * rstd * gg.z, t.w * rstd * gg.w) << 32); } }
}


__device__ __forceinline__ int t5_bucket(int n) {
    if (n < 16) return n;
    int b = 15;
    b += n >= 16; b += n >= 19; b += n >= 21; b += n >= 24; b += n >= 27; b += n >= 31; b += n >= 35; b += n >= 40;
    b += n >= 46; b += n >= 52; b += n >= 59; b += n >= 67; b += n >= 77; b += n >= 87; b += n >= 99; b += n >= 113;
    return b;
}
__device__ __forceinline__ void naive_attn_row(int r, bool active, int tid, LAS float* sm, const bf16* AK, const bf16* AV, bf16* QQ, const float* KMEAN, const float* table) {
    LAS float* qs = sm; LAS float* gate = sm + 128; LAS int* sel = (LAS int*)(sm + 144); LAS float* bias_s = sm + 160; LAS float* lg = sm + 192; LAS float* red = sm + 192 + 1024;
    const int t = r % SEQ, bh = r / SEQ, h = bh % NH, b = bh / NH;
    const size_t m = (size_t)b * SEQ + t; const int c = t >> 8;
    if (tid < 128) qs[tid] = bf2f(QQ[m * 2048 + 1024 + h * 128 + tid]);
    if (tid < 32) bias_s[tid] = table[tid * 8 + h];
    __syncthreads();
    if (tid < 16) { float g = -INFINITY; if (tid < c) { g = 0.f; const float* km = KMEAN + ((size_t)bh * NBLK + tid) * HD; for (int d = 0; d < 128; ++d) g += qs[d] * km[d]; } gate[tid] = g; }
    __syncthreads();
    if (tid == 0) { unsigned used = 0u;
        for (int s = 0; s < 3; ++s) { int best = -1; float bv = 0.f; for (int n = 0; n < 16; ++n) if (!((used >> n) & 1u)) { const float gv = gate[n]; if (best < 0 || gv > bv) { best = n; bv = gv; } } used |= 1u << best; sel[s] = best; } }
    __syncthreads();
    for (int s = 0; s < 4; ++s) {
        int blk; bool valid;
        if (s == 0) { blk = c; valid = tid <= (t & 255); } else { blk = sel[s - 1]; valid = blk < c; }
        float logit = -INFINITY;
        if (valid) { const int pos = blk * 256 + tid; const bf16* kr = AK + ((size_t)b * SEQ + pos) * 1024 + h * 128; float dot = 0.f;
            for (int d = 0; d < 128; d += 8) { const v4u w = *(const GAS v4u*)(kr + d);
                dot += qs[d] * __uint_as_float(w.x << 16) + qs[d + 1] * __uint_as_float(w.x & 0xffff0000u) + qs[d + 2] * __uint_as_float(w.y << 16) + qs[d + 3] * __uint_as_float(w.y & 0xffff0000u)
                     + qs[d + 4] * __uint_as_float(w.z << 16) + qs[d + 5] * __uint_as_float(w.z & 0xffff0000u) + qs[d + 6] * __uint_as_float(w.w << 16) + qs[d + 7] * __uint_as_float(w.w & 0xffff0000u); }
            logit = dot * ATT_SCALE + bias_s[t5_bucket(t - pos)]; }
        lg[s * 256 + tid] = logit;
    }
    __syncthreads();
    float mx = fmaxf(fmaxf(lg[tid], lg[256 + tid]), fmaxf(lg[512 + tid], lg[768 + tid]));
    red[tid] = mx; __syncthreads();
    for (int o = 128; o > 0; o >>= 1) { if (tid < o) red[tid] = fmaxf(red[tid], red[tid + o]); __syncthreads(); }
    mx = red[0]; __syncthreads();
    float ps = 0.f;
    for (int s = 0; s < 4; ++s) { const float p = __expf(lg[s * 256 + tid] - mx); lg[s * 256 + tid] = p; ps += p; }
    red[tid] = ps; __syncthreads();
    for (int o = 128; o > 0; o >>= 1) { if (tid < o) red[tid] += red[tid + o]; __syncthreads(); }
    const float tot = red[0];
    if (tid < 128) { float acc = 0.f;
        for (int s = 0; s < 4; ++s) { const int blk = (s == 0) ? c : sel[s - 1]; if (s > 0 && blk >= c) continue;
            const bf16* vr = AV + ((size_t)b * SEQ + blk * 256) * 1024 + h * 128 + tid;
            for (int j = 0; j < 256; ++j) { const float p = lg[s * 256 + j]; if (p != 0.f) acc += p * bf2f(vr[(size_t)j * 1024]); } }
        if (active) QQ[m * 2048 + 1024 + h * 128 + tid] = (bf16)f2bf(acc / tot); }
    __syncthreads();
}

#ifndef MK_NAIVE_ATTN
#define MK_NAIVE_ATTN 0
#endif
#ifndef MK_NAIVE_HGRN
#define MK_NAIVE_HGRN 0
#endif
#ifndef PROBE_DUP
#define PROBE_DUP 0
#endif
#ifndef PROBE_T
#define PROBE_T -1
#endif
#ifndef PROBE_BLK
#define PROBE_BLK 0
#endif
#ifndef MK_P0_PIPE
#define MK_P0_PIPE 0
#endif
#ifndef PROBE_P0
#define PROBE_P0 0
#endif
#ifndef MK_ALIGN_P1A
#define MK_ALIGN_P1A true
#endif
#ifndef MK_ALIGN_P8
#define MK_ALIGN_P8 true
#endif
#ifndef MK_ALIGN_1U
#define MK_ALIGN_1U true
#endif
#ifndef MK_SP2
#define MK_SP2 true
#endif
#ifndef MK_WGM_P1B
#define MK_WGM_P1B 4
#endif
#ifndef MK_WGM_P1A
#define MK_WGM_P1A 4
#endif
#ifndef MK_WGM_P8
#define MK_WGM_P8 4
#endif
#ifndef MK_WGM_1U
#define MK_WGM_1U 4
#endif
#ifndef MK_HG2
#define MK_HG2 1
#endif
#ifndef MK_HG2A
#define MK_HG2A MK_HG2
#endif
#ifndef MK_HG2B
#define MK_HG2B MK_HG2
#endif
#ifndef MK_ATT2
#define MK_ATT2 1
#endif
#ifndef MK_ATT3
#define MK_ATT3 1
#endif
#ifndef MK_ATT_HEAVY_FIRST
#define MK_ATT_HEAVY_FIRST 0
#endif
#ifndef MK_ONE_LAUNCH
#define MK_ONE_LAUNCH 1
#endif
struct Args { const float* in[15]; float* out; unsigned char* ws; int ph_lo, ph_hi; };
static_assert(sizeof(Args) == 15 * 8 + 8 + 8 + 8, "Args has no padding");

__global__ void __launch_bounds__(NWAVES * 64, 2) mk_fwd(Args args) {
    extern __shared__ __attribute__((aligned(16))) unsigned char lds[];
    Frame F;
    F.lds = (LAS unsigned char*)lds;
    F.MISC = (volatile LAS unsigned*)(F.lds + MISC_OFF);
    F.tid = threadIdx.x; F.lane = F.tid & 63; F.wave = __builtin_amdgcn_readfirstlane(F.tid >> 6);
    F.G = gridDim.x; { const int bx = blockIdx.x; F.vcu = (F.G % 8 == 0) ? (bx % 8) * (F.G / 8) + bx / 8 : bx; }
    unsigned char* ws = args.ws;
    F.ctl = (gu32*)(ws + WS_CTL);
    const float* x = args.in[0]; const float* attn_g = args.in[1]; const float* w_in = args.in[2]; const float* lb_gamma = args.in[3];
    const float* hg_out_g = args.in[4]; const float* q_g = args.in[5]; const float* k_g = args.in[6]; const float* rel_tab = args.in[7];
    const float* w_bh = args.in[8]; const float* w_ba = args.in[9]; const float* w_out = args.in[10]; const float* ffn_g = args.in[11];
    const float* w_gate = args.in[12]; const float* w_up = args.in[13]; const float* w_down = args.in[14];
    (void)hg_out_g; (void)rel_tab;
    bf16* WT_IN = (bf16*)(ws + WS_WT_IN); bf16* WT_CAT = (bf16*)(ws + WS_WT_CAT); bf16* WT_OUT = (bf16*)(ws + WS_WT_OUT);
    bf16* WT_FIN = (bf16*)(ws + WS_WT_FIN); bf16* WT_DOWN = (bf16*)(ws + WS_WT_DOWN); bf16* HB = (bf16*)(ws + WS_H);
    bf16* QQ = (bf16*)(ws + WS_QQ); bf16* AK = (bf16*)(ws + WS_AK); bf16* AV = (bf16*)(ws + WS_AV);
    unsigned short* HLF = (unsigned short*)(ws + WS_HLF); bf16* HSG = (bf16*)(ws + WS_HSG);
    float* KMEAN = (float*)(ws + WS_KMEAN); bf16* KMEANB = (bf16*)(ws + WS_KMEANB); float* LB = (float*)(ws + WS_LB); float* SSQ = (float*)(ws + WS_SSQ);
    bf16* MERGED = (bf16*)(ws + WS_MERGED); bf16* X1B = (bf16*)(ws + WS_A2); bf16* ACT = (bf16*)(ws + WS_ACT);
    float* LST = (float*)(ws + WS_LST); float* DST = (float*)(ws + WS_DST);
    bf16* GATES = (bf16*)args.out;

    for (int u = F.tid; u < (LDS_BYTES - LDSCTL_OFF) / 4; u += NWAVES * 64) ((LAS unsigned*)(F.lds + LDSCTL_OFF))[u] = 0u;
    __syncthreads();
    const int lo = args.ph_lo, hi = args.ph_hi;
    XcdBarrier bar; bar.bar = (unsigned*)(F.ctl + CW_BAR); bar.x = 0; bar.st = nullptr;
    if (hi - lo > 1) bar = xcd_barrier_post((unsigned*)(F.ctl + CW_BAR), F.MISC + 8);
#ifndef PHMASK
#define PHMASK 0x3ff
#endif
#define IN(k) (((PHMASK >> (k)) & 1) && lo <= (k) && (k) < hi)
#define BOTH(k) (IN(k) && IN((k) + 1))
#define GRID_BAR() xcd_barrier(bar)
    const int gw = F.vcu * NWAVES + F.wave, NGW = F.G * NWAVES;
    unsigned long long pt0 = 0ull, pt1 = 0ull; (void)pt0; (void)pt1;
#define TSTART(k) do { if (PROBE_T == (k) || PROBE_T == (k) + 20) pt0 = __builtin_amdgcn_s_memrealtime(); } while (0)
#define TEND(k) do { if (PROBE_T == (k)) pt1 = __builtin_amdgcn_s_memrealtime(); } while (0)
    LAS unsigned char* scrb = F.lds + RING_OFF + F.wave * 16384;

#if (PROBE_DUP >> 0) & 1
    for (int rep_0 = 0; rep_0 < 2; ++rep_0) {
#endif
    if (IN(0)) { TSTART(0);
        constexpr int I_IN = 16 * 144, I_B = 16 * 16, I_T = I_IN + 3 * I_B, I_H = MTOK / 2;
        if (MK_P0_PIPE && NGW == 2048) {
            const int nit = gw < 1024 ? 5 : 6;
#define P0_DEC(k) const int k_ = (k); const bool isT = k_ == 0 || (gw < 1024 && k_ == 1); \
            const int idx = isT ? (k_ == 0 ? gw : 2048 + gw) : (gw < 1024 ? 3 * gw + k_ - 2 : 3072 + 5 * (gw - 1024) + k_ - 1); \
            TrDesc td; { int r = idx; if (r < I_IN) { const int c = 64 * (r % 144); td = TrDesc{w_in, INCOLS, 64 * (r / 144), c, WT_IN, 1024, win_row(c), 0}; } \
                else { r -= I_IN; const int wsel = r / I_B; r %= I_B; td = TrDesc{wsel == 0 ? w_bh : (wsel == 1 ? w_ba : w_out), 1024, 64 * (r / 16), 64 * (r % 16), wsel == 2 ? WT_OUT : WT_CAT, wsel == 2 ? 1024 : 2048, 64 * (r % 16), wsel == 1 ? 1024 : 0}; } }
#define P0_LOAD(v, k) do { P0_DEC(k); if (isT) tr_load(v, td, F.lane); else h2_load(v, x, 2 * idx, F.lane); } while (0)
#define P0_PROC(v, k) do { P0_DEC(k); if (isT) tr_store(v, td, scrb, F.lane); else h2_store(v, attn_g, HB, 2 * idx, F.lane); } while (0)
            f32x4 va[16], vb[16];
#pragma unroll
            for (int j = 0; j < 16; ++j) { va[j] = (f32x4){0.f, 0.f, 0.f, 0.f}; vb[j] = (f32x4){0.f, 0.f, 0.f, 0.f}; }
            P0_LOAD(va, 0);
#pragma unroll 1
            for (int k = 0; k < nit; k += 2) {
                if (k + 1 < nit) P0_LOAD(vb, k + 1);
                P0_PROC(va, k);
                if (k + 2 < nit) P0_LOAD(va, k + 2);
                if (k + 1 < nit) P0_PROC(vb, k + 1);
            }
#undef P0_DEC
#undef P0_LOAD
#undef P0_PROC
        } else
        for (int it = gw; it < I_T + I_H; it += NGW) {
            int r = it;
            if (r < I_IN) { const int kb = r / 144, c = 64 * (r % 144); const int d = win_row(c);
                p0_transpose64(w_in, INCOLS, 64 * kb, c, WT_IN, 1024, d, 0, scrb, F.lane); continue; } r -= I_IN;
            if (r < I_B) { p0_transpose64(w_bh, 1024, 64 * (r / 16), 64 * (r % 16), WT_CAT, 2048, 64 * (r % 16), 0, scrb, F.lane); continue; } r -= I_B;
            if (r < I_B) { p0_transpose64(w_ba, 1024, 64 * (r / 16), 64 * (r % 16), WT_CAT, 2048, 64 * (r % 16), 1024, scrb, F.lane); continue; } r -= I_B;
            if (r < I_B) { p0_transpose64(w_out, 1024, 64 * (r / 16), 64 * (r % 16), WT_OUT, 1024, 64 * (r % 16), 0, scrb, F.lane); continue; } r -= I_B;
            rms_row_to_bf16(x + (size_t)(2 * r) * DM, attn_g, HB + (size_t)(2 * r) * DM, F.lane);
            rms_row_to_bf16(x + (size_t)(2 * r + 1) * DM, attn_g, HB + (size_t)(2 * r + 1) * DM, F.lane);
        }
#if PROBE_P0 & 1
        for (int m = gw; m < MTOK; m += NGW) rms_row_to_bf16(x + (size_t)m * DM, attn_g, HB + (size_t)m * DM, F.lane);
#endif
#if PROBE_P0 & 2
        for (int it = gw; it < I_IN; it += NGW) { const int r = it, kb = r / 144, c = 64 * (r % 144); const int d = win_row(c);
            p0_transpose64(w_in, INCOLS, 64 * kb, c, WT_IN, 1024, d, 0, scrb, F.lane); }
#endif
        { const int gt = blockIdx.x * (NWAVES * 64) + F.tid; if (gt < 1024) LB[gt] = 1.f / (1.f + __expf(lb_gamma[1024 + gt] - lb_gamma[gt])); }
        if (BOTH(0)) GRID_BAR();
        TEND(0);
    }
#if (PROBE_DUP >> 0) & 1
    }
#endif
#if (PROBE_DUP >> 2) & 1
    for (int rep_2 = 0; rep_2 < 2; ++rep_2) {
#endif
#if (PROBE_DUP >> 1) & 1
    for (int rep_1 = 0; rep_1 < 2; ++rep_1) {
#endif
    if (IN(1)) { TSTART(1);
        pg8::Gemm g{HB, WT_IN, MTOK, 3072, 1024}; pg8::StaticOrder S; S.init(MTOK, 3072, F.G, (int)blockIdx.x, MK_WGM_P1B);
        pg8::EpiProj E{0, QQ, AK, AV, HLF, HSG, GATES, KMEAN, KMEANB, LB, q_g, k_g, (PG8_LAS unsigned char*)(F.lds + EPI_SCR_OFF)};
        pg8::gemm_phase<pg8::EpiProj, pg8::StaticOrder, true, MK_SP2>(F.lds + RING_OFF, g, S, E);
        if (BOTH(1)) GRID_BAR();
        TEND(1);
    }
#if (PROBE_DUP >> 1) & 1
    }
#endif
#if (PROBE_DUP >> 11) & 1
    {
        pg8::Gemm g{HB, WT_IN, MTOK, 2048, 1024}; pg8::StaticOrder S; S.init(MTOK, 2048, F.G, (int)blockIdx.x);
        pg8::EpiPlain E{(bf16*)(ws + WS_HLF), 2048};
        pg8::gemm_phase<pg8::EpiPlain, pg8::StaticOrder, true, MK_SP2>(F.lds + RING_OFF, g, S, E);
        GRID_BAR();
    }
#endif
#if (PROBE_DUP >> 12) & 1
    {
        pg8::Gemm g{HB, WT_IN, MTOK, 1024, 1024}; pg8::StaticOrder S; S.init(MTOK, 1024, F.G, (int)blockIdx.x);
        pg8::EpiPlain E{(bf16*)(ws + WS_HLF), 2048};
        pg8::gemm_phase<pg8::EpiPlain, pg8::StaticOrder, true, MK_SP2>(F.lds + RING_OFF, g, S, E);
        GRID_BAR();
    }
#endif
#if (PROBE_DUP >> 13) & 1
    {
        pg8::Gemm g{HB, WT_IN, MTOK, 1024, 1024}; pg8::StaticOrder S; S.init(MTOK, 1024, F.G, (int)blockIdx.x);
        pg8::EpiProj E{0, QQ, AK, AV, HLF, HSG, GATES, KMEAN, KMEANB, LB, q_g, k_g, (PG8_LAS unsigned char*)(F.lds + EPI_SCR_OFF)};
        pg8::gemm_phase<pg8::EpiProj, pg8::StaticOrder, true, MK_SP2>(F.lds + RING_OFF, g, S, E);
        GRID_BAR();
    }
#endif
#if (PROBE_DUP >> 14) & 1
    {
        pg8::Gemm g{HB, WT_IN, MTOK, 3072, 1024}; pg8::StaticOrder S; S.init(MTOK, 3072, F.G, (int)blockIdx.x);
        pg8::EpiProj E{0, QQ, AK, AV, HLF, HSG, GATES, KMEAN, KMEANB, LB, q_g, k_g, (PG8_LAS unsigned char*)(F.lds + EPI_SCR_OFF)};
        pg8::gemm_phase<pg8::EpiProj, pg8::StaticOrder, true, MK_SP2>(F.lds + RING_OFF, g, S, E);
        GRID_BAR();
    }
#endif
#if (PROBE_DUP >> 15) & 1
    {
        pg8::Gemm g{HB, WT_IN, MTOK, 3072, 1024}; pg8::StaticOrder S; S.init(MTOK, 3072, F.G, (int)blockIdx.x);
        pg8::EpiPlain E{(bf16*)(ws + WS_HLF), 4096};
        pg8::gemm_phase<pg8::EpiPlain, pg8::StaticOrder, true, MK_SP2>(F.lds + RING_OFF, g, S, E);
        GRID_BAR();
    }
#endif
#ifdef MK_ABL
    if (IN(2)) { pt0 = __builtin_amdgcn_s_memrealtime();
            moba::Seam S; S.vs = 0;
            for (int L = F.vcu; L < BATCH * NH * 8; L += F.G) {
                const int bh = L >> 3, xq = L & 7, bb = bh / NH, hh = bh % NH;
                const bf16* kbase = AK + (size_t)bb * SEQ * 1024 + hh * 128; const bf16* vbase = AV + (size_t)bb * SEQ * 1024 + hh * 128;
                bf16* q0 = QQ + ((size_t)bb * SEQ + xq * 256) * 2048 + 1024 + hh * 128; bf16* q1 = QQ + ((size_t)bb * SEQ + (15 - xq) * 256) * 2048 + 1024 + hh * 128;
                bf16* d0 = (bf16*)(ws + WS_HLF) + (q0 - QQ); bf16* d1 = (bf16*)(ws + WS_HLF) + (q1 - QQ);
                const moba::BlockRef c0{q0, kbase, vbase, d0, KMEANB + (size_t)bh * NBLK * HD, rel_tab + hh, q_g, k_g, xq * 256};
                const moba::BlockRef c1{q1, kbase, vbase, d1, KMEANB + (size_t)bh * NBLK * HD, rel_tab + hh, q_g, k_g, (15 - xq) * 256};
#if MK_ATT3
                moba::moba_prime3(c0, F.lds + RING_OFF, S);
#pragma unroll 1
                for (int pass = 0; pass < 2; ++pass) { const moba::BlockRef cu = pass ? c1 : c0; moba::moba_block3<MK_ABL>(cu, c1, F.lds + RING_OFF, S); }
#else
                moba::moba_prime(c0, (char*)lds + RING_OFF, S);
#pragma unroll 1
                for (int pass = 0; pass < 2; ++pass) { const moba::BlockRef cu = pass ? c1 : c0; moba::moba_block2<MK_ABL>(cu, c1, (char*)lds + RING_OFF, S); }
#endif
            }
        GRID_BAR();
        pt1 = __builtin_amdgcn_s_memrealtime();
    }
#endif
    if (IN(2)) { TSTART(2);
#if MK_NAIVE_ATTN
        { const int half = F.tid >> 8, ht = F.tid & 255; LAS float* sm = (LAS float*)(F.lds + RING_OFF) + half * 2048;
          const int total = BATCH * NH * SEQ, iters = (total + 2 * F.G - 1) / (2 * F.G);
          for (int i = 0; i < iters; ++i) { int r = i * 2 * F.G + blockIdx.x * 2 + half; const bool act = r < total; if (!act) r = total - 1;
              naive_attn_row(r, act, ht, sm, AK, AV, QQ, KMEAN, rel_tab); } }
#else
        {
            moba::Seam S; S.vs = 0;
            for (int L = F.vcu; L < BATCH * NH * 8; L += F.G) {
                const int bh = L >> 3, xq = L & 7, bb = bh / NH, hh = bh % NH;
                const bf16* kbase = AK + (size_t)bb * SEQ * 1024 + hh * 128; const bf16* vbase = AV + (size_t)bb * SEQ * 1024 + hh * 128;
                bf16* q0 = QQ + ((size_t)bb * SEQ + xq * 256) * 2048 + 1024 + hh * 128; bf16* q1 = QQ + ((size_t)bb * SEQ + (15 - xq) * 256) * 2048 + 1024 + hh * 128;
                const moba::BlockRef c0{q0, kbase, vbase, q0, KMEANB + (size_t)bh * NBLK * HD, rel_tab + hh, q_g, k_g, xq * 256};
                const moba::BlockRef c1{q1, kbase, vbase, q1, KMEANB + (size_t)bh * NBLK * HD, rel_tab + hh, q_g, k_g, (15 - xq) * 256};
#if MK_ATT3
                moba::moba_prime3(c0, F.lds + RING_OFF, S);
#else
                moba::moba_prime(MK_ATT_HEAVY_FIRST ? c1 : c0, (char*)lds + RING_OFF, S);
#endif
#pragma unroll 1

#if MK_ATT_HEAVY_FIRST
                for (int pass = 0; pass < 2; ++pass) { const moba::BlockRef cu = pass ? c0 : c1; moba::moba_block(cu, c0, (char*)lds + RING_OFF, S); }
#else
                for (int pass = 0; pass < 2; ++pass) { const moba::BlockRef cu = pass ? c1 : c0;
#if MK_ATT3
                    moba::moba_block3<0>(cu, c1, F.lds + RING_OFF, S);
#elif MK_ATT2
                    moba::moba_block2<0>(cu, c1, (char*)lds + RING_OFF, S);
#else
                    moba::moba_block(cu, c1, (char*)lds + RING_OFF, S);
#endif
                }
#endif
            }
        }
#endif
        if (BOTH(2)) GRID_BAR();
        TEND(2);
    }
#if (PROBE_DUP >> 2) & 1
    }
#endif
#if (PROBE_DUP >> 3) & 1
    for (int rep_3 = 0; rep_3 < 2; ++rep_3) {
#endif
    if (IN(3)) { TSTART(3);
        pg8::Gemm g{HB, WT_IN + (size_t)3072 * 1024, MTOK, 6144, 1024}; pg8::StaticOrder S; S.init(MTOK, 6144, F.G, (int)blockIdx.x, MK_WGM_P1A);
        pg8::EpiProj E{1, QQ, AK, AV, HLF, HSG, GATES, KMEAN, KMEANB, LB, q_g, k_g, (PG8_LAS unsigned char*)(F.lds + EPI_SCR_OFF)};
        pg8::gemm_phase<pg8::EpiProj, pg8::StaticOrder, MK_ALIGN_P1A, MK_SP2>(F.lds + RING_OFF, g, S, E);
        if (BOTH(3)) GRID_BAR();
        TEND(3);
    }
#if (PROBE_DUP >> 3) & 1
    }
#endif
#if (PROBE_DUP >> 4) & 1
    for (int rep_4 = 0; rep_4 < 2; ++rep_4) {
#endif
    if (IN(4)) { TSTART(4);
        constexpr int I_G = 16 * 44, I_D = 44 * 16;
        const bool down_later = (F.G == 256);
        for (int it = gw; it < 2 * I_G + (down_later ? 0 : I_D); it += NGW) {
            int r = it;
            if (r < 2 * I_G) { const int up = r >= I_G; if (up) r -= I_G; const int kb = r / 44, c = 64 * (r % 44);
                p0_transpose64(up ? w_up : w_gate, DFF, 64 * kb, c, WT_FIN, 1024, 256 * (c / 128) + (c % 128) + (up ? 128 : 0), 0, scrb, F.lane, ffn_g); continue; } r -= 2 * I_G;
            p0_transpose64(w_down, 1024, 64 * (r / 16), 64 * (r % 16), WT_DOWN, DFF, 64 * (r % 16), 0, scrb, F.lane);
        }
#if !MK_NAIVE_HGRN
        __syncthreads();
        {
#if MK_HG2A
          namespace hga = hg2;
#else
          namespace hga = hgrn;
#endif
          const hga::Ptrs HP{QQ, AK, AV, HLF, HSG};
          for (int L = F.vcu; L < BATCH * NH * 8; L += F.G) { const int bh = L >> 3, gg = L & 7;
        if (PROBE_T == 34) pt0 = __builtin_amdgcn_s_memrealtime();
              hga::run_item<false>((char*)lds + RING_OFF, HP, QQ, hg_out_g, LST, DST, L, gg, (size_t)(bh / NH) * SEQ + gg * 512, bh % NH); } }
        if (PROBE_T == 24 || PROBE_T == 34) pt1 = __builtin_amdgcn_s_memrealtime();
#endif
        if (BOTH(4)) GRID_BAR();
        TEND(4);
    }
#if (PROBE_DUP >> 4) & 1
    }
#endif
    if (IN(5)) { TSTART(5);
#if MK_NAIVE_HGRN
        if (blockIdx.x < 8) {
            const int grp = F.tid >> 7, v = F.tid & 127, bh = blockIdx.x * 4 + grp, h = bh % NH, b = bh / NH; const float g = hg_out_g[v];
            LAS float* qs = (LAS float*)(F.lds + RING_OFF) + grp * 512; LAS float* ks = qs + 128; LAS float* fs = qs + 256; LAS float* red = qs + 384;
            float S[128];
#pragma unroll
            for (int k = 0; k < 128; ++k) S[k] = 0.f;
            for (int t = 0; t < SEQ; ++t) { const size_t m = (size_t)b * SEQ + t;
                qs[v] = bf2f(QQ[m * 2048 + h * 128 + v]); ks[v] = bf2f(AK[m * 1024 + h * 128 + v]);
                { const unsigned short hb = HLF[m * 1024 + h * 128 + v]; _Float16 hf = __builtin_bit_cast(_Float16, hb); fs[v] = exp2f((float)hf); }
                const float vv = bf2f(AV[m * 1024 + h * 128 + v]), sg = bf2f(HSG[m * 1024 + h * 128 + v]);
                __syncthreads();
                float o = 0.f;
#pragma unroll
                for (int k = 0; k < 128; ++k) { S[k] = fs[k] * S[k] + ks[k] * vv; o += qs[k] * S[k]; }
                const float ss = wave_sum(o * o); if ((v & 63) == 0) red[v >> 6] = ss;
                __syncthreads();
                const float rstd = 1.f / sqrtf((red[0] + red[1]) * (1.f / 128.f) + NORM_EPS);
                QQ[m * 2048 + h * 128 + v] = (bf16)f2bf(o * rstd * g * sg);
            }
        }
#else
        {
#if MK_HG2B
          namespace hgb = hg2;
#else
          namespace hgb = hgrn;
#endif
          const hgb::Ptrs HP{QQ, AK, AV, HLF, HSG};
          for (int L = F.vcu; L < BATCH * NH * 8; L += F.G) { const int bh = L >> 3, gg = L & 7;
#if defined(DBG_MIX)
              if (!(DBG_MIX)) { const hgrn::Ptrs HP1{QQ, AK, AV, HLF, HSG}; hgrn::run_item<true>((char*)lds + RING_OFF, HP1, QQ, hg_out_g, LST, DST, L, gg, (size_t)(bh / NH) * SEQ + gg * 512, bh % NH); } else
#endif
              hgb::run_item<true>((char*)lds + RING_OFF, HP, QQ, hg_out_g, LST, DST, L, gg, (size_t)(bh / NH) * SEQ + gg * 512, bh % NH); } }
        if (PROBE_T == 25) pt1 = __builtin_amdgcn_s_memrealtime();
#endif
        if (BOTH(5)) GRID_BAR();
        TEND(5);
    }
#if (PROBE_DUP >> 6) & 1
    for (int rep_6 = 0; rep_6 < 2; ++rep_6) {
#endif
    if (IN(6)) { TSTART(6);
        pg8::Gemm g{QQ, WT_CAT, MTOK, 1024, 2048}; pg8::StaticOrder S; S.init(MTOK, 1024, F.G, (int)blockIdx.x, MK_WGM_1U);
        pg8::EpiMerge E{GATES, MERGED};
        pg8::gemm_phase<pg8::EpiMerge, pg8::StaticOrder, MK_ALIGN_1U, MK_SP2>(F.lds + RING_OFF, g, S, E);
        if (BOTH(6)) GRID_BAR();
        TEND(6);
    }
#if (PROBE_DUP >> 6) & 1
    }
#endif
#if (PROBE_DUP >> 7) & 1
    for (int rep_7 = 0; rep_7 < 2; ++rep_7) {
#endif
    if (IN(7)) { TSTART(7);
        pg8::Gemm g{MERGED, WT_OUT, MTOK, 1024, 1024}; pg8::StaticOrder S; S.init(MTOK, 1024, F.G, (int)blockIdx.x, MK_WGM_1U);
        pg8::EpiOut E{x, X1B, SSQ};
        pg8::gemm_phase<pg8::EpiOut, pg8::StaticOrder, MK_ALIGN_1U, MK_SP2>(F.lds + RING_OFF, g, S, E);
        if (BOTH(7)) GRID_BAR();
        TEND(7);
    }
#if (PROBE_DUP >> 7) & 1
    }
#endif
#if (PROBE_DUP >> 8) & 1
    for (int rep_8 = 0; rep_8 < 2; ++rep_8) {
#endif
    if (IN(8)) { TSTART(8);
        pg8::Gemm g{X1B, WT_FIN, MTOK, 2 * DFF, 1024}; pg8::StaticOrder S; S.init(MTOK, 2 * DFF, F.G, (int)blockIdx.x, MK_WGM_P8);
        pg8::EpiFfnIn E{SSQ, ACT};
        pg8::gemm_phase<pg8::EpiFfnIn, pg8::StaticOrder, MK_ALIGN_P8, MK_SP2>(F.lds + RING_OFF, g, S, E);
        if (F.G == 256 && blockIdx.x >= 128) {
            for (int it = ((int)blockIdx.x - 128) * NWAVES + F.wave; it < 44 * 16; it += 128 * NWAVES)
                p0_transpose64(w_down, 1024, 64 * (it / 16), 64 * (it % 16), WT_DOWN, DFF, 64 * (it % 16), 0, scrb, F.lane);
        }
        if (BOTH(8)) GRID_BAR();
        TEND(8);
    }
#if (PROBE_DUP >> 8) & 1
    }
#endif
#if (PROBE_DUP >> 9) & 1
    for (int rep_9 = 0; rep_9 < 2; ++rep_9) {
#endif
    if (IN(9)) { TSTART(9);
        pg8::Gemm g{ACT, WT_DOWN, MTOK, 1024, DFF}; pg8::StaticOrder S; S.init(MTOK, 1024, F.G, (int)blockIdx.x, MK_WGM_1U);
        pg8::EpiDown E{X1B, args.out};
        pg8::gemm_phase<pg8::EpiDown, pg8::StaticOrder, MK_ALIGN_1U, MK_SP2>(F.lds + RING_OFF, g, S, E);
        TEND(9);
    }
#if (PROBE_DUP >> 9) & 1
    }
#endif
    if ((PROBE_DUP >> 10) & 1) { for (int e = 0; e < 10; ++e) GRID_BAR(); }
    if (PROBE_T >= 0 && blockIdx.x == PROBE_BLK && F.tid == 0) { const unsigned long long tgt = __builtin_amdgcn_s_memrealtime() + 4ull * (pt1 - pt0); while (__builtin_amdgcn_s_memrealtime() < tgt) __builtin_amdgcn_s_sleep(16); }
#undef IN
#undef BOTH
#undef GRID_BAR
}

extern "C" void kernel_launch(void* const* d_in, const int* in_sizes, int n_in, void* d_out, int out_size, void* d_ws, size_t ws_size, hipStream_t stream) {
    static int grid = 0;
    if (grid == 0) {
        if (n_in != 15 || in_sizes[0] != MTOK * DM || out_size != MTOK * DM || ws_size < WS_END) {
            fprintf(stderr, "kernel_launch: shape/workspace mismatch (n_in %d, in0 %d, out %d, ws %zu); nothing launched\n", n_in, n_in > 0 ? in_sizes[0] : -1, out_size, ws_size); grid = -1; return; }
        int dev = 0, cus = 0, per_cu = 0;
        if (hipGetDevice(&dev) != hipSuccess || hipDeviceGetAttribute(&cus, hipDeviceAttributeMultiprocessorCount, dev) != hipSuccess) { grid = -1; return; }
        if (hipFuncSetAttribute((const void*)mk_fwd, hipFuncAttributeMaxDynamicSharedMemorySize, LDS_BYTES) != hipSuccess) { fprintf(stderr, "kernel_launch: hipFuncSetAttribute failed\n"); grid = -1; return; }
        if (hipOccupancyMaxActiveBlocksPerMultiprocessor(&per_cu, (const void*)mk_fwd, NWAVES * 64, LDS_BYTES) != hipSuccess || per_cu < 1) { fprintf(stderr, "kernel_launch: occupancy query says %d\n", per_cu); per_cu = 1; }
        (void)hipGetLastError();
        grid = cus;
    }
    if (grid < 0) return;
    (void)hipMemsetAsync((char*)d_ws + WS_CTL, 0, CTL_ZERO_BYTES, stream);
    Args a{};
    for (int i = 0; i < 15; ++i) a.in[i] = (const float*)d_in[i];
    a.out = (float*)d_out; a.ws = (unsigned char*)d_ws;
    unsigned char* ws = (unsigned char*)d_ws;
#define FRAME(lo_, hi_) do { a.ph_lo = (lo_); a.ph_hi = (hi_); hipLaunchKernelGGL(mk_fwd, dim3(grid), dim3(NWAVES * 64), LDS_BYTES, stream, a); } while (0)
    FRAME(0, 10);
#undef FRAME
    const hipError_t le = hipPeekAtLastError();
    if (le != hipSuccess) fprintf(stderr, "kernel_launch: launch failed: %s\n", hipGetErrorName(le));
}
```

```cpp
#include <hip/hip_runtime.h>
#include <cstdio>
#include <cstdint>

#ifndef MK_ATT_QS
#define MK_ATT_QS 1
#endif
constexpr int BATCH = 4, SEQ = 4096, DM = 1024, MTOK = BATCH * SEQ;
constexpr int NH = 8, HD = 128;
constexpr int DFF = 2816, INCOLS = 9216;
constexpr int MBLK = 256, NBLK = SEQ / MBLK, TOPK = 3;
constexpr float NORM_EPS = 1e-6f;
constexpr float ATT_SCALE = 0.08838834764831845f;
constexpr float LOG2E = 1.4426950408889634f;


namespace pg8 {
#define PG8_LAS __attribute__((address_space(3)))
typedef unsigned short bf16_t;
typedef short bf16x8 __attribute__((ext_vector_type(8)));
typedef float f32x4 __attribute__((ext_vector_type(4)));
typedef unsigned u32x4 __attribute__((ext_vector_type(4)));
constexpr int BM = 256, BK = 64, HALF = 128, HTB = HALF * BK * 2  , STAGE_BYTES = 8 * HTB, NXCD = 8;

__host__ __device__ __forceinline__ int lds_byte(int r, int c) { const int st = (r >> 4) * 2 + (c >> 5), rr = r & 15, cc = c & 31, ob = rr * 64 + cc * 2; return st * 1024 + (ob ^ (((ob >> 9) & 1) << 5)); }
__host__ __device__ __forceinline__ void stage_rc(int b, int& R, int& C) { const int st = b / 1024, sb = b % 1024, swz = sb ^ (((sb >> 9) & 1) << 5); R = (st >> 1) * 16 + swz / 64; C = (st & 1) * 32 + (swz % 64) / 2; }
__host__ __device__ __forceinline__ int perm32(int rho) { const int n = rho >> 4, i = rho & 15; return 8 * (i >> 2) + 4 * n + (i & 3); }

struct Unit { int pm, pn; };
struct Gemm { const bf16_t* A; const bf16_t* Bt; int M, N, K; };

struct StaticOrder {
    int nM, nN, nwg, G, c, WGM;
    __host__ __device__ void init(int M, int N, int G_, int c_, int wgm = 4) { nM = M / BM; nN = N / BM; nwg = nM * nN; G = G_; c = c_; WGM = wgm; }
    __host__ __device__ bool next(int i, Unit& u) const {
        const long L = (long)i * G + c; if (L >= nwg) return false;
        int wgid = (int)L; { const int q = nwg / NXCD, r = nwg % NXCD, xcd = wgid % NXCD, off = wgid / NXCD; wgid = (xcd < r ? xcd * (q + 1) : r * (q + 1) + (xcd - r) * q) + off; }
        const int nig = WGM * nN, gid = wgid / nig, fm = gid * WGM, gsz = (nM - fm) < WGM ? (nM - fm) : WGM;
        u.pm = fm + ((wgid % nig) % gsz); u.pn = (wgid % nig) / gsz; return true;
    }
    __device__ __forceinline__ void a_ready(const Unit&) const {}
    __device__ __forceinline__ void done(const Unit&) const {}
};

__device__ __forceinline__ unsigned cvt_pk_bf16(float lo, float hi) { unsigned r; asm volatile("v_cvt_pk_bf16_f32 %0, %1, %2" : "=v"(r) : "v"(lo), "v"(hi)); return r; }
typedef float f32x2 __attribute__((ext_vector_type(2)));

typedef unsigned u32x2 __attribute__((ext_vector_type(2)));
typedef _Float16 f16x8 __attribute__((ext_vector_type(8)));
__device__ __forceinline__ float bf2f(unsigned short b) { return __uint_as_float((unsigned)b << 16); }
__device__ __forceinline__ u32x4 pack8bf(f32x4 a, f32x4 b) { u32x4 w; w.x = cvt_pk_bf16(a[0], a[1]); w.y = cvt_pk_bf16(a[2], a[3]); w.z = cvt_pk_bf16(b[0], b[1]); w.w = cvt_pk_bf16(b[2], b[3]); return w; }
__device__ __forceinline__ void unpack8bf(u32x4 w, f32x4& a, f32x4& b) {
    a[0] = __uint_as_float(w.x << 16); a[1] = __uint_as_float(w.x & 0xffff0000u); a[2] = __uint_as_float(w.y << 16); a[3] = __uint_as_float(w.y & 0xffff0000u);
    b[0] = __uint_as_float(w.z << 16); b[1] = __uint_as_float(w.z & 0xffff0000u); b[2] = __uint_as_float(w.w << 16); b[3] = __uint_as_float(w.w & 0xffff0000u); }
__device__ __forceinline__ float fsigmoid(float x) { return __builtin_amdgcn_rcpf(1.f + __builtin_amdgcn_exp2f(-x * 1.4426950408889634f)); }
template <int CTRL> __device__ __forceinline__ float dpp_mov(float v) { return __int_as_float(__builtin_amdgcn_update_dpp(0, __float_as_int(v), CTRL, 0xf, 0xf, true)); }
__device__ __forceinline__ float row16_sum(float s) { s += dpp_mov<0xB1>(s); s += dpp_mov<0x4E>(s); s += dpp_mov<0x141>(s); s += dpp_mov<0x140>(s); return s; }
__device__ __forceinline__ float rows4_sum(float s) {
    auto r16 = __builtin_amdgcn_permlane16_swap(__float_as_uint(s), __float_as_uint(s), false, false);
    const float pr = __uint_as_float(r16[0]) + __uint_as_float(r16[1]);
    auto r32 = __builtin_amdgcn_permlane32_swap(__float_as_uint(pr), __float_as_uint(pr), false, false);
    return __uint_as_float(r32[0]) + __uint_as_float(r32[1]);
}
#define PG8_EPI_BAR() do { asm volatile("s_waitcnt lgkmcnt(0)" ::: "memory"); __builtin_amdgcn_s_barrier(); asm volatile("" ::: "memory"); } while (0)

struct EpiProj {
    static constexpr bool PERM = true, AFTER_DRAIN = false, MIDK = false;
    int mode;
    bf16_t* QQ; bf16_t* AK; bf16_t* AV; unsigned short* HLF; bf16_t* HSG; bf16_t* GATES; float* KMEAN; bf16_t* KMEANB;
    const float* lb; const float* qg; const float* kg;
    PG8_LAS unsigned char* scr;
    __device__ __forceinline__ void midk(f32x4 (&)[2][2][4][2], const Unit&, int, int, int, int) const {}
    __device__ __forceinline__ void operator()(const f32x4 (&acc)[2][2][4][2], const Unit& u, int wr, int wc, int fr, int fq) const {
        const int row0 = u.pm * BM + wr * 64 + fr;
        const int cw = wc * 32 + 8 * fq;
        int kind, c0;
        if (mode == 0) { kind = u.pn >> 2; c0 = (u.pn & 3) * 256; }
        else if (u.pn < 16) { kind = 3 + (u.pn >> 2); c0 = (u.pn & 3) * 256; }
        else { kind = 7; c0 = (u.pn - 16) * 256; }
        if (kind <= 1) {
            PG8_LAS float* P = (PG8_LAS float*)scr; PG8_LAS float* CS = (PG8_LAS float*)(scr + 8192);
#pragma unroll
            for (int ai = 0; ai < 2; ++ai)
#pragma unroll
                for (int m = 0; m < 4; ++m)
#pragma unroll
                    for (int bj = 0; bj < 2; ++bj) { const f32x4 a = acc[ai][bj][m][0], b = acc[ai][bj][m][1];
                        float s = (a[0] * a[0] + a[1] * a[1]) + (a[2] * a[2] + a[3] * a[3]) + (b[0] * b[0] + b[1] * b[1]) + (b[2] * b[2] + b[3] * b[3]);
                        s = rows4_sum(s);
                        if (fq == 0) P[((ai * 128 + wr * 64 + m * 16 + fr) * 2 + bj) * 4 + wc] = s; }
            PG8_EPI_BAR();
            const float* gp = (kind == 0 ? qg : kg) + cw;
            const float qsc = (kind == 0 && MK_ATT_QS) ? 1.4426950408889634f * ATT_SCALE : 1.f;
            const f32x4 g0 = *(const f32x4*)gp * qsc, g1 = *(const f32x4*)(gp + 4) * qsc;
            f32x4 cs[2][2];
#pragma unroll
            for (int bj = 0; bj < 2; ++bj) { cs[bj][0] = (f32x4){0.f, 0.f, 0.f, 0.f}; cs[bj][1] = (f32x4){0.f, 0.f, 0.f, 0.f}; }
            bf16_t* dst = (kind == 0) ? (QQ + 1024 + c0 + cw) : (AK + c0 + cw); const int ld = (kind == 0) ? 2048 : 1024;
#pragma unroll
            for (int ai = 0; ai < 2; ++ai)
#pragma unroll
                for (int m = 0; m < 4; ++m) { const int row = row0 + ai * 128 + m * 16;
#pragma unroll
                    for (int bj = 0; bj < 2; ++bj) { const f32x4 p4 = *(const PG8_LAS f32x4*)&P[((ai * 128 + wr * 64 + m * 16 + fr) * 2 + bj) * 4];
                        const float rstd = __builtin_amdgcn_rsqf(((p4[0] + p4[1]) + (p4[2] + p4[3])) * (1.f / 128.f) + NORM_EPS);
                        const f32x4 y0 = acc[ai][bj][m][0] * rstd * g0, y1 = acc[ai][bj][m][1] * rstd * g1;
                        cs[bj][0] += y0; cs[bj][1] += y1;
                        *(u32x4*)(dst + (size_t)row * ld + bj * 128) = pack8bf(y0, y1); } }
            if (kind == 1) {
#pragma unroll
                for (int bj = 0; bj < 2; ++bj)
#pragma unroll
                    for (int n = 0; n < 2; ++n)
#pragma unroll
                        for (int j = 0; j < 4; ++j) { const float v = row16_sum(cs[bj][n][j]);
                            if (fr == 0) CS[wr * 256 + bj * 128 + cw + 4 * n + j] = v; }
                PG8_EPI_BAR();
                const int t = threadIdx.x;
                if (t < 256) { const float km = (CS[t] + CS[256 + t]) * (1.f / 256.f);
                    const int bb = u.pm >> 4, nb = u.pm & 15, head = (c0 + t) >> 7, d = t & 127;
                    const size_t o = ((size_t)((bb * NH + head) * NBLK + nb)) * HD + d;
                    KMEAN[o] = km; KMEANB[o] = (bf16_t)(cvt_pk_bf16(km, 0.f) & 0xffffu); }
            }
            return;
        }
        if (kind == 4) {
#pragma unroll
            for (int bj = 0; bj < 2; ++bj) { const int col = c0 + bj * 128 + cw;
                const f32x4 l0 = *(const f32x4*)(lb + col), l1 = *(const f32x4*)(lb + col + 4);
#pragma unroll
                for (int ai = 0; ai < 2; ++ai)
#pragma unroll
                    for (int m = 0; m < 4; ++m) { const int row = row0 + ai * 128 + m * 16;
                        f32x4 k0, k1; f16x8 lf;
#pragma unroll
                        for (int j = 0; j < 4; ++j) { const float ka = (1.f - l0[j]) * fsigmoid(-acc[ai][bj][m][0][j]), kb = (1.f - l1[j]) * fsigmoid(-acc[ai][bj][m][1][j]);
                            k0[j] = ka; k1[j] = kb; lf[j] = (_Float16)__builtin_amdgcn_logf(1.f - ka); lf[4 + j] = (_Float16)__builtin_amdgcn_logf(1.f - kb); }
                        *(u32x4*)(AK + (size_t)row * 1024 + col) = pack8bf(k0, k1);
                        *(f16x8*)(HLF + (size_t)row * 1024 + col) = lf; } }
            return;
        }
        if (kind == 7) {
            bf16_t* RT = GATES + (c0 >> 1) + cw; bf16_t* G1 = RT + (size_t)MTOK * 1024;
#pragma unroll
            for (int ai = 0; ai < 2; ++ai)
#pragma unroll
                for (int m = 0; m < 4; ++m) { const int row = row0 + ai * 128 + m * 16; f32x4 r0, r1, s0, s1;
#pragma unroll
                    for (int j = 0; j < 4; ++j) { const float e0a = __builtin_amdgcn_exp2f(-acc[ai][0][m][0][j] * 1.4426950408889634f), e1a = __builtin_amdgcn_exp2f(-acc[ai][1][m][0][j] * 1.4426950408889634f);
                        const float e0b = __builtin_amdgcn_exp2f(-acc[ai][0][m][1][j] * 1.4426950408889634f), e1b = __builtin_amdgcn_exp2f(-acc[ai][1][m][1][j] * 1.4426950408889634f);
                        r0[j] = (1.f + e1a) * __builtin_amdgcn_rcpf(1.f + e0a); r1[j] = (1.f + e1b) * __builtin_amdgcn_rcpf(1.f + e0b);
                        s0[j] = __builtin_amdgcn_rcpf(1.f + e1a); s1[j] = __builtin_amdgcn_rcpf(1.f + e1b); }
                    *(u32x4*)(RT + (size_t)row * 1024) = pack8bf(r0, r1); *(u32x4*)(G1 + (size_t)row * 1024) = pack8bf(s0, s1); }
            return;
        }
        bf16_t* dst; int ld;
        if (kind == 2) { dst = AV; ld = 1024; } else if (kind == 3) { dst = QQ; ld = 2048; } else if (kind == 5) { dst = AV; ld = 1024; } else { dst = HSG; ld = 1024; }
        dst += c0 + cw;
#pragma unroll
        for (int ai = 0; ai < 2; ++ai)
#pragma unroll
            for (int m = 0; m < 4; ++m) { const int row = row0 + ai * 128 + m * 16;
#pragma unroll
                for (int bj = 0; bj < 2; ++bj) { f32x4 v0 = acc[ai][bj][m][0], v1 = acc[ai][bj][m][1];
                    if (kind == 3) { v0 = v0 * ATT_SCALE; v1 = v1 * ATT_SCALE; }
                    else if (kind == 6) {
#pragma unroll
                        for (int j = 0; j < 4; ++j) { v0[j] = v0[j] * fsigmoid(v0[j]); v1[j] = v1[j] * fsigmoid(v1[j]); } }
                    *(u32x4*)(dst + (size_t)row * ld + bj * 128) = pack8bf(v0, v1); } }
    }
};

struct EpiPlain {
    static constexpr bool PERM = true, AFTER_DRAIN = false, MIDK = false;
    bf16_t* O; int ldc;
    __device__ __forceinline__ void midk(f32x4 (&)[2][2][4][2], const Unit&, int, int, int, int) const {}
    __device__ __forceinline__ void operator()(const f32x4 (&acc)[2][2][4][2], const Unit& u, int wr, int wc, int fr, int fq) const {
        const int row0 = u.pm * BM + wr * 64 + fr, col0 = u.pn * BM + wc * 32 + 8 * fq;
#pragma unroll
        for (int ai = 0; ai < 2; ++ai)
#pragma unroll
            for (int m = 0; m < 4; ++m) { bf16_t* rowp = O + (size_t)(row0 + ai * 128 + m * 16) * ldc + col0;
#pragma unroll
                for (int bj = 0; bj < 2; ++bj) *(u32x4*)(rowp + bj * 128) = pack8bf(acc[ai][bj][m][0], acc[ai][bj][m][1]); }
    }
};

struct EpiMerge {
    static constexpr bool PERM = true, AFTER_DRAIN = false, MIDK = true;
    const bf16_t* G; bf16_t* O;
    __device__ __forceinline__ void midk(f32x4 (&acc)[2][2][4][2], const Unit& u, int wr, int wc, int fr, int fq) const {
        int row0 = u.pm * BM + wr * 64 + fr, col0 = u.pn * BM + wc * 32 + 8 * fq;
        asm volatile("" : "+v"(row0), "+v"(col0));
#pragma unroll
        for (int ai = 0; ai < 2; ++ai)
#pragma unroll
            for (int m = 0; m < 4; ++m) { const bf16_t* gp = G + (size_t)(row0 + ai * 128 + m * 16) * 1024 + col0;
#pragma unroll
                for (int bj = 0; bj < 2; ++bj) { const u32x4 w0 = *(const u32x4*)(gp + bj * 128); f32x4 a0, a1; unpack8bf(w0, a0, a1);
                    acc[ai][bj][m][0] *= a0; acc[ai][bj][m][1] *= a1; }
                asm volatile("" ::: "memory"); }
    }
    __device__ __forceinline__ void operator()(const f32x4 (&acc)[2][2][4][2], const Unit& u, int wr, int wc, int fr, int fq) const {
        const int row0 = u.pm * BM + wr * 64 + fr, col0 = u.pn * BM + wc * 32 + 8 * fq;
#pragma unroll
        for (int ai = 0; ai < 2; ++ai)
#pragma unroll
            for (int m = 0; m < 4; ++m) { const int row = row0 + ai * 128 + m * 16; const bf16_t* gp = G + (size_t)MTOK * 1024 + (size_t)row * 1024 + col0;
#pragma unroll
                for (int bj = 0; bj < 2; ++bj) { const u32x4 w1 = *(const u32x4*)(gp + bj * 128); f32x4 b0, b1; unpack8bf(w1, b0, b1);
                    *(u32x4*)(O + (size_t)row * 1024 + col0 + bj * 128) = pack8bf(acc[ai][bj][m][0] * b0, acc[ai][bj][m][1] * b1); }
                asm volatile("" ::: "memory"); }
    }
};

struct EpiOut {
    static constexpr bool PERM = true, AFTER_DRAIN = false, MIDK = false;
    const float* X; bf16_t* X1B; float* SSQ;
    __device__ __forceinline__ void midk(f32x4 (&)[2][2][4][2], const Unit&, int, int, int, int) const {}
    __device__ __forceinline__ void operator()(const f32x4 (&acc)[2][2][4][2], const Unit& u, int wr, int wc, int fr, int fq) const {
        const int row0 = u.pm * BM + wr * 64 + fr, col0 = u.pn * BM + wc * 32 + 8 * fq;
#pragma unroll
        for (int ai = 0; ai < 2; ++ai)
#pragma unroll
            for (int m = 0; m < 4; ++m) { const int row = row0 + ai * 128 + m * 16; const size_t off = (size_t)row * 1024 + col0; float s = 0.f;
#pragma unroll
                for (int bj = 0; bj < 2; ++bj) { const f32x4 v0 = acc[ai][bj][m][0] + *(const f32x4*)(X + off + bj * 128), v1 = acc[ai][bj][m][1] + *(const f32x4*)(X + off + bj * 128 + 4);
                    s += (v0[0] * v0[0] + v0[1] * v0[1]) + (v0[2] * v0[2] + v0[3] * v0[3]) + (v1[0] * v1[0] + v1[1] * v1[1]) + (v1[2] * v1[2] + v1[3] * v1[3]);
                    *(u32x4*)(X1B + off + bj * 128) = pack8bf(v0, v1); }
                s = rows4_sum(s);
                if (fq == 0) SSQ[(size_t)row * 16 + u.pn * 4 + wc] = s;
                asm volatile("" ::: "memory"); }
    }
};

struct EpiFfnIn {
    static constexpr bool PERM = true, AFTER_DRAIN = false, MIDK = false;
    const float* SSQ; bf16_t* ACT;
    __device__ __forceinline__ void midk(f32x4 (&)[2][2][4][2], const Unit&, int, int, int, int) const {}
    __device__ __forceinline__ void operator()(const f32x4 (&acc)[2][2][4][2], const Unit& u, int wr, int wc, int fr, int fq) const {
        const int row0 = u.pm * BM + wr * 64 + fr, col0 = u.pn * 128 + wc * 32 + 8 * fq;
#pragma unroll
        for (int ai = 0; ai < 2; ++ai)
#pragma unroll
            for (int m = 0; m < 4; ++m) { const int row = row0 + ai * 128 + m * 16; const f32x4* sp = (const f32x4*)(SSQ + (size_t)row * 16);
                const f32x4 s0 = sp[0], s1 = sp[1], s2 = sp[2], s3 = sp[3];
                const float tot = ((s0[0] + s0[1]) + (s0[2] + s0[3])) + ((s1[0] + s1[1]) + (s1[2] + s1[3])) + ((s2[0] + s2[1]) + (s2[2] + s2[3])) + ((s3[0] + s3[1]) + (s3[2] + s3[3]));
                const float rstd = __builtin_amdgcn_rsqf(tot * (1.f / 1024.f) + NORM_EPS);
                f32x4 o0, o1;
#pragma unroll
                for (int j = 0; j < 4; ++j) { const float ga = acc[ai][0][m][0][j] * rstd, gb = acc[ai][0][m][1][j] * rstd;
                    o0[j] = ga * fsigmoid(ga) * (acc[ai][1][m][0][j] * rstd); o1[j] = gb * fsigmoid(gb) * (acc[ai][1][m][1][j] * rstd); }
                *(u32x4*)(ACT + (size_t)row * DFF + col0) = pack8bf(o0, o1);
                asm volatile("" ::: "memory"); }
    }
};

struct EpiDown {
    static constexpr bool PERM = true, AFTER_DRAIN = false, MIDK = false;
    const bf16_t* X1B; float* OUT;
    __device__ __forceinline__ void midk(f32x4 (&)[2][2][4][2], const Unit&, int, int, int, int) const {}
    __device__ __forceinline__ void operator()(const f32x4 (&acc)[2][2][4][2], const Unit& u, int wr, int wc, int fr, int fq) const {
        const int row0 = u.pm * BM + wr * 64 + fr, col0 = u.pn * BM + wc * 32 + 8 * fq;
#pragma unroll
        for (int ai = 0; ai < 2; ++ai)
#pragma unroll
            for (int m = 0; m < 4; ++m) { const size_t off = (size_t)(row0 + ai * 128 + m * 16) * 1024 + col0;
#pragma unroll
                for (int bj = 0; bj < 2; ++bj) { f32x4 r0, r1; unpack8bf(*(const u32x4*)(X1B + off + bj * 128), r0, r1);
                    *(f32x4*)(OUT + off + bj * 128) = acc[ai][bj][m][0] + r0; *(f32x4*)(OUT + off + bj * 128 + 4) = acc[ai][bj][m][1] + r1; }
                asm volatile("" ::: "memory"); }
    }
};


template <class Epi, class Sched, bool ALIGN_EPI = false, bool SP2 = false>
__device__ __forceinline__ void gemm_phase(PG8_LAS unsigned char* lds, const Gemm g, const Sched& S, const Epi& E) {
    int tid = threadIdx.x; asm volatile("" : "+v"(tid));
    const int wid = __builtin_amdgcn_readfirstlane(tid >> 6), lane = tid & 63, wr = wid >> 2, wc = wid & 3, fr = lane & 15, fq = lane >> 4;
    const int K = g.K, nt = K / BK;
    unsigned voffA[2], voffB[2];
#pragma unroll
    for (int i = 0; i < 2; ++i) { int R, C; stage_rc(tid * 16 + i * 8192, R, C); const int Rb = Epi::PERM ? ((R & ~31) + perm32(R & 31)) : R;
        voffA[i] = (unsigned)(R * K + C) * 2u; voffB[i] = (unsigned)(Rb * K + C) * 2u; }
    const size_t kstep = (size_t)(BK * 2);
    const size_t hstep = (size_t)HALF * K * 2;
    const size_t tstep = 2 * hstep;
    const unsigned ldsw = (unsigned)wid * 1024u;
    const int aoff = lds_byte(wr * 64 + fr, fq * 8), boff = lds_byte(wc * 32 + fr, fq * 8);
#define PG8_SA(b, h) (((b) * 2 + (h)) * HTB)
#define PG8_SB(b, h) ((4 + (b) * 2 + (h)) * HTB)
#define PG8_STAGE(bufoff, gbase, voff) do { _Pragma("unroll") for (int _i = 0; _i < 2; ++_i) \
        __builtin_amdgcn_global_load_lds((const unsigned*)((const char*)(gbase) + (voff)[_i]), (PG8_LAS unsigned*)(lds + (bufoff) + ldsw + _i * 8192), 16, 0, 0); } while (0)
#define PG8_LDA(dst, b, h) do { _Pragma("unroll") for (int m = 0; m < 4; ++m) _Pragma("unroll") for (int k = 0; k < 2; ++k) dst[m][k] = *(const PG8_LAS bf16x8*)(lds + PG8_SA(b, h) + aoff + m * 2048 + k * 1024); } while (0)
#define PG8_LDB(dst, b, h) do { _Pragma("unroll") for (int n = 0; n < 2; ++n) _Pragma("unroll") for (int k = 0; k < 2; ++k) dst[n][k] = *(const PG8_LAS bf16x8*)(lds + PG8_SB(b, h) + boff + n * 2048 + k * 1024); } while (0)
#define PG8_MMA(ai, bj, At, Bt) do { __builtin_amdgcn_s_setprio(1); _Pragma("unroll") for (int m = 0; m < 4; ++m) _Pragma("unroll") for (int n = 0; n < 2; ++n) _Pragma("unroll") for (int k = 0; k < 2; ++k) \
        acc[ai][bj][m][n] = __builtin_amdgcn_mfma_f32_16x16x32_bf16(Bt[n][k], At[m][k], acc[ai][bj][m][n], 0, 0, 0); __builtin_amdgcn_s_setprio(0); } while (0)
#define PG8_WAIT_V(n) asm volatile("s_waitcnt vmcnt(" #n ")" ::: "memory")
#define PG8_WAIT_L(n) asm volatile("s_waitcnt lgkmcnt(" #n ")" ::: "memory")
#define PG8_BAR __builtin_amdgcn_s_barrier()
#define PG8_SCHED __builtin_amdgcn_sched_barrier(0)
    Unit cur, nxt; int ui = 0;
    if (!S.next(0, cur)) return;
    f32x4 acc[2][2][4][2];
#pragma unroll
    for (int a = 0; a < 2; ++a)
#pragma unroll
        for (int b = 0; b < 2; ++b)
#pragma unroll
            for (int m = 0; m < 4; ++m)
#pragma unroll
                for (int n = 0; n < 2; ++n) acc[a][b][m][n] = (f32x4){0.f, 0.f, 0.f, 0.f};
    bf16x8 At[4][2], B0[2][2], B1[2][2];
    const char* cA = (const char*)g.A + (size_t)cur.pm * tstep; const char* cB = (const char*)g.Bt + (size_t)cur.pn * tstep;
    S.a_ready(cur);
    if constexpr (SP2) {
        PG8_STAGE(PG8_SB(0, 0), cB, voffB); PG8_STAGE(PG8_SB(0, 1), cB + hstep, voffB); PG8_STAGE(PG8_SA(0, 0), cA, voffA); PG8_STAGE(PG8_SA(0, 1), cA + hstep, voffA);
        if (wr == 1) PG8_BAR;
        PG8_WAIT_V(2); PG8_BAR;
        PG8_STAGE(PG8_SB(1, 0), cB + kstep, voffB); PG8_STAGE(PG8_SA(1, 0), cA + kstep, voffA); PG8_STAGE(PG8_SB(1, 1), cB + hstep + kstep, voffB);
        PG8_WAIT_V(6); PG8_BAR;
    } else {
        PG8_STAGE(PG8_SB(0, 0), cB, voffB); PG8_STAGE(PG8_SA(0, 0), cA, voffA); PG8_STAGE(PG8_SB(0, 1), cB + hstep, voffB); PG8_STAGE(PG8_SA(0, 1), cA + hstep, voffA);
        if (wr == 1) PG8_BAR;
        PG8_WAIT_V(4); PG8_BAR;
        PG8_STAGE(PG8_SB(1, 0), cB + kstep, voffB); PG8_STAGE(PG8_SA(1, 0), cA + kstep, voffA); PG8_STAGE(PG8_SB(1, 1), cB + hstep + kstep, voffB);
        PG8_WAIT_V(6); PG8_BAR;
    }
    for (;;) {
        const bool has_next = S.next(ui + 1, nxt);
        const char* nA = has_next ? (const char*)g.A + (size_t)nxt.pm * tstep : cA; const char* nB = has_next ? (const char*)g.Bt + (size_t)nxt.pn * tstep : cB;
        for (int t = 0; t < nt; t += 2) {
            if constexpr (Epi::MIDK) { if (t == (nt >> 1)) E.midk(acc, cur, wr, wc, fr, fq); }
            const bool last = (t == nt - 2);
            const char* a1 = cA + (size_t)(t + 1) * kstep;
            const char* a2 = last ? nA : cA + (size_t)(t + 2) * kstep; const char* b2 = last ? nB : cB + (size_t)(t + 2) * kstep;
            const char* a3 = a2 + kstep; const char* b3 = b2 + kstep;
            if (last && has_next) S.a_ready(nxt);
            if constexpr (SP2) {
            PG8_LDB(B0, 0, 0); PG8_LDB(B1, 0, 1); PG8_SCHED; PG8_LDA(At, 0, 0); PG8_STAGE(PG8_SA(1, 1), a1 + hstep, voffA);
            PG8_WAIT_V(8); PG8_WAIT_L(0); PG8_BAR; PG8_MMA(0, 0, At, B0); PG8_MMA(0, 1, At, B1); PG8_BAR; PG8_SCHED;
            PG8_LDA(At, 0, 1); PG8_STAGE(PG8_SB(0, 0), b2, voffB); PG8_STAGE(PG8_SB(0, 1), b2 + hstep, voffB); PG8_STAGE(PG8_SA(0, 0), a2, voffA);
            PG8_WAIT_V(8); PG8_WAIT_L(0); PG8_BAR; PG8_MMA(1, 0, At, B0); PG8_MMA(1, 1, At, B1); PG8_BAR; PG8_SCHED;
            PG8_LDB(B0, 1, 0); PG8_LDB(B1, 1, 1); PG8_SCHED; PG8_LDA(At, 1, 0); PG8_STAGE(PG8_SA(0, 1), a2 + hstep, voffA);
            PG8_WAIT_V(8); PG8_WAIT_L(0); PG8_BAR; PG8_MMA(0, 0, At, B0); PG8_MMA(0, 1, At, B1); PG8_BAR; PG8_SCHED;
            PG8_LDA(At, 1, 1); PG8_STAGE(PG8_SB(1, 0), b3, voffB); PG8_STAGE(PG8_SB(1, 1), b3 + hstep, voffB); PG8_STAGE(PG8_SA(1, 0), a3, voffA);
            PG8_WAIT_V(8); PG8_WAIT_L(0); PG8_BAR; PG8_MMA(1, 0, At, B0); PG8_MMA(1, 1, At, B1); PG8_BAR; PG8_SCHED;
            } else {
            PG8_LDB(B0, 0, 0); PG8_SCHED; PG8_LDA(At, 0, 0); PG8_STAGE(PG8_SA(1, 1), a1 + hstep, voffA);
            PG8_WAIT_L(8); PG8_BAR; PG8_WAIT_L(0); PG8_MMA(0, 0, At, B0); PG8_BAR; PG8_SCHED;
            PG8_LDB(B1, 0, 1); PG8_STAGE(PG8_SB(0, 0), b2, voffB);
            PG8_BAR; PG8_WAIT_L(0); PG8_MMA(0, 1, At, B1); PG8_BAR;
            PG8_LDA(At, 0, 1); PG8_STAGE(PG8_SA(0, 0), a2, voffA);
            PG8_BAR; PG8_WAIT_L(0); PG8_MMA(1, 0, At, B0); PG8_BAR; PG8_SCHED;
            PG8_STAGE(PG8_SB(0, 1), b2 + hstep, voffB);
            PG8_WAIT_V(6); PG8_BAR; PG8_MMA(1, 1, At, B1); PG8_BAR;
            PG8_LDB(B0, 1, 0); PG8_SCHED; PG8_LDA(At, 1, 0); PG8_STAGE(PG8_SA(0, 1), a2 + hstep, voffA);
            PG8_WAIT_L(8); PG8_BAR; PG8_WAIT_L(0); PG8_MMA(0, 0, At, B0); PG8_BAR; PG8_SCHED;
            PG8_LDB(B1, 1, 1); PG8_STAGE(PG8_SB(1, 0), b3, voffB);
            PG8_BAR; PG8_WAIT_L(0); PG8_MMA(0, 1, At, B1); PG8_BAR;
            PG8_LDA(At, 1, 1); PG8_STAGE(PG8_SA(1, 0), a3, voffA);
            PG8_BAR; PG8_WAIT_L(0); PG8_MMA(1, 0, At, B0); PG8_BAR; PG8_SCHED;
            PG8_STAGE(PG8_SB(1, 1), b3 + hstep, voffB);
            PG8_WAIT_V(6); PG8_BAR; PG8_MMA(1, 1, At, B1); PG8_BAR;
            }
        }
        if constexpr (ALIGN_EPI) { if (wr == 0) PG8_BAR; }
        if constexpr (!Epi::AFTER_DRAIN) { E(acc, cur, wr, wc, fr, fq); S.done(cur); }
        if (!has_next) break;
#pragma unroll
        for (int a = 0; a < 2; ++a)
#pragma unroll
            for (int b = 0; b < 2; ++b)
#pragma unroll
                for (int m = 0; m < 4; ++m)
#pragma unroll
                    for (int n = 0; n < 2; ++n) acc[a][b][m][n] = (f32x4){0.f, 0.f, 0.f, 0.f};
        cur = nxt; cA = nA; cB = nB; ++ui;
        if constexpr (ALIGN_EPI) { if (wr == 1) PG8_BAR; }
    }
    PG8_WAIT_V(0);
    if constexpr (!ALIGN_EPI) { if (wr == 0) PG8_BAR; }
    PG8_BAR;
    if constexpr (Epi::AFTER_DRAIN) { E.fused(acc, cur, wr, wc, fr, fq, lds, wid, lane); S.done(cur); }
#undef PG8_SA
#undef PG8_SB
#undef PG8_STAGE
#undef PG8_LDA
#undef PG8_LDB
#undef PG8_MMA
#undef PG8_WAIT_V
#undef PG8_WAIT_L
#undef PG8_BAR
#undef PG8_SCHED
}
}

constexpr size_t MiB = 1u << 20;
constexpr size_t WS_CTL = 0, CTL_ZERO_BYTES = 64 * 1024;
constexpr size_t WS_WT_IN = 1 * MiB;
constexpr size_t WS_LST = 1 * MiB, WS_DST = 17 * MiB;
constexpr size_t WS_WT_CAT = 19 * MiB;
constexpr size_t WS_WT_OUT = 23 * MiB;
constexpr size_t WS_H = 25 * MiB;
constexpr size_t WS_WT_FIN = 25 * MiB;
constexpr size_t WS_WT_DOWN = 36 * MiB;
constexpr size_t WS_QQ = 57 * MiB;
constexpr size_t WS_AK = 121 * MiB, WS_AV = 153 * MiB;
constexpr size_t WS_HLF = 185 * MiB, WS_HSG = 217 * MiB;
constexpr size_t WS_KMEAN = 249 * MiB, WS_KMEANB = 249 * MiB + 512 * 1024, WS_LB = 250 * MiB, WS_SSQ = 251 * MiB;
constexpr size_t WS_MERGED = 121 * MiB;
constexpr size_t WS_X1 = 153 * MiB;
constexpr size_t WS_A2 = 217 * MiB;
constexpr size_t WS_ACT = 57 * MiB;
constexpr size_t WS_END = 256 * MiB;
static_assert(WS_ACT + (size_t)MTOK * DFF * 2 <= WS_X1 && WS_SSQ + (size_t)MTOK * 16 * 4 <= WS_END, "d_ws map");
constexpr int CW_TMO = 0, CW_BAR = 4096;

constexpr int RING_OFF = 0, RING_BYTES = 131072;
constexpr int EPI_SCR_OFF = RING_BYTES;
constexpr int LDSCTL_OFF = RING_BYTES + 12288, MISC_OFF = LDSCTL_OFF + 320;
constexpr int LDS_BYTES = 147456;
static_assert(MISC_OFF + 128 <= LDS_BYTES, "LDS map");
constexpr int NWAVES = 8;

__device__ __forceinline__ float bf2f(unsigned short b) { return __uint_as_float((unsigned)b << 16); }


#define GAS __attribute__((address_space(1)))
#define LAS __attribute__((address_space(3)))
typedef unsigned short bf16;
typedef unsigned v4u __attribute__((ext_vector_type(4)));
typedef float f32x4 __attribute__((ext_vector_type(4)));
typedef short bf16x8 __attribute__((ext_vector_type(8)));
typedef GAS unsigned gu32;
typedef GAS unsigned long long gu64;
#define RLX_AGENT __ATOMIC_RELAXED, __HIP_MEMORY_SCOPE_AGENT
#define LDS_WAIT() asm volatile("s_waitcnt lgkmcnt(0)" ::: "memory")
#define VM_WAIT() asm volatile("s_waitcnt vmcnt(0)" ::: "memory")
__device__ __forceinline__ unsigned long long rt() { return __builtin_amdgcn_s_memrealtime(); }
__device__ __forceinline__ unsigned f2bf(float f) { unsigned u = __builtin_bit_cast(unsigned, f); return (u + 0x7fffu + ((u >> 16) & 1u)) >> 16; }
__device__ __forceinline__ unsigned pk2(float lo, float hi) { return f2bf(lo) | (f2bf(hi) << 16); }

#define XB_TMO      128
#define XB_XCNT(j)  (256  + 64 * (j))
#define XB_XSUB(j)  (1280 + 64 * (j))
#define XB_XGEN(j)  (2304 + 64 * (j))
#define XB_TOP      3328
#define XB_TOPGEN   3392
#define XCD_BAR_WORDS 3456
#define XB_SPIN_CAP (1u << 18)

__device__ __forceinline__ unsigned xb_ld(unsigned* p)              { return __hip_atomic_load(p, __ATOMIC_RELAXED, __HIP_MEMORY_SCOPE_AGENT); }
__device__ __forceinline__ unsigned xb_add(unsigned* p, unsigned v) { return __hip_atomic_fetch_add(p, v, __ATOMIC_RELAXED, __HIP_MEMORY_SCOPE_AGENT); }
__device__ __forceinline__ unsigned xb_xcc_id() { return (unsigned)__builtin_amdgcn_s_getreg((3 << 11) | 20) & 0xFu; }
#define XB_SPIN(cond, bar) do { unsigned _sp = 0; while (cond) { __builtin_amdgcn_s_sleep(1); \
    if ((++_sp & 255u) == 0u) { if (xb_ld(&(bar)[XB_TMO])) break; if (_sp > XB_SPIN_CAP) { atomicAdd(&(bar)[XB_TMO], 1u); break; } } } } while (0)

struct XcdBarrier {
    unsigned* bar; unsigned x;
    volatile LAS unsigned* st;
};

__device__ __forceinline__ XcdBarrier xcd_barrier_post(unsigned* bar, volatile LAS unsigned* st) {
    XcdBarrier b; b.bar = bar; b.x = xb_xcc_id(); b.st = st;
    if (threadIdx.x == 0) (void)xb_add(&bar[XB_XCNT(b.x)], 1u);
    return b;
}
__device__ __forceinline__ void xcd_barrier_complete(unsigned* bar, unsigned x, unsigned& nloc, unsigned& nx) {
    const unsigned G = gridDim.x * gridDim.y * gridDim.z;
    unsigned sum, cnt, mine, sp = 0u;
    for (;;) {
        sum = 0u; cnt = 0u; mine = 0u;
#pragma unroll
        for (unsigned j = 0; j < 16; ++j) { const unsigned c = xb_ld(&bar[XB_XCNT(j)]); sum += c; cnt += (c > 0u) ? 1u : 0u; mine = (j == x) ? c : mine; }
        if (sum == G) break;
        __builtin_amdgcn_s_sleep(1);
        if ((++sp & 255u) == 0u) { if (xb_ld(&bar[XB_TMO])) break; if (sp > XB_SPIN_CAP) { atomicAdd(&bar[XB_TMO], 1u); break; } }
    }
    nloc = mine > 0u ? mine : 1u; nx = cnt > 0u ? cnt : 1u;
}

__device__ __forceinline__ void xcd_barrier(const XcdBarrier& b) {
    asm volatile("s_waitcnt vmcnt(0)" ::: "memory");
    __syncthreads();
    if (threadIdx.x == 0) {
        unsigned* bar = b.bar;
        __builtin_amdgcn_s_waitcnt(0);
        unsigned nloc = b.st[0], nx = b.st[1];
        if (nloc == 0u) { xcd_barrier_complete(bar, b.x, nloc, nx); b.st[0] = nloc; b.st[1] = nx; }
        const unsigned old = xb_add(&bar[XB_XSUB(b.x)], 1u);
        const unsigned gen = old / nloc;
        if (old + 1u == (gen + 1u) * nloc) {
            __builtin_amdgcn_fence(__ATOMIC_RELEASE, "agent");
            asm volatile("s_waitcnt vmcnt(0)" ::: "memory");
            const unsigned og = xb_add(&bar[XB_TOP], 1u);
            const unsigned tg = og / nx;
            if (og + 1u == (tg + 1u) * nx) xb_add(&bar[XB_TOPGEN], 1u);
            else XB_SPIN(xb_ld(&bar[XB_TOPGEN]) == tg, bar);
            __builtin_amdgcn_fence(__ATOMIC_ACQUIRE, "agent");
            xb_add(&bar[XB_XGEN(b.x)], 1u);
            asm volatile("s_waitcnt vmcnt(0)" ::: "memory");
        } else {
            XB_SPIN(xb_ld(&bar[XB_XGEN(b.x)]) == gen, bar);
            __builtin_amdgcn_fence(__ATOMIC_ACQUIRE, "agent");
            asm volatile("s_waitcnt vmcnt(0)" ::: "memory");
        }
    }
    __syncthreads();
}

namespace moba {
typedef unsigned short bf16;
typedef short bf16x8 __attribute__((ext_vector_type(8)));
typedef short s16x4 __attribute__((ext_vector_type(4)));
typedef float f32x16 __attribute__((ext_vector_type(16)));
typedef float f32x4 __attribute__((ext_vector_type(4)));
typedef unsigned u32x4 __attribute__((ext_vector_type(4)));
constexpr float SCALE = 0.08838834764831845f;
constexpr float THR = 8.f;
constexpr int NW = 8, QBLK = 32, KVBLK = 64, QB = NW * QBLK, D = 128;
constexpr int QP = 2048, KP = 1024;
constexpr int SHM_V = KVBLK * D * 2, SHM_K = KVBLK * D * 2;
constexpr int OFF_WS = 2 * SHM_V + 2 * SHM_K, OFF_BIAS = OFF_WS + NW * 64 * 4, LDS_BYTES = OFF_BIAS + 512;
#define KSWZ(row, colB) ((row) * 256 + ((colB) ^ (((row) & 7) << 4)))
#define KSW16(row, colB) ((row) * 256 + ((colB) ^ (((row) & 15) << 4)))
#define SBAR() __builtin_amdgcn_sched_barrier(0)
__device__ __forceinline__ int v_st(int k, int c) { const int kk = (k & ~0xC) | ((k & 4) << 1) | ((k & 8) >> 1); return ((kk >> 3) * 4 + (c >> 5)) * 512 + ((kk & 7) * 32 + (c & 31)) * 2; }
__device__ __forceinline__ int v_rd_base(int lane) { return ((lane & 3) << 3) | (((lane >> 2) & 3) << 6) | (((lane >> 4) & 1) << 5) | (((lane >> 5) & 1) << 8); }
constexpr int v_rd_off(int d0, int ks, int half) { return d0 * 512 + ks * 4096 + half * 2048; }
__device__ __forceinline__ int crow(int r, int hi) { return (r & 3) + 8 * (r >> 2) + 4 * hi; }
__device__ __forceinline__ unsigned cvtpk(float lo, float hi) { unsigned r; asm volatile("v_cvt_pk_bf16_f32 %0, %1, %2" : "=v"(r) : "v"(lo), "v"(hi)); return r; }
template <int CTRL> __device__ __forceinline__ float dpp_mov(float v) { return __int_as_float(__builtin_amdgcn_update_dpp(0, __float_as_int(v), CTRL, 0xf, 0xf, true)); }
__device__ __forceinline__ bf16x8 load8(const bf16* p) { return *reinterpret_cast<const bf16x8*>(p); }

__device__ __forceinline__ void partialSM(f32x16& p0, f32x16& p1, float& m_reg, float& mn, float& alpha) {
    float pmax = p0[0]; for (int r = 1; r < 16; ++r) pmax = fmaxf(pmax, p0[r]); for (int r = 0; r < 16; ++r) pmax = fmaxf(pmax, p1[r]);
    { auto rr = __builtin_amdgcn_permlane32_swap(__float_as_uint(pmax), __float_as_uint(pmax), false, false);
      pmax = fmaxf(__uint_as_float(rr[0]), __uint_as_float(rr[1])); }
    constexpr float C2 = 1.4426950408889634f * SCALE;
    if (__builtin_expect(__all((pmax - m_reg) * SCALE <= THR), 1)) { mn = m_reg; alpha = 1.f; }
    else { mn = fmaxf(m_reg, pmax); alpha = __builtin_amdgcn_exp2f((m_reg - mn) * C2); m_reg = mn; }
    const float mnL = -mn * C2;
    for (int r = 0; r < 16; ++r) p0[r] = fmaf(p0[r], C2, mnL); for (int r = 0; r < 16; ++r) p1[r] = fmaf(p1[r], C2, mnL);
    for (int r = 0; r < 16; ++r) p0[r] = __builtin_amdgcn_exp2f(p0[r]);
}
__device__ __forceinline__ void finishSM(f32x16& p0, f32x16& p1, float alpha, float& l_reg, bf16x8& pa0, bf16x8& pa1, bf16x8& pa2, bf16x8& pa3) {
    for (int r = 0; r < 16; ++r) p1[r] = __builtin_amdgcn_exp2f(p1[r]);
    float ps = 0; for (int r = 0; r < 16; ++r) ps += p0[r]; for (int r = 0; r < 16; ++r) ps += p1[r];
    { auto rr = __builtin_amdgcn_permlane32_swap(__float_as_uint(ps), __float_as_uint(ps), false, false);
      ps = __uint_as_float(rr[0]) + __uint_as_float(rr[1]); }
    l_reg = l_reg * alpha + ps;
#define PK4(P, B_, OUT) do { unsigned a0 = cvtpk(P[B_+0], P[B_+1]), a1 = cvtpk(P[B_+2], P[B_+3]);                          \
        unsigned b0 = cvtpk(P[B_+4], P[B_+5]), b1 = cvtpk(P[B_+6], P[B_+7]);                                             \
        auto r0 = __builtin_amdgcn_permlane32_swap(a0, b0, false, false); auto r1 = __builtin_amdgcn_permlane32_swap(a1, b1, false, false); \
        u32x4 w = {r0[0], r1[0], r0[1], r1[1]}; OUT = *reinterpret_cast<bf16x8*>(&w); } while (0)
    PK4(p0, 0, pa0); PK4(p0, 8, pa1); PK4(p1, 0, pa2); PK4(p1, 8, pa3);
#undef PK4
}
__device__ __forceinline__ void expA(f32x16& p0, f32x16& p1, float negMC) {
    constexpr float C2 = 1.4426950408889634f * SCALE;
    for (int r = 0; r < 16; ++r) p0[r] = fmaf(p0[r], C2, negMC); for (int r = 0; r < 16; ++r) p1[r] = fmaf(p1[r], C2, negMC);
    for (int r = 0; r < 16; ++r) p0[r] = __builtin_amdgcn_exp2f(p0[r]);
}
__device__ __forceinline__ void finishFS(f32x16& p0, f32x16& p1, bool keep, float& l_reg, bf16x8& pa0, bf16x8& pa1, bf16x8& pa2, bf16x8& pa3) {
    for (int r = 0; r < 16; ++r) p1[r] = __builtin_amdgcn_exp2f(p1[r]);
    float ps = 0; for (int r = 0; r < 16; ++r) ps += p0[r]; for (int r = 0; r < 16; ++r) ps += p1[r];
    { auto rr = __builtin_amdgcn_permlane32_swap(__float_as_uint(ps), __float_as_uint(ps), false, false);
      ps = __uint_as_float(rr[0]) + __uint_as_float(rr[1]); }
    l_reg += keep ? ps : 0.f;
    const unsigned km = keep ? 0xffffffffu : 0u;
#define PK4(P, B_, OUT) do { unsigned a0 = cvtpk(P[B_+0], P[B_+1]) & km, a1 = cvtpk(P[B_+2], P[B_+3]) & km;                 \
        unsigned b0 = cvtpk(P[B_+4], P[B_+5]) & km, b1 = cvtpk(P[B_+6], P[B_+7]) & km;                                     \
        auto r0 = __builtin_amdgcn_permlane32_swap(a0, b0, false, false); auto r1 = __builtin_amdgcn_permlane32_swap(a1, b1, false, false); \
        u32x4 w = {r0[0], r1[0], r0[1], r1[1]}; OUT = *reinterpret_cast<bf16x8*>(&w); } while (0)
    PK4(p0, 0, pa0); PK4(p0, 8, pa1); PK4(p1, 0, pa2); PK4(p1, 8, pa3);
#undef PK4
}
template <int KB>
__device__ __forceinline__ void qkt(f32x16& p0, f32x16& p1, const char* K_lds, int r32, int hi, const bf16x8* qr) {
    p0 = f32x16{}; p1 = f32x16{};
    const char* kb[4];
#pragma unroll
    for (int dd = 0; dd < 4; ++dd) kb[dd] = K_lds + KB * SHM_K + KSWZ(r32, (dd * 16 + hi * 8) * 2);
#pragma unroll
    for (int d0 = 0; d0 < 8; ++d0) { const char* a = kb[d0 & 3] + (d0 >> 2) * 128;
        bf16x8 b0 = *reinterpret_cast<const bf16x8*>(a);
        bf16x8 b1 = *reinterpret_cast<const bf16x8*>(a + 32 * 256);
        p0 = __builtin_amdgcn_mfma_f32_32x32x16_bf16(b0, qr[d0], p0, 0, 0, 0);
        p1 = __builtin_amdgcn_mfma_f32_32x32x16_bf16(b1, qr[d0], p1, 0, 0, 0); }
}
template <int VB>
__device__ __forceinline__ void pv_tile(f32x16* o, int vb0, bf16x8 pa0, bf16x8 pa1, bf16x8 pa2, bf16x8 pa3) {
#define TRRD(dst, off) asm volatile("ds_read_b64_tr_b16 %0, %1 offset:%2" : "=&v"(dst) : "v"(vb0), "i"(off) : "memory")
#define PV_D0(d0) do { s16x4 l0, l1, l2, l3, h0, h1, h2, h3; constexpr int b_ = VB * SHM_V + v_rd_off(d0, 0, 0); \
        TRRD(l0, b_); TRRD(h0, b_ + 2048); TRRD(l1, b_ + 4096); TRRD(h1, b_ + 6144); TRRD(l2, b_ + 8192); TRRD(h2, b_ + 10240); TRRD(l3, b_ + 12288); TRRD(h3, b_ + 14336); \
        asm volatile("s_waitcnt lgkmcnt(0)" ::: "memory"); SBAR();   \
        o[d0] = __builtin_amdgcn_mfma_f32_32x32x16_bf16(pa0, (bf16x8){l0[0], l0[1], l0[2], l0[3], h0[0], h0[1], h0[2], h0[3]}, o[d0], 0, 0, 0);   \
        o[d0] = __builtin_amdgcn_mfma_f32_32x32x16_bf16(pa1, (bf16x8){l1[0], l1[1], l1[2], l1[3], h1[0], h1[1], h1[2], h1[3]}, o[d0], 0, 0, 0);   \
        o[d0] = __builtin_amdgcn_mfma_f32_32x32x16_bf16(pa2, (bf16x8){l2[0], l2[1], l2[2], l2[3], h2[0], h2[1], h2[2], h2[3]}, o[d0], 0, 0, 0);   \
        o[d0] = __builtin_amdgcn_mfma_f32_32x32x16_bf16(pa3, (bf16x8){l3[0], l3[1], l3[2], l3[3], h3[0], h3[1], h3[2], h3[3]}, o[d0], 0, 0, 0); } while (0)
    PV_D0(0); PV_D0(1); PV_D0(2); PV_D0(3);
#undef PV_D0
#undef TRRD
}
__device__ __forceinline__ void mask_all(f32x16& p0, f32x16& p1, bool keep) {
    const float NEG = -__builtin_inff();
#pragma unroll
    for (int r = 0; r < 16; ++r) { p0[r] = keep ? p0[r] : NEG; p1[r] = keep ? p1[r] : NEG; }
}
__device__ __forceinline__ void mask_bias(f32x16& p0, f32x16& p1, int dq, const float* biasL, bool causal) {
    const float NEG = -__builtin_inff();
#pragma unroll
    for (int g = 0; g < 4; ++g) {
#pragma unroll
        for (int j = 0; j < 4; ++j) { const int r = 4 * g + j;
            const int c = (r & 3) + 8 * (r >> 2); const int d0 = dq - c, d1 = d0 - 32;
            const int i0 = d0 < 0 ? 0 : (d0 > 113 ? 113 : d0), i1 = d1 < 0 ? 0 : (d1 > 113 ? 113 : d1);
            const float v0 = p0[r] + biasL[i0], v1 = p1[r] + biasL[i1];
            p0[r] = (causal && d0 < 0) ? NEG : v0; p1[r] = (causal && d1 < 0) ? NEG : v1; }
        SBAR();
    }
}

struct BlockRef { const bf16* Q; const bf16* K; const bf16* V; bf16* O; const bf16* KM; const float* BT; const float* QG; const float* KG; int P0; };
struct Seam { bf16x8 qr[8]; bf16x8 st_v0, st_v1, st_k0, st_k1; int vs; };
#define ROWK(p, k0, rr) ((p) + (size_t)((k0) + (rr)) * KP + sc)
#define VMW() asm volatile("s_waitcnt vmcnt(0)" ::: "memory")
#define VMWN(n) asm volatile("s_waitcnt vmcnt(%0)" :: "i"(n) : "memory")
#define SLOAD_H(Kp, Vp, k0) do { S.st_v0 = load8(ROWK(Vp, k0, sr)); S.st_v1 = load8(ROWK(Vp, k0, 32 + sr));              \
                         S.st_k0 = load8(ROWK(Kp, k0, sr)); S.st_k1 = load8(ROWK(Kp, k0, 32 + sr)); } while (0)
#define SWRITE_HK(bf) do { *(bf16x8*)(K_lds + (bf) * SHM_K + kws) = S.st_k0; *(bf16x8*)(K_lds + (bf) * SHM_K + kws + 32 * 256) = S.st_k1; } while (0)
#define SWRITE_HV(bf) do { *(bf16x8*)(V_lds + (bf) * SHM_V + vst0) = S.st_v0; *(bf16x8*)(V_lds + (bf) * SHM_V + vst1) = S.st_v1; } while (0)
#define SWRITE_H(bf) do { SWRITE_HV(bf); SWRITE_HK(bf); } while (0)
__device__ __forceinline__ void moba_prime(const BlockRef& cur, char* lds, Seam& S) {
    int tid = threadIdx.x; asm volatile("" : "+v"(tid));
    const int wid = __builtin_amdgcn_readfirstlane(tid >> 6), lane = tid & 63, r32 = lane & 31, hi = lane >> 5;
    const int sr = tid >> 4, sc = (tid & 15) * 8, kws = KSWZ(sr, sc * 2); char* K_lds = lds + 2 * SHM_V;
    for (int d0 = 0; d0 < 8; ++d0) S.qr[d0] = load8(cur.Q + (size_t)(wid * QBLK + r32) * QP + d0 * 16 + hi * 8);
    SLOAD_H(cur.K, cur.V, 0); VMW(); SWRITE_HK(0);
    __syncthreads();
}
__device__ __forceinline__ void moba_block(const BlockRef& cur, const BlockRef& nxt, char* lds, Seam& S) {
    int tid = threadIdx.x; asm volatile("" : "+v"(tid));
    const int wid = __builtin_amdgcn_readfirstlane(tid >> 6), lane = tid & 63, r32 = lane & 31, hi = lane >> 5;
    const int cblk = cur.P0 >> 8;
    const int NT = 4 * (cblk + 1);
    const int qlo = cur.P0 + wid * QBLK, qm = qlo + r32 - 4 * hi;
    char* V_lds = lds; char* K_lds = lds + 2 * SHM_V;
    float* ws = (float*)(lds + OFF_WS) + wid * 64; float* li_l = ws; float* biasL = (float*)(lds + OFF_BIAS);
    float l_reg = 0; f32x16 o[4];
    const int sr = tid >> 4, sc = (tid & 15) * 8, vst0 = v_st(sr, sc), vst1 = v_st(32 + sr, sc), kws = KSWZ(sr, sc * 2);
    const int vb0 = (int)(uintptr_t)V_lds + v_rd_base(lane);
    const bf16* Kh = cur.K; const bf16* Vh = cur.V;
    f32x16 pA0, pA1, pB0, pB1; bf16x8 pa0, pa1, pa2, pa3;
    if (tid < 128) { const int d = tid < 113 ? tid : 113; int bk = d;
        if (d >= 16) { bk = 15; bk += d >= 16; bk += d >= 19; bk += d >= 21; bk += d >= 24; bk += d >= 27; bk += d >= 31; bk += d >= 35; bk += d >= 40;
            bk += d >= 46; bk += d >= 52; bk += d >= 59; bk += d >= 67; bk += d >= 77; bk += d >= 87; bk += d >= 99; bk += d >= 113; }
        biasL[tid] = (cur.BT[bk * 8] - cur.BT[31 * 8]) * (1.f / SCALE); }
    if (tid < 256) { const bf16x8 kmv = load8(cur.KM + (size_t)(tid >> 4) * 128 + (tid & 15) * 8); *(bf16x8*)(K_lds + SHM_K + KSWZ(tid >> 4, (tid & 15) * 16)) = kmv; }
    __syncthreads();
    unsigned selmask = 0u;
#ifndef ATT_NOGATE
    { qkt<1>(pA0, pA1, K_lds, r32, hi, S.qr);
      float G[16];
#pragma unroll
      for (int r = 0; r < 8; ++r) { auto rr = __builtin_amdgcn_permlane32_swap(__float_as_uint(pA0[r]), __float_as_uint(pA0[r]), false, false);
          const int n0 = (r & 3) + 8 * (r >> 2); G[n0] = __uint_as_float(rr[0]); G[n0 + 4] = __uint_as_float(rr[1]); }
#pragma unroll
      for (int s = 0; s < 3; ++s) { float bv = 0.f; int bi = -1;
#pragma unroll
          for (int n = 0; n < 16; ++n) { const bool ok = (n < cblk) && !((selmask >> n) & 1u); const bool take = ok && (bi < 0 || G[n] > bv); bv = take ? G[n] : bv; bi = take ? n : bi; }
          selmask |= (bi >= 0) ? (1u << bi) : 0u; }
    }
#endif
    __syncthreads();
    o[0] = f32x16{}; o[1] = f32x16{}; o[2] = f32x16{}; o[3] = f32x16{};
#define KBASE(t) ((t) * KVBLK)
    float negMC;
    { float mq = fmaxf(fabsf(cur.QG[lane]), fabsf(cur.QG[lane + 64])), mk = fmaxf(fabsf(cur.KG[lane]), fabsf(cur.KG[lane + 64])), mb = fmaxf(biasL[lane], biasL[lane + 64]);
#pragma unroll
      for (int s = 1; s < 64; s <<= 1) { mq = fmaxf(mq, __shfl_xor(mq, s)); mk = fmaxf(mk, __shfl_xor(mk, s)); mb = fmaxf(mb, __shfl_xor(mb, s)); }
      negMC = -(1.02f * 128.f * mq * mk + fmaxf(mb, 0.f)) * (1.4426950408889634f * SCALE); }
#define MASKT(P0_, P1_, t) do { const int kb_ = KBASE(t), nb_ = (t) >> 2; \
        if (qlo - (kb_ + KVBLK - 1) < 113) mask_bias(P0_, P1_, qm - kb_, biasL, nb_ == cblk); } while (0)
#define KEEP(t) ((((t) >> 2) >= cblk) || ((selmask >> ((t) >> 2)) & 1u))
    constexpr int NQL = 8;
#define SEAM_K0() do { VMWN(NQL); SWRITE_HK(0); SBAR(); } while (0)
    SWRITE_HV(0); SBAR();
    SLOAD_H(Kh, Vh, KBASE(1));
    SBAR(); qkt<0>(pA0, pA1, K_lds, r32, hi, S.qr);
    MASKT(pA0, pA1, 0); expA(pA0, pA1, negMC);
    VMW(); SWRITE_H(1);
    __syncthreads();
#define HALF_STEP(PX0, PX1, PY0, PY1, t, KB, VB, SB) do {                                                                     \
        SBAR(); qkt<KB>(PX0, PX1, K_lds, r32, hi, S.qr);                                                                      \
        finishFS(PY0, PY1, KEEP((t) - 1), l_reg, pa0, pa1, pa2, pa3); SBAR();                                                 \
        if ((t) + 1 < NT) { SLOAD_H(Kh, Vh, KBASE((t) + 1)); SBAR(); }                                                        \
        pv_tile<VB>(o, vb0, pa0, pa1, pa2, pa3); MASKT(PX0, PX1, (t)); expA(PX0, PX1, negMC);                                 \
        __syncthreads();                                                                                                      \
        if ((t) + 1 < NT) { VMW(); SWRITE_H(SB); }                                                                            \
        __syncthreads(); } while (0)
    for (int t = 1; t + 1 < NT; t += 2) {
        HALF_STEP(pB0, pB1, pA0, pA1, t, 1, 0, 0);
        HALF_STEP(pA0, pA1, pB0, pB1, t + 1, 0, 1, 1);
    }
    SBAR(); qkt<1>(pB0, pB1, K_lds, r32, hi, S.qr); SBAR();
    SLOAD_H(nxt.K, nxt.V, 0); SBAR();
#pragma unroll
    for (int d0 = 0; d0 < 8; ++d0) S.qr[d0] = load8(nxt.Q + (size_t)(wid * QBLK + r32) * QP + d0 * 16 + hi * 8);
    SBAR();
    finishFS(pA0, pA1, true, l_reg, pa0, pa1, pa2, pa3); SBAR();
    pv_tile<0>(o, vb0, pa0, pa1, pa2, pa3);
    MASKT(pB0, pB1, NT - 1); expA(pB0, pB1, negMC); __syncthreads();
    finishFS(pB0, pB1, true, l_reg, pa0, pa1, pa2, pa3); SBAR(); pv_tile<1>(o, vb0, pa0, pa1, pa2, pa3);
    SBAR(); SEAM_K0();
    if (hi == 0) li_l[r32] = l_reg; asm volatile("s_waitcnt lgkmcnt(0)" ::: "memory");
    float rli[16];
#pragma unroll
    for (int r = 0; r < 16; ++r) rli[r] = __builtin_amdgcn_rcpf(li_l[crow(r, hi)]);
    bf16* Ow = cur.O + (size_t)(wid * QBLK) * QP;
#pragma unroll
    for (int r = 0; r < 16; ++r) { const int orow = crow(r, hi);
#pragma unroll
        for (int d0 = 0; d0 < 4; ++d0) { const float v = o[d0][r] * rli[r];
            const float vn = dpp_mov<0xB1>(v);
            if ((r32 & 1) == 0) *(unsigned*)(Ow + (size_t)orow * QP + d0 * 32 + r32) = cvtpk(v, vn); } }
    __syncthreads();
#undef KBASE
#undef MASKT
#undef KEEP
#undef SEAM_K0
#undef HALF_STEP
}

#ifndef MK_ATT_OL
#define MK_ATT_OL 0
#endif
typedef float f32x2_t __attribute__((ext_vector_type(2)));
typedef __bf16 bf16x2_t __attribute__((ext_vector_type(2)));
__device__ __forceinline__ unsigned cvtpk2(float lo, float hi) { f32x2_t v = {lo, hi}; bf16x2_t b = __builtin_convertvector(v, bf16x2_t); return __builtin_bit_cast(unsigned, b); }
__device__ __forceinline__ void sm_tile(f32x16& p0, f32x16& p1, bf16x8* pa, float& l_reg) {
#pragma unroll
    for (int r = 0; r < 16; ++r) { p0[r] = __builtin_amdgcn_exp2f(p0[r]); p1[r] = __builtin_amdgcn_exp2f(p1[r]); }
    if constexpr (!MK_ATT_OL) {
#pragma unroll
        for (int r = 0; r < 16; ++r) l_reg += p0[r];
#pragma unroll
        for (int r = 0; r < 16; ++r) l_reg += p1[r]; }
#define PK4(P, B_, OUT) do { unsigned a0 = cvtpk2(P[B_+0], P[B_+1]), a1 = cvtpk2(P[B_+2], P[B_+3]);                         \
        unsigned b0 = cvtpk2(P[B_+4], P[B_+5]), b1 = cvtpk2(P[B_+6], P[B_+7]);                                             \
        auto r0 = __builtin_amdgcn_permlane32_swap(a0, b0, false, false); auto r1 = __builtin_amdgcn_permlane32_swap(a1, b1, false, false); \
        u32x4 w = {r0[0], r1[0], r0[1], r1[1]}; OUT = *reinterpret_cast<bf16x8*>(&w); } while (0)
    PK4(p0, 0, pa[0]); PK4(p0, 8, pa[1]); PK4(p1, 0, pa[2]); PK4(p1, 8, pa[3]);
#undef PK4
}
#define A2_TR(dst, off) do { if constexpr ((ABL & 512) != 0) asm volatile("" : "=v"(dst)); else asm volatile("ds_read_b64_tr_b16 %0, %1 offset:%2" : "=&v"(dst) : "v"(vb0), "i"(off) : "memory"); } while (0)
#define A2_KR(dst, areg, off) do { if constexpr ((ABL & 512) != 0) asm volatile("" : "=v"(dst)); else asm volatile("ds_read_b128 %0, %1 offset:%2" : "=&v"(dst) : "v"(areg), "i"(off) : "memory"); } while (0)
#define A2_RPV(T, VB, k, ks) do { constexpr int b_ = (VB) * SHM_V + (2 * (k)) * 512 + (ks) * 4096; A2_TR(T[0], b_); A2_TR(T[1], b_ + 2048); A2_TR(T[2], b_ + 512); A2_TR(T[3], b_ + 512 + 2048); } while (0)
#define A2_RQK(Kf, KB, d0) do { constexpr int o_ = (KB) * SHM_K; A2_KR(Kf[0], kbv[d0], o_); A2_KR(Kf[1], kbv[d0], o_ + 8192); } while (0)
#define A2_WPV(N, T) asm volatile("s_waitcnt lgkmcnt(" #N ")" : "+v"(T[0]), "+v"(T[1]), "+v"(T[2]), "+v"(T[3]) :: "memory")
#define A2_WQK(N, Kf) asm volatile("s_waitcnt lgkmcnt(" #N ")" : "+v"(Kf[0]), "+v"(Kf[1]) :: "memory")
#define A2_CAT(a, b) ((bf16x8){a[0], a[1], a[2], a[3], b[0], b[1], b[2], b[3]})
#define A2_MPV(T, k, ks) do { if constexpr (!(ABL & 1)) { o[2 * (k)] = __builtin_amdgcn_mfma_f32_32x32x16_bf16(pa[ks], A2_CAT(T[0], T[1]), o[2 * (k)], 0, 0, 0);            \
                              o[2 * (k) + 1] = __builtin_amdgcn_mfma_f32_32x32x16_bf16(pa[ks], A2_CAT(T[2], T[3]), o[2 * (k) + 1], 0, 0, 0);            \
                              if constexpr ((k) == 0 && MK_ATT_OL) ol = __builtin_amdgcn_mfma_f32_32x32x16_bf16(pa[ks], ones, ol, 0, 0, 0); } SBAR(); } while (0)
#define A2_MQK(Kf, d0) do { if constexpr (!(ABL & 1)) { p0 = __builtin_amdgcn_mfma_f32_32x32x16_bf16(Kf[0], S.qr[d0], p0, 0, 0, 0);                                    \
                            p1 = __builtin_amdgcn_mfma_f32_32x32x16_bf16(Kf[1], S.qr[d0], p1, 0, 0, 0); } SBAR(); } while (0)
template <int VB, int KB, bool DO_PV, bool DO_QK, int ABL = 0>
__device__ __forceinline__ void mstretch(f32x16* o, f32x16& ol, f32x16& p0, f32x16& p1, const bf16x8* pa, const Seam& S, int vb0, const int* kbv, const f32x16& negm, const bf16x8 ones) {
    s16x4 T0[4], T1[4], T2[4], T3[4], T4[4], T5[4], T6[4], T7[4]; bf16x8 Q0[2], Q1[2], Q2[2], Q3[2], Q4[2], Q5[2], Q6[2], Q7[2];
    if constexpr (DO_PV && DO_QK) {
        A2_RPV(T0, VB, 0, 0); A2_RPV(T1, VB, 0, 1); A2_RPV(T2, VB, 0, 2);
        A2_WPV(8, T0); A2_RPV(T3, VB, 0, 3); A2_MPV(T0, 0, 0);
        A2_WPV(8, T1); A2_RPV(T4, VB, 1, 0); A2_MPV(T1, 0, 1);
        A2_WPV(8, T2); A2_RPV(T5, VB, 1, 1); A2_MPV(T2, 0, 2);
        A2_WPV(8, T3); A2_RPV(T6, VB, 1, 2); A2_MPV(T3, 0, 3);
        A2_WPV(8, T4); A2_RPV(T7, VB, 1, 3); A2_MPV(T4, 1, 0);
        A2_WPV(8, T5); A2_RQK(Q0, KB, 0);    A2_MPV(T5, 1, 1);
        A2_WPV(6, T6); A2_RQK(Q1, KB, 1);    A2_MPV(T6, 1, 2);
        A2_WPV(4, T7); A2_RQK(Q2, KB, 2);    A2_MPV(T7, 1, 3);
        p0 = negm; p1 = negm;
        A2_WQK(4, Q0); A2_RQK(Q3, KB, 3);    A2_MQK(Q0, 0);
        A2_WQK(4, Q1); A2_RQK(Q4, KB, 4);    A2_MQK(Q1, 1);
        A2_WQK(4, Q2); A2_RQK(Q5, KB, 5);    A2_MQK(Q2, 2);
        A2_WQK(4, Q3); A2_RQK(Q6, KB, 6);    A2_MQK(Q3, 3);
        A2_WQK(4, Q4); A2_RQK(Q7, KB, 7);    A2_MQK(Q4, 4);
        A2_WQK(4, Q5);                       A2_MQK(Q5, 5);
        A2_WQK(2, Q6);                       A2_MQK(Q6, 6);
        A2_WQK(0, Q7);                       A2_MQK(Q7, 7);
    } else if constexpr (DO_PV) {
        A2_RPV(T0, VB, 0, 0); A2_RPV(T1, VB, 0, 1); A2_RPV(T2, VB, 0, 2);
        A2_WPV(8, T0); A2_RPV(T3, VB, 0, 3); A2_MPV(T0, 0, 0);
        A2_WPV(8, T1); A2_RPV(T4, VB, 1, 0); A2_MPV(T1, 0, 1);
        A2_WPV(8, T2); A2_RPV(T5, VB, 1, 1); A2_MPV(T2, 0, 2);
        A2_WPV(8, T3); A2_RPV(T6, VB, 1, 2); A2_MPV(T3, 0, 3);
        A2_WPV(8, T4); A2_RPV(T7, VB, 1, 3); A2_MPV(T4, 1, 0);
        A2_WPV(8, T5);                       A2_MPV(T5, 1, 1);
        A2_WPV(4, T6);                       A2_MPV(T6, 1, 2);
        A2_WPV(0, T7);                       A2_MPV(T7, 1, 3);
    } else {
        A2_RQK(Q0, KB, 0); A2_RQK(Q1, KB, 1); A2_RQK(Q2, KB, 2);
        p0 = negm; p1 = negm;
        A2_WQK(4, Q0); A2_RQK(Q3, KB, 3);    A2_MQK(Q0, 0);
        A2_WQK(4, Q1); A2_RQK(Q4, KB, 4);    A2_MQK(Q1, 1);
        A2_WQK(4, Q2); A2_RQK(Q5, KB, 5);    A2_MQK(Q2, 2);
        A2_WQK(4, Q3); A2_RQK(Q6, KB, 6);    A2_MQK(Q3, 3);
        A2_WQK(4, Q4); A2_RQK(Q7, KB, 7);    A2_MQK(Q4, 4);
        A2_WQK(4, Q5);                       A2_MQK(Q5, 5);
        A2_WQK(2, Q6);                       A2_MQK(Q6, 6);
        A2_WQK(0, Q7);                       A2_MQK(Q7, 7);
    }
}
template <int ABL>
__device__ __forceinline__ void moba_block2(const BlockRef& cur, const BlockRef& nxt, char* lds, Seam& S) {
    int tid = threadIdx.x; asm volatile("" : "+v"(tid));
    const int wid = __builtin_amdgcn_readfirstlane(tid >> 6), lane = tid & 63, r32 = lane & 31, hi = lane >> 5;
#ifndef MK_ATT2_ROLE
#define MK_ATT2_ROLE 0
#endif
    const bool roleB = MK_ATT2_ROLE == 0 ? wid >= 4 : (MK_ATT2_ROLE == 2 ? (wid & 1) != 0 : false);
    const int cblk = cur.P0 >> 8;
    const int NT = 4 * (cblk + 1);
    const int qlo = cur.P0 + wid * QBLK, qm = qlo + r32 - 4 * hi;
    char* V_lds = lds; char* K_lds = lds + 2 * SHM_V;
    float* ws = (float*)(lds + OFF_WS) + wid * 64; float* li_l = ws; float* biasL = (float*)(lds + OFF_BIAS);
    f32x16 o[4], ol, negm;
    const bf16x8 ones = {0x3F80, 0x3F80, 0x3F80, 0x3F80, 0x3F80, 0x3F80, 0x3F80, 0x3F80};
    const int sr = tid >> 4, sc = (tid & 15) * 8, vst0 = v_st(sr, sc), vst1 = v_st(32 + sr, sc), kws = KSWZ(sr, sc * 2);
    const int vb0 = (int)(uintptr_t)V_lds + v_rd_base(lane);
    int kbv[8];
#pragma unroll
    for (int dd = 0; dd < 8; ++dd) kbv[dd] = (int)(uintptr_t)K_lds + KSWZ(r32, ((dd & 3) * 16 + hi * 8) * 2) + (dd >> 2) * 128;
    const bf16* Kh = cur.K; const bf16* Vh = cur.V;
    f32x16 p0, p1; bf16x8 pa[4]; float l_reg = 0.f;
    if constexpr (ABL != 0) { pa[0] = bf16x8{}; pa[1] = bf16x8{}; pa[2] = bf16x8{}; pa[3] = bf16x8{}; }
    if (tid < 128) { const int d = tid < 113 ? tid : 113; int bk = d;
        if (d >= 16) { bk = 15; bk += d >= 16; bk += d >= 19; bk += d >= 21; bk += d >= 24; bk += d >= 27; bk += d >= 31; bk += d >= 35; bk += d >= 40;
            bk += d >= 46; bk += d >= 52; bk += d >= 59; bk += d >= 67; bk += d >= 77; bk += d >= 87; bk += d >= 99; bk += d >= 113; }
        biasL[tid] = (cur.BT[bk * 8] - cur.BT[31 * 8]) * 1.4426950408889634f; }
    if (tid < 256) { const bf16x8 kmv = load8(cur.KM + (size_t)(tid >> 4) * 128 + (tid & 15) * 8); *(bf16x8*)(K_lds + SHM_K + KSWZ(tid >> 4, (tid & 15) * 16)) = kmv; }
    __syncthreads();
    unsigned selmask = 0u;
    { qkt<1>(p0, p1, K_lds, r32, hi, S.qr);
      float G[16];
#pragma unroll
      for (int r = 0; r < 8; ++r) { auto rr = __builtin_amdgcn_permlane32_swap(__float_as_uint(p0[r]), __float_as_uint(p0[r]), false, false);
          const int n0 = (r & 3) + 8 * (r >> 2); G[n0] = __uint_as_float(rr[0]); G[n0 + 4] = __uint_as_float(rr[1]); }
#pragma unroll
      for (int s = 0; s < 3; ++s) { float bv = 0.f; int bi = -1;
#pragma unroll
          for (int n = 0; n < 16; ++n) { const bool ok = (n < cblk) && !((selmask >> n) & 1u); const bool take = ok && (bi < 0 || G[n] > bv); bv = take ? G[n] : bv; bi = take ? n : bi; }
          selmask |= (bi >= 0) ? (1u << bi) : 0u; }
    }
    __syncthreads();
    o[0] = f32x16{}; o[1] = f32x16{}; o[2] = f32x16{}; o[3] = f32x16{}; ol = f32x16{};
#define KBASE(t) ((t) * KVBLK)
    float negMC;
    { float mq = fmaxf(fabsf(cur.QG[lane]), fabsf(cur.QG[lane + 64])), mk = fmaxf(fabsf(cur.KG[lane]), fabsf(cur.KG[lane + 64])), mb = fmaxf(biasL[lane], biasL[lane + 64]);
#pragma unroll
      for (int s = 1; s < 64; s <<= 1) { mq = fmaxf(mq, __shfl_xor(mq, s)); mk = fmaxf(mk, __shfl_xor(mk, s)); mb = fmaxf(mb, __shfl_xor(mb, s)); }
      negMC = -(1.02f * 128.f * mq * mk * (1.4426950408889634f * SCALE) + fmaxf(mb, 0.f)); }
#define MASKT(t) do { const int kb_ = KBASE(t), nb_ = (t) >> 2; \
        if (qlo - (kb_ + KVBLK - 1) < 113) mask_bias(p0, p1, qm - kb_, biasL, nb_ == cblk); } while (0)
#define KEEP(t) ((((t) >> 2) >= cblk) || ((selmask >> ((t) >> 2)) & 1u))
#define SMT(t) do { if constexpr (!(ABL & 2)) { MASKT(t); sm_tile(p0, p1, pa, l_reg); } SBAR(); } while (0)
#define NEGM(t) do { const float nm_ = KEEP(t) ? negMC : -__builtin_inff(); _Pragma("unroll") for (int r_ = 0; r_ < 16; ++r_) negm[r_] = nm_; } while (0)
    constexpr int NQL = 8;
    SWRITE_HV(0); SBAR();
    SLOAD_H(Kh, Vh, KBASE(1)); SBAR();
    NEGM(0);
    mstretch<0, 0, false, true, ABL>(o, ol, p0, p1, pa, S, vb0, kbv, negm, ones);
    if (!roleB) SMT(0);
    VMW(); SWRITE_H(1);
    __syncthreads();
#define IV(VB, KB, t) do {                                                                                     \
        if constexpr (!(ABL & 32)) { SLOAD_H(Kh, Vh, KBASE((t) + 1)); SBAR(); }                                \
        if (roleB) SMT((t) - 1);                                                                               \
        if constexpr (!(ABL & 8)) mstretch<VB, KB, true, true, ABL>(o, ol, p0, p1, pa, S, vb0, kbv, negm, ones);               \
        if (!roleB) SMT(t);                                                                                    \
        if constexpr (!(ABL & 16)) __syncthreads();                                                            \
        if constexpr (!(ABL & 4)) { VMW(); SWRITE_H(VB); __syncthreads(); } } while (0)
    for (int t = 1; t + 1 < NT; t += 2) { IV(0, 1, t); if (((t + 1) & 3) == 0) NEGM(t + 1); IV(1, 0, t + 1); }
#undef IV
    if (roleB) SMT(NT - 2);
    mstretch<0, 1, true, true, ABL>(o, ol, p0, p1, pa, S, vb0, kbv, negm, ones);
    SLOAD_H(nxt.K, nxt.V, 0); SBAR();
#pragma unroll
    for (int d0 = 0; d0 < 8; ++d0) S.qr[d0] = load8(nxt.Q + (size_t)(wid * QBLK + r32) * QP + d0 * 16 + hi * 8);
    SBAR();
    SMT(NT - 1);
    mstretch<1, 0, true, false, ABL>(o, ol, p0, p1, pa, S, vb0, kbv, negm, ones);
    SBAR(); VMWN(NQL); SWRITE_HK(0); SBAR();
    float rli[16];
    if constexpr (MK_ATT_OL) {
#pragma unroll
        for (int r = 0; r < 16; ++r) rli[r] = __builtin_amdgcn_rcpf(ol[r]);
    } else {
        { auto rr = __builtin_amdgcn_permlane32_swap(__float_as_uint(l_reg), __float_as_uint(l_reg), false, false); l_reg = __uint_as_float(rr[0]) + __uint_as_float(rr[1]); }
        float* li_l = (float*)(lds + OFF_WS) + wid * 64;
        if (hi == 0) li_l[r32] = l_reg; asm volatile("s_waitcnt lgkmcnt(0)" ::: "memory");
#pragma unroll
        for (int r = 0; r < 16; ++r) rli[r] = __builtin_amdgcn_rcpf(li_l[crow(r, hi)]);
    }
    bf16* Ow = cur.O + (size_t)(wid * QBLK) * QP;
#pragma unroll
    for (int r = 0; r < 16; ++r) { const int orow = crow(r, hi);
#pragma unroll
        for (int d0 = 0; d0 < 4; ++d0) { const float v = o[d0][r] * rli[r];
            const float vn = dpp_mov<0xB1>(v);
            if ((r32 & 1) == 0) *(unsigned*)(Ow + (size_t)orow * QP + d0 * 32 + r32) = cvtpk2(v, vn); } }
    __syncthreads();
#undef KBASE
#undef MASKT
#undef KEEP
#undef SMT
#undef NEGM
}

constexpr int V3_V = 0, V3_K = 3 * SHM_V, V3_KM = V3_K + 2 * SHM_K, V3_BIAS = V3_KM + 4096, V3_LI = V3_BIAS + 512, V3_BYTES = V3_LI + 2048;
#define A3_GLDS(g, l) __builtin_amdgcn_global_load_lds((const unsigned*)(g), (PG8_LAS unsigned*)(l), 16, 0, 0)
#define A3_DMA(Kp, Vp, k0, kslot, vslot) do { const bf16* kp_ = (Kp) + (size_t)(k0) * KP; const bf16* vp_ = (Vp) + (size_t)(k0) * KP;                         \
        PG8_LAS unsigned char* kd_ = ldsL + V3_K + (kslot) * SHM_K + wid * 2048; PG8_LAS unsigned char* vd_ = ldsL + V3_V + (vslot) * SHM_V + wid * 2048;       \
        A3_GLDS(kp_ + koff0, kd_); A3_GLDS(kp_ + koff1, kd_ + 1024); A3_GLDS(vp_ + voff0, vd_); A3_GLDS(vp_ + voff1, vd_ + 1024); } while (0)
#define A3_OFFS()                                                                                                                                             \
    const int krow0_ = 8 * wid + (lane >> 4), krow1_ = krow0_ + 4;                                                                                             \
    const int koff0 = krow0_ * KP + (((lane & 15) ^ (krow0_ & 15)) << 3), koff1 = krow1_ * KP + (((lane & 15) ^ (krow1_ & 15)) << 3);                         \
    const int vkk_ = wid * 8 + ((lane & 31) >> 2), vk_ = (vkk_ & ~0xC) | ((vkk_ & 4) << 1) | ((vkk_ & 8) >> 1);                                                \
    const int voff0 = vk_ * KP + (lane >> 5) * 32 + (lane & 3) * 8, voff1 = voff0 + 64;
__device__ __forceinline__ void moba_prime3(const BlockRef& cur, PG8_LAS unsigned char* ldsL, Seam& S) {
    int tid = threadIdx.x; asm volatile("" : "+v"(tid));
    const int wid = __builtin_amdgcn_readfirstlane(tid >> 6), lane = tid & 63, r32 = lane & 31, hi = lane >> 5;
    A3_OFFS();
    const int vs = __builtin_amdgcn_readfirstlane(S.vs);
    A3_DMA(cur.K, cur.V, 0, 0, vs);
    for (int d0 = 0; d0 < 8; ++d0) S.qr[d0] = load8(cur.Q + (size_t)(wid * QBLK + r32) * QP + d0 * 16 + hi * 8);
    VMW();
    __syncthreads();
}
template <int ABL>
__device__ __forceinline__ void moba_block3(const BlockRef& cur, const BlockRef& nxt, PG8_LAS unsigned char* ldsL, Seam& S) {
    int tid = threadIdx.x; asm volatile("" : "+v"(tid));
    const int wid = __builtin_amdgcn_readfirstlane(tid >> 6), lane = tid & 63, r32 = lane & 31, hi = lane >> 5;
    char* lds = (char*)ldsL;
    const bool roleB = MK_ATT2_ROLE == 0 ? wid >= 4 : (MK_ATT2_ROLE == 2 ? (wid & 1) != 0 : false);
    const int cblk = cur.P0 >> 8;
    const int NT = 4 * (cblk + 1);
    const int qlo = cur.P0 + wid * QBLK, qm = qlo + r32 - 4 * hi;
    char* V_lds = lds + V3_V; char* K_lds = lds + V3_K;
    float* biasL = (float*)(lds + V3_BIAS);
    f32x16 o[4], ol, negm;
    const bf16x8 ones = {0x3F80, 0x3F80, 0x3F80, 0x3F80, 0x3F80, 0x3F80, 0x3F80, 0x3F80};
    A3_OFFS();
    const int vbase = (int)(uintptr_t)V_lds + v_rd_base(lane);
    int kbv[8];
#pragma unroll
    for (int dd = 0; dd < 8; ++dd) kbv[dd] = (int)(uintptr_t)K_lds + KSW16(r32, (dd * 16 + hi * 8) * 2);
    const bf16* Kh = cur.K; const bf16* Vh = cur.V;
    f32x16 p0, p1; bf16x8 pa[4]; float l_reg = 0.f;
    if constexpr (ABL != 0) { pa[0] = bf16x8{}; pa[1] = bf16x8{}; pa[2] = bf16x8{}; pa[3] = bf16x8{}; }
    int sv = __builtin_amdgcn_readfirstlane(S.vs);
#define SV_NEXT(s) ((s) == 2 ? 0 : (s) + 1)
    A3_DMA(Kh, Vh, KVBLK, 1, SV_NEXT(sv));
    if (tid < 128) { const int d = tid < 113 ? tid : 113; int bk = d;
        if (d >= 16) { bk = 15; bk += d >= 16; bk += d >= 19; bk += d >= 21; bk += d >= 24; bk += d >= 27; bk += d >= 31; bk += d >= 35; bk += d >= 40;
            bk += d >= 46; bk += d >= 52; bk += d >= 59; bk += d >= 67; bk += d >= 77; bk += d >= 87; bk += d >= 99; bk += d >= 113; }
        biasL[tid] = (cur.BT[bk * 8] - cur.BT[31 * 8]) * 1.4426950408889634f; }
    if (tid < 256) { const bf16x8 kmv = load8(cur.KM + (size_t)(tid >> 4) * 128 + (tid & 15) * 8); *(bf16x8*)(lds + V3_KM + KSW16(tid >> 4, (tid & 15) * 16)) = kmv; }
    __syncthreads();
    unsigned selmask = 0u;
    { p0 = f32x16{};
#pragma unroll
      for (int d0 = 0; d0 < 8; ++d0) { const bf16x8 kb_ = *reinterpret_cast<const bf16x8*>(lds + V3_KM + KSW16(r32, (d0 * 16 + hi * 8) * 2));
          p0 = __builtin_amdgcn_mfma_f32_32x32x16_bf16(kb_, S.qr[d0], p0, 0, 0, 0); }
      float G[16];
#pragma unroll
      for (int r = 0; r < 8; ++r) { auto rr = __builtin_amdgcn_permlane32_swap(__float_as_uint(p0[r]), __float_as_uint(p0[r]), false, false);
          const int n0 = (r & 3) + 8 * (r >> 2); G[n0] = __uint_as_float(rr[0]); G[n0 + 4] = __uint_as_float(rr[1]); }
#pragma unroll
      for (int s = 0; s < 3; ++s) { float bv = 0.f; int bi = -1;
#pragma unroll
          for (int n = 0; n < 16; ++n) { const bool ok = (n < cblk) && !((selmask >> n) & 1u); const bool take = ok && (bi < 0 || G[n] > bv); bv = take ? G[n] : bv; bi = take ? n : bi; }
          selmask |= (bi >= 0) ? (1u << bi) : 0u; }
    }
    o[0] = f32x16{}; o[1] = f32x16{}; o[2] = f32x16{}; o[3] = f32x16{}; ol = f32x16{};
#define KBASE(t) ((t) * KVBLK)
    float negMC;
    { float mq = fmaxf(fabsf(cur.QG[lane]), fabsf(cur.QG[lane + 64])), mk = fmaxf(fabsf(cur.KG[lane]), fabsf(cur.KG[lane + 64])), mb = fmaxf(biasL[lane], biasL[lane + 64]);
#pragma unroll
      for (int s = 1; s < 64; s <<= 1) { mq = fmaxf(mq, __shfl_xor(mq, s)); mk = fmaxf(mk, __shfl_xor(mk, s)); mb = fmaxf(mb, __shfl_xor(mb, s)); }
      negMC = -(1.02f * 128.f * mq * mk * (1.4426950408889634f * SCALE) + fmaxf(mb, 0.f)); }
#define MASKT(t) do { const int kb_ = KBASE(t), nb_ = (t) >> 2; \
        if (qlo - (kb_ + KVBLK - 1) < 113) mask_bias(p0, p1, qm - kb_, biasL, nb_ == cblk); } while (0)
#define KEEP(t) ((((t) >> 2) >= cblk) || ((selmask >> ((t) >> 2)) & 1u))
#define SMT(t) do { if constexpr (!(ABL & 2)) { MASKT(t); sm_tile(p0, p1, pa, l_reg); } SBAR(); } while (0)
#define NEGM(t) do { const float nm_ = KEEP(t) ? negMC : -__builtin_inff(); _Pragma("unroll") for (int r_ = 0; r_ < 16; ++r_) negm[r_] = nm_; } while (0)
    NEGM(0);
    mstretch<0, 0, false, true, ABL>(o, ol, p0, p1, pa, S, vbase, kbv, negm, ones);
    if (!roleB) SMT(0);
    VMW(); __syncthreads();
#define IV(KB, t, Kn, Vn, kn) do {                                                                             \
        if constexpr (!(ABL & 32)) A3_DMA(Kn, Vn, kn, 1 - (KB), SV_NEXT(SV_NEXT(sv)));                         \
        if (roleB) SMT((t) - 1);                                                                               \
        if constexpr (!(ABL & 8)) mstretch<0, KB, true, true, ABL>(o, ol, p0, p1, pa, S, vbase + sv * SHM_V, kbv, negm, ones);   \
        if (!roleB) SMT(t);                                                                                    \
        VMW(); if constexpr (!(ABL & 16)) __syncthreads(); sv = SV_NEXT(sv); } while (0)
    for (int t = 1; t + 1 < NT; t += 2) { IV(1, t, Kh, Vh, KBASE(t + 1)); if (((t + 1) & 3) == 0) NEGM(t + 1); IV(0, t + 1, Kh, Vh, KBASE(t + 2)); }
    if constexpr (!(ABL & 32)) A3_DMA(nxt.K, nxt.V, 0, 0, SV_NEXT(SV_NEXT(sv)));
    if (roleB) SMT(NT - 2);
    mstretch<0, 1, true, true, ABL>(o, ol, p0, p1, pa, S, vbase + sv * SHM_V, kbv, negm, ones);
#pragma unroll
    for (int d0 = 0; d0 < 8; ++d0) S.qr[d0] = load8(nxt.Q + (size_t)(wid * QBLK + r32) * QP + d0 * 16 + hi * 8);
    SBAR();
    SMT(NT - 1);
    sv = SV_NEXT(sv);
    mstretch<0, 0, true, false, ABL>(o, ol, p0, p1, pa, S, vbase + sv * SHM_V, kbv, negm, ones);
    S.vs = SV_NEXT(sv);
#undef IV
    VMW();
    float rli[16];
    if constexpr (MK_ATT_OL) {
#pragma unroll
        for (int r = 0; r < 16; ++r) rli[r] = __builtin_amdgcn_rcpf(ol[r]);
    } else {
        { auto rr = __builtin_amdgcn_permlane32_swap(__float_as_uint(l_reg), __float_as_uint(l_reg), false, false); l_reg = __uint_as_float(rr[0]) + __uint_as_float(rr[1]); }
        float* li_l = (float*)(lds + V3_LI) + wid * 64;
        if (hi == 0) li_l[r32] = l_reg; asm volatile("s_waitcnt lgkmcnt(0)" ::: "memory");
#pragma unroll
        for (int r = 0; r < 16; ++r) rli[r] = __builtin_amdgcn_rcpf(li_l[crow(r, hi)]);
    }
    bf16* Ow = cur.O + (size_t)(wid * QBLK) * QP;
#pragma unroll
    for (int r = 0; r < 16; ++r) { const int orow = crow(r, hi);
#pragma unroll
        for (int d0 = 0; d0 < 4; ++d0) { const float v = o[d0][r] * rli[r];
            const float vn = dpp_mov<0xB1>(v);
            if ((r32 & 1) == 0) *(unsigned*)(Ow + (size_t)orow * QP + d0 * 32 + r32) = cvtpk2(v, vn); } }
    __syncthreads();
#undef KBASE
#undef MASKT
#undef KEEP
#undef SMT
#undef NEGM
#undef SV_NEXT
}

constexpr int V4_V = 0, V4_K = 2 * SHM_V, V4_KM = V4_K + 2 * SHM_K, V4_BIAS = V4_KM + 4096, V4_LI = V4_BIAS + 512, V4_BYTES = V4_LI + 2048;
#define A4_DMA(Kp, Vp, k0, slot) do { const bf16* kp_ = (Kp) + (size_t)(k0) * KP; const bf16* vp_ = (Vp) + (size_t)(k0) * KP;                                 \
        PG8_LAS unsigned char* kd_ = ldsL + V4_K + (slot) * SHM_K + wid * 2048; PG8_LAS unsigned char* vd_ = ldsL + V4_V + (slot) * SHM_V + wid * 2048;         \
        A3_GLDS(kp_ + koff0, kd_); A3_GLDS(kp_ + koff1, kd_ + 1024); A3_GLDS(vp_ + voff0, vd_); A3_GLDS(vp_ + voff1, vd_ + 1024); } while (0)
#define A4_OFFS()                                                                                                                                             \
    const int krow0_ = 8 * wid + (lane >> 4), krow1_ = krow0_ + 4;                                                                                             \
    const int koff0 = krow0_ * KP + (((lane & 15) ^ (krow0_ & 15)) << 3), koff1 = krow1_ * KP + (((lane & 15) ^ (krow1_ & 15)) << 3);                         \
    const int vkk_ = wid * 8 + ((lane & 31) >> 2), vk_ = (vkk_ & ~0xC) | ((vkk_ & 4) << 1) | ((vkk_ & 8) >> 1);                                                \
    const int voff0 = vk_ * KP + (lane >> 5) * 32 + (lane & 3) * 8, voff1 = voff0 + 64;
__device__ __forceinline__ void moba_prime4(const BlockRef& cur, PG8_LAS unsigned char* ldsL, Seam& S) {
    int tid = threadIdx.x; asm volatile("" : "+v"(tid));
    const int wid = __builtin_amdgcn_readfirstlane(tid >> 6), lane = tid & 63, r32 = lane & 31, hi = lane >> 5;
    A4_OFFS();
    A4_DMA(cur.K, cur.V, 0, 0);
    for (int d0 = 0; d0 < 8; ++d0) S.qr[d0] = load8(cur.Q + (size_t)(wid * QBLK + r32) * QP + d0 * 16 + hi * 8);
    VMW();
    __syncthreads();
}
#define A4_RQ(Kf, SL, h, d0) do { constexpr int o_ = (SL) * SHM_K + (h) * 8192; A2_KR(Kf[0], kbv[d0], o_); A2_KR(Kf[1], kbv[(d0) + 1], o_); } while (0)
#define A4_MQ(Kf, P, d0) do { if constexpr (!(ABL & 1)) { P = __builtin_amdgcn_mfma_f32_32x32x16_bf16(Kf[0], S.qr[d0], P, 0, 0, 0);                            \
                                                         P = __builtin_amdgcn_mfma_f32_32x32x16_bf16(Kf[1], S.qr[(d0) + 1], P, 0, 0, 0); } } while (0)
#define A4_MPV(T, k, ks) do { if constexpr (!(ABL & 1)) { o[2 * (k)] = __builtin_amdgcn_mfma_f32_32x32x16_bf16(pa[ks], A2_CAT(T[0], T[1]), o[2 * (k)], 0, 0, 0);            \
                              o[2 * (k) + 1] = __builtin_amdgcn_mfma_f32_32x32x16_bf16(pa[ks], A2_CAT(T[2], T[3]), o[2 * (k) + 1], 0, 0, 0);            \
                              if constexpr ((k) == 0 && MK_ATT_OL) ol = __builtin_amdgcn_mfma_f32_32x32x16_bf16(pa[ks], ones, ol, 0, 0, 0); } } while (0)
#define A4_EXP8(P, b) do { if constexpr (!(ABL & 2) && !(ABL & 64)) { _Pragma("unroll") for (int r_ = (b); r_ < (b) + 8; ++r_) P[r_] = __builtin_amdgcn_exp2f(P[r_]);   \
        if constexpr (!MK_ATT_OL) { _Pragma("unroll") for (int r_ = (b); r_ < (b) + 8; ++r_) l_reg += P[r_]; } } } while (0)
#define A4_PK(P, B_, OUT) do { if constexpr ((ABL & 256) != 0) { asm volatile("" :: "v"(P)); } if constexpr (!(ABL & 2) && !(ABL & 128) && !(ABL & 256)) { unsigned a0 = cvtpk2(P[B_+0], P[B_+1]), a1 = cvtpk2(P[B_+2], P[B_+3]);                          \
        unsigned b0 = cvtpk2(P[B_+4], P[B_+5]), b1 = cvtpk2(P[B_+6], P[B_+7]);                                             \
        auto r0 = __builtin_amdgcn_permlane32_swap(a0, b0, false, false); auto r1 = __builtin_amdgcn_permlane32_swap(a1, b1, false, false); \
        u32x4 w = {r0[0], r1[0], r0[1], r1[1]}; OUT = *reinterpret_cast<bf16x8*>(&w); } } while (0)
__device__ __forceinline__ void mask_half(f32x16& P, int dqh, const float* biasL, bool causal) {
    const float NEG = -__builtin_inff();
#pragma unroll
    for (int g = 0; g < 4; ++g) {
#pragma unroll
        for (int j = 0; j < 4; ++j) { const int r = 4 * g + j;
            const int c = (r & 3) + 8 * (r >> 2); const int d0 = dqh - c;
            const int i0 = d0 < 0 ? 0 : (d0 > 113 ? 113 : d0);
            const float v0 = P[r] + biasL[i0];
            P[r] = (causal && d0 < 0) ? NEG : v0; }
    }
}
template <int SL, int ABL>
__device__ __forceinline__ void tile_fast(f32x16* o, f32x16& ol, f32x16& p0, f32x16& p1, bf16x8* pa, const Seam& S, int vb0, const int* kbv, const f32x16& negm, const bf16x8 ones,
                                          bool near, int dq, const float* biasL, bool causal, float& l_reg) {
    s16x4 T0[4], T1[4], T2[4], T3[4], T4[4], T5[4], T6[4], T7[4]; bf16x8 Q0[2], Q1[2], Q2[2], Q3[2], Q4[2], Q5[2], Q6[2], Q7[2];
    A4_RQ(Q0, SL, 0, 0); A4_RQ(Q1, SL, 0, 2); A4_RQ(Q2, SL, 0, 4);
    p0 = negm;
    A2_WQK(4, Q0); A4_RQ(Q3, SL, 0, 6);  A4_MQ(Q0, p0, 0); SBAR();
    A2_WQK(4, Q1); A4_RQ(Q4, SL, 1, 0);  A4_MQ(Q1, p0, 2); SBAR();
    A2_WQK(4, Q2); A4_RQ(Q5, SL, 1, 2);  A4_MQ(Q2, p0, 4); SBAR();
    A2_WQK(4, Q3); A4_RQ(Q6, SL, 1, 4);  A4_MQ(Q3, p0, 6); SBAR();
    p1 = negm;
    A2_WQK(4, Q4); A4_RQ(Q7, SL, 1, 6);      A4_MQ(Q4, p1, 0); if (near) { if constexpr (!(ABL & 2)) mask_half(p0, dq, biasL, causal); } A4_EXP8(p0, 0); SBAR();
    A2_WQK(4, Q5); A2_RPV(T0, SL, 0, 0);     A4_MQ(Q5, p1, 2); A4_EXP8(p0, 8); SBAR();
    A2_WQK(6, Q6); A2_RPV(T1, SL, 1, 0);     A4_MQ(Q6, p1, 4); A4_PK(p0, 0, pa[0]); SBAR();
    A2_WQK(8, Q7); A2_RPV(T2, SL, 0, 1);     A4_MQ(Q7, p1, 6); A4_PK(p0, 8, pa[1]); SBAR();
    A2_WPV(8, T0); A2_RPV(T3, SL, 1, 1);     A4_MPV(T0, 0, 0); if (near) { if constexpr (!(ABL & 2)) mask_half(p1, dq - 32, biasL, causal); } A4_EXP8(p1, 0); SBAR();
    A2_WPV(8, T1); A2_RPV(T4, SL, 0, 2);     A4_MPV(T1, 1, 0); A4_EXP8(p1, 8); SBAR();
    A2_WPV(8, T2); A2_RPV(T5, SL, 1, 2);     A4_MPV(T2, 0, 1); A4_PK(p1, 0, pa[2]); SBAR();
    A2_WPV(8, T3); A2_RPV(T6, SL, 0, 3);     A4_MPV(T3, 1, 1); A4_PK(p1, 8, pa[3]); SBAR();
    A2_WPV(8, T4); A2_RPV(T7, SL, 1, 3);     A4_MPV(T4, 0, 2); SBAR();
    A2_WPV(8, T5);                           A4_MPV(T5, 1, 2); SBAR();
    A2_WPV(4, T6);                           A4_MPV(T6, 0, 3); SBAR();
    A2_WPV(0, T7);                           A4_MPV(T7, 1, 3); SBAR();
}
template <int ABL>
__device__ __forceinline__ void moba_block4(const BlockRef& cur, const BlockRef& nxt, PG8_LAS unsigned char* ldsL, Seam& S) {
    int tid = threadIdx.x; asm volatile("" : "+v"(tid));
    const int wid = __builtin_amdgcn_readfirstlane(tid >> 6), lane = tid & 63, r32 = lane & 31, hi = lane >> 5;
    char* lds = (char*)ldsL;
    const int cblk = cur.P0 >> 8;
    const int NT = 4 * (cblk + 1);
    const int qlo = cur.P0 + wid * QBLK, qm = qlo + r32 - 4 * hi;
    float* biasL = (float*)(lds + V4_BIAS);
    f32x16 o[4], ol, negm;
    const bf16x8 ones = {0x3F80, 0x3F80, 0x3F80, 0x3F80, 0x3F80, 0x3F80, 0x3F80, 0x3F80};
    A4_OFFS();
    const int vb0 = (int)(uintptr_t)(lds + V4_V) + v_rd_base(lane);
    int kbv[8];
#pragma unroll
    for (int dd = 0; dd < 8; ++dd) kbv[dd] = (int)(uintptr_t)(lds + V4_K) + KSW16(r32, (dd * 16 + hi * 8) * 2);
    const bf16* Kh = cur.K; const bf16* Vh = cur.V;
    f32x16 p0, p1; bf16x8 pa[4];
    float l_reg = 0.f;
    if constexpr (ABL != 0) { pa[0] = bf16x8{}; pa[1] = bf16x8{}; pa[2] = bf16x8{}; pa[3] = bf16x8{}; p0 = f32x16{}; p1 = f32x16{}; }
    A4_DMA(Kh, Vh, KVBLK, 1);
    if (tid < 128) { const int d = tid < 113 ? tid : 113; int bk = d;
        if (d >= 16) { bk = 15; bk += d >= 16; bk += d >= 19; bk += d >= 21; bk += d >= 24; bk += d >= 27; bk += d >= 31; bk += d >= 35; bk += d >= 40;
            bk += d >= 46; bk += d >= 52; bk += d >= 59; bk += d >= 67; bk += d >= 77; bk += d >= 87; bk += d >= 99; bk += d >= 113; }
        biasL[tid] = (cur.BT[bk * 8] - cur.BT[31 * 8]) * 1.4426950408889634f; }
    if (tid < 256) { const bf16x8 kmv = load8(cur.KM + (size_t)(tid >> 4) * 128 + (tid & 15) * 8); *(bf16x8*)(lds + V4_KM + KSW16(tid >> 4, (tid & 15) * 16)) = kmv; }
    __syncthreads();
    unsigned selmask = 0u;
    { f32x16 g0 = f32x16{};
#pragma unroll
      for (int d0 = 0; d0 < 8; ++d0) { const bf16x8 kb_ = *reinterpret_cast<const bf16x8*>(lds + V4_KM + KSW16(r32, (d0 * 16 + hi * 8) * 2));
          g0 = __builtin_amdgcn_mfma_f32_32x32x16_bf16(kb_, S.qr[d0], g0, 0, 0, 0); }
      float G[16];
#pragma unroll
      for (int r = 0; r < 8; ++r) { auto rr = __builtin_amdgcn_permlane32_swap(__float_as_uint(g0[r]), __float_as_uint(g0[r]), false, false);
          const int n0 = (r & 3) + 8 * (r >> 2); G[n0] = __uint_as_float(rr[0]); G[n0 + 4] = __uint_as_float(rr[1]); }
#pragma unroll
      for (int s = 0; s < 3; ++s) { float bv = 0.f; int bi = -1;
#pragma unroll
          for (int n = 0; n < 16; ++n) { const bool ok = (n < cblk) && !((selmask >> n) & 1u); const bool take = ok && (bi < 0 || G[n] > bv); bv = take ? G[n] : bv; bi = take ? n : bi; }
          selmask |= (bi >= 0) ? (1u << bi) : 0u; }
    }
    o[0] = f32x16{}; o[1] = f32x16{}; o[2] = f32x16{}; o[3] = f32x16{}; ol = f32x16{};
#define KBASE(t) ((t) * KVBLK)
    float negMC;
    { float mq = fmaxf(fabsf(cur.QG[lane]), fabsf(cur.QG[lane + 64])), mk = fmaxf(fabsf(cur.KG[lane]), fabsf(cur.KG[lane + 64])), mb = fmaxf(biasL[lane], biasL[lane + 64]);
#pragma unroll
      for (int s = 1; s < 64; s <<= 1) { mq = fmaxf(mq, __shfl_xor(mq, s)); mk = fmaxf(mk, __shfl_xor(mk, s)); mb = fmaxf(mb, __shfl_xor(mb, s)); }
      negMC = -(1.02f * 128.f * mq * mk * (1.4426950408889634f * SCALE) + fmaxf(mb, 0.f)); }
#define KEEP(t) ((((t) >> 2) >= cblk) || ((selmask >> ((t) >> 2)) & 1u))
#define NEGM(t) do { const float nm_ = KEEP(t) ? negMC : -__builtin_inff(); _Pragma("unroll") for (int r_ = 0; r_ < 16; ++r_) negm[r_] = nm_; } while (0)
#define IV(SL, t, first) do {                                                                                  \
        if (!(first)) { if constexpr (!(ABL & 32)) { if ((t) + 1 < NT) A4_DMA(Kh, Vh, KBASE((t) + 1), 1 - (SL)); else A4_DMA(nxt.K, nxt.V, 0, 1 - (SL)); } }   \
        if (((t) & 3) == 0) NEGM(t);                                                                           \
        if constexpr (!(ABL & 8)) tile_fast<SL, ABL>(o, ol, p0, p1, pa, S, vb0, kbv, negm, ones, qlo - (KBASE(t) + KVBLK - 1) < 113, qm - KBASE(t), biasL, ((t) >> 2) == cblk, l_reg);   \
        if ((t) + 1 == NT) { _Pragma("unroll") for (int d0 = 0; d0 < 8; ++d0) S.qr[d0] = load8(nxt.Q + (size_t)(wid * QBLK + r32) * QP + d0 * 16 + hi * 8); }   \
        VMW(); if constexpr (!(ABL & 16)) __syncthreads(); } while (0)
    IV(0, 0, true); IV(1, 1, false);
    for (int t = 2; t < NT; t += 2) { IV(0, t, false); IV(1, t + 1, false); }
#undef IV
    float rli[16];
    if constexpr (MK_ATT_OL) {
#pragma unroll
        for (int r = 0; r < 16; ++r) rli[r] = __builtin_amdgcn_rcpf(ol[r]);
    } else {
        { auto rr = __builtin_amdgcn_permlane32_swap(__float_as_uint(l_reg), __float_as_uint(l_reg), false, false); l_reg = __uint_as_float(rr[0]) + __uint_as_float(rr[1]); }
        float* li_l = (float*)(lds + V4_LI) + wid * 64;
        if (hi == 0) li_l[r32] = l_reg; asm volatile("s_waitcnt lgkmcnt(0)" ::: "memory");
#pragma unroll
        for (int r = 0; r < 16; ++r) rli[r] = __builtin_amdgcn_rcpf(li_l[crow(r, hi)]);
    }
    bf16* Ow = cur.O + (size_t)(wid * QBLK) * QP;
#pragma unroll
    for (int r = 0; r < 16; ++r) { const int orow = crow(r, hi);
#pragma unroll
        for (int d0 = 0; d0 < 4; ++d0) { const float v = o[d0][r] * rli[r];
            const float vn = dpp_mov<0xB1>(v);
            if ((r32 & 1) == 0) *(unsigned*)(Ow + (size_t)orow * QP + d0 * 32 + r32) = cvtpk2(v, vn); } }
    __syncthreads();
#undef KBASE
#undef KEEP
#undef NEGM
}
#undef ROWK
#undef VMW
#undef VMWN
#undef SLOAD_H
#undef SWRITE_HK
#undef SWRITE_HV
#undef SWRITE_H
#undef KSWZ
#undef SBAR
}


namespace hgrn {
typedef short s16x4 __attribute__((ext_vector_type(4)));
typedef short bf16x8 __attribute__((ext_vector_type(8)));
typedef float f32x4 __attribute__((ext_vector_type(4)));
typedef unsigned u32x2 __attribute__((ext_vector_type(2)));
typedef unsigned u32x4 __attribute__((ext_vector_type(4)));
constexpr int QROW = 272, TROW = 40;
constexpr int OFF_QH = 0, OFF_KH = 16 * QROW, OFF_KDT = 2 * 16 * QROW, OFF_VT = OFF_KDT + 128 * TROW, OFF_DV = OFF_VT + 128 * TROW, SET_BYTES = OFF_DV + 512;
constexpr int OFF_PART = 2 * SET_BYTES, OFF_RAW = 40960, RAW_T = 16 * QROW  , RAW_SLOT = 5 * RAW_T, OFF_OBUF = OFF_RAW + 3 * RAW_SLOT, LDS_BYTES = OFF_OBUF + 64 * QROW;
static_assert(SET_BYTES % 16 == 0 && OFF_KDT % 16 == 0 && OFF_VT % 8 == 0 && OFF_DV % 16 == 0 && OFF_PART + 1024 <= OFF_RAW && LDS_BYTES <= 131072, "hgrn LDS map");
typedef float f32x2_t __attribute__((ext_vector_type(2))); typedef __bf16 bf16x2_t __attribute__((ext_vector_type(2)));
__device__ __forceinline__ unsigned cvtpk(float lo, float hi) { f32x2_t v = {lo, hi}; bf16x2_t b = __builtin_convertvector(v, bf16x2_t); return __builtin_bit_cast(unsigned, b); }
__device__ __forceinline__ float bf2f(unsigned short b) { return __uint_as_float((unsigned)b << 16); }
__device__ __forceinline__ s16x4 pack4(f32x4 v) { u32x2 w; w.x = cvtpk(v[0], v[1]); w.y = cvtpk(v[2], v[3]); return __builtin_bit_cast(s16x4, w); }

template <int CTRL> __device__ __forceinline__ float dpp_mov(float v) { return __int_as_float(__builtin_amdgcn_update_dpp(0, __float_as_int(v), CTRL, 0xf, 0xf, true)); }
__device__ __forceinline__ float row16_sum(float s) { s += dpp_mov<0xB1>(s); s += dpp_mov<0x4E>(s); s += dpp_mov<0x141>(s); s += dpp_mov<0x140>(s); return s; }
__device__ __forceinline__ void quarter_scan(float T, int qt, float& pre, float& post, float& tot) {
    auto r16 = __builtin_amdgcn_permlane16_swap(__float_as_uint(T), __float_as_uint(T), false, false);
    const float a = __uint_as_float(r16[0]), b = __uint_as_float(r16[1]);
    const float pr = a + b;
    auto r32 = __builtin_amdgcn_permlane32_swap(__float_as_uint(pr), __float_as_uint(pr), false, false);
    const float c = __uint_as_float(r32[0]), d = __uint_as_float(r32[1]);
    pre = qt == 0 ? 0.f : qt == 1 ? a : qt == 2 ? c : c + a;
    post = qt == 0 ? b + d : qt == 1 ? d : qt == 2 ? b : 0.f;
    tot = c + d;
}
struct Ptrs { const unsigned short* QQ; const unsigned short* HK; const unsigned short* HV; const unsigned short* HLF; const unsigned short* HSG; };
struct RawRegs { u32x4 a, b, c; };

template <bool OUT> __device__ __forceinline__ void g_load(RawRegs& R, const Ptrs& P, size_t row0, int hcol, int w, int lane) {
    const bool lo = w < 4; const size_t r = row0 + 4 * (w & 3) + (lane >> 4); const int c = hcol + 8 * (lane & 15);
    R.a = *(const u32x4*)((lo ? P.HLF : P.HK) + r * 1024 + c);
    if constexpr (OUT) { R.b = *(const u32x4*)((lo ? P.HV + r * 1024 : P.QQ + r * 2048) + c); if (lo) R.c = *(const u32x4*)(P.HSG + r * 1024 + c); }
    else { if (lo) R.b = *(const u32x4*)(P.HV + r * 1024 + c); }
}
template <bool OUT> __device__ __forceinline__ void raw_write(const RawRegs& R, char* slot, int w, int lane) {
    const bool lo = w < 4; const int d = (4 * (w & 3) + (lane >> 4)) * QROW + 16 * (lane & 15);
    *(u32x4*)(slot + (lo ? 0 : RAW_T) + d) = R.a;
    if constexpr (OUT) { *(u32x4*)(slot + (lo ? 2 * RAW_T : 3 * RAW_T) + d) = R.b; if (lo) *(u32x4*)(slot + 4 * RAW_T + d) = R.c; }
    else { if (lo) *(u32x4*)(slot + 2 * RAW_T + d) = R.b; }
}
template <bool OUT>
__device__ __forceinline__ float stage(const char* raw, char* set, int ch, int qt, float run, float (&sg)[4]) {
    float lf[4], kk[4], vv4[4], qq[4];
#pragma unroll
    for (int j = 0; j < 4; ++j) { const int o = (4 * qt + j) * QROW + ch * 2;
        lf[j] = (float)__builtin_bit_cast(_Float16, *(const unsigned short*)(raw + o));
        kk[j] = bf2f(*(const unsigned short*)(raw + RAW_T + o)); vv4[j] = bf2f(*(const unsigned short*)(raw + 2 * RAW_T + o));
        if constexpr (OUT) { qq[j] = bf2f(*(const unsigned short*)(raw + 3 * RAW_T + o)); sg[j] = bf2f(*(const unsigned short*)(raw + 4 * RAW_T + o)); } }
    float pre, post, tot;
    f32x4 kd, vv;
    if constexpr (OUT) {
        float c[4]; c[0] = lf[0]; c[1] = c[0] + lf[1]; c[2] = c[1] + lf[2]; c[3] = c[2] + lf[3];
        quarter_scan(c[3], qt, pre, post, tot);
#pragma unroll
        for (int j = 0; j < 4; ++j) { const float b = pre + c[j]; const int t = 4 * qt + j;
            kd[j] = kk[j] * __builtin_amdgcn_exp2f(tot - b); vv[j] = vv4[j];
            *(unsigned short*)(set + OFF_QH + t * QROW + ch * 2) = (unsigned short)(cvtpk(qq[j] * __builtin_amdgcn_exp2f(b), 0.f) & 0xffffu);
            *(unsigned short*)(set + OFF_KH + t * QROW + ch * 2) = (unsigned short)(cvtpk(kk[j] * __builtin_amdgcn_exp2f(fminf(-b, 100.f)), 0.f) & 0xffffu); }
        if (qt == 0) *(float*)(set + OFF_DV + ch * 4) = __builtin_amdgcn_exp2f(tot);
    } else {
        float e[4]; e[3] = 0.f; e[2] = lf[3]; e[1] = e[2] + lf[2]; e[0] = e[1] + lf[1];
        quarter_scan(e[0] + lf[0], qt, pre, post, tot);
#pragma unroll
        for (int j = 0; j < 4; ++j) { kd[j] = kk[j] * __builtin_amdgcn_exp2f(e[j] + post + run); vv[j] = vv4[j]; }
    }
    *(s16x4*)(set + OFF_KDT + ch * TROW + 8 * qt) = pack4(kd);
    *(s16x4*)(set + OFF_VT + ch * TROW + 8 * qt) = pack4(vv);
    return tot;
}

template <bool OUT>
__device__ __forceinline__ void run_item(char* lds, const Ptrs& P, unsigned short* OUTQ  , const float* gout, float* LST, float* DST, int item, int g, size_t m0, int h) {
    int tid = threadIdx.x; asm volatile("" : "+v"(tid));
    const int w = __builtin_amdgcn_readfirstlane(tid >> 6), lane = tid & 63, c16 = lane & 15, q = lane >> 4;
    const int ch = 16 * w + c16, hcol = h * 128;
    float* part = (float*)(lds + OFF_PART); char* rawb = lds + OFF_RAW; char* obuf = lds + OFF_OBUF; (void)obuf;
    constexpr int NSUB = 32;
#define HG_ROW(s) (m0 + 16 * (OUT ? (s) : (NSUB - 1 - (s))))
    RawRegs RA, RB; RA.a = RA.b = RA.c = RB.a = RB.b = RB.c = (u32x4){0u, 0u, 0u, 0u};
    g_load<OUT>(RA, P, HG_ROW(0), hcol, w, lane); g_load<OUT>(RB, P, HG_ROW(1), hcol, w, lane);
    f32x4 S[8];
#pragma unroll
    for (int kb = 0; kb < 8; ++kb) S[kb] = (f32x4){0.f, 0.f, 0.f, 0.f};
    if constexpr (OUT) {
        int gp = 0;
        for (; gp + 1 < g; gp += 2) { const int it0 = item - g + gp, it1 = it0 + 1;
#pragma unroll
            for (int kb = 0; kb < 8; ++kb) { const f32x4 d0 = *(const f32x4*)(DST + (size_t)it0 * 128 + 16 * kb + 4 * q), d1 = *(const f32x4*)(DST + (size_t)it1 * 128 + 16 * kb + 4 * q);
                const f32x4 l0 = *(const f32x4*)(LST + ((size_t)(it0 * 8 + w) * 8 + kb) * 256 + lane * 4), l1 = *(const f32x4*)(LST + ((size_t)(it1 * 8 + w) * 8 + kb) * 256 + lane * 4);
#pragma unroll
                for (int r = 0; r < 4; ++r) S[kb][r] = __builtin_amdgcn_exp2f(d1[r]) * (__builtin_amdgcn_exp2f(d0[r]) * S[kb][r] + l0[r]) + l1[r]; } }
        if (gp < g) { const int itp = item - g + gp;
#pragma unroll
            for (int kb = 0; kb < 8; ++kb) { const f32x4 dl = *(const f32x4*)(DST + (size_t)itp * 128 + 16 * kb + 4 * q);
                const f32x4 l4 = *(const f32x4*)(LST + ((size_t)(itp * 8 + w) * 8 + kb) * 256 + lane * 4);
#pragma unroll
                for (int r = 0; r < 4; ++r) S[kb][r] = __builtin_amdgcn_exp2f(dl[r]) * S[kb][r] + l4[r]; } }
    }
    float gv = 0.f; if constexpr (OUT) gv = gout[ch];
    float dsum = 0.f;
    raw_write<OUT>(RA, rawb, w, lane); raw_write<OUT>(RB, rawb + RAW_SLOT, w, lane);
    g_load<OUT>(RA, P, HG_ROW(2), hcol, w, lane); g_load<OUT>(RB, P, HG_ROW(3), hcol, w, lane);
    __syncthreads();
    float sgc[4] = {0.f, 0.f, 0.f, 0.f};
    dsum += stage<OUT>(rawb, lds, ch, q, dsum, sgc);
    __syncthreads();
#define HG_STEP(i, RX) do { \
        char* set = lds + ((i) & 1) * SET_BYTES; char* setn = lds + (((i) + 1) & 1) * SET_BYTES; \
        if ((i) + 2 < NSUB) { raw_write<OUT>(RX, rawb + (((i) + 2) % 3) * RAW_SLOT, w, lane); if ((i) + 4 < NSUB) g_load<OUT>(RX, P, HG_ROW((i) + 4), hcol, w, lane); } \
        const s16x4 vb = *(const s16x4*)(set + OFF_VT + ch * TROW + 8 * q); \
        f32x4 o = (f32x4){0.f, 0.f, 0.f, 0.f}; \
        if constexpr (OUT) { \
            f32x4 at = (f32x4){0.f, 0.f, 0.f, 0.f}; \
            _Pragma("unroll") for (int ks = 0; ks < 4; ++ks) { const bf16x8 a = *(const bf16x8*)(set + OFF_KH + c16 * QROW + (32 * ks + 8 * q) * 2), b = *(const bf16x8*)(set + OFF_QH + c16 * QROW + (32 * ks + 8 * q) * 2); \
                at = __builtin_amdgcn_mfma_f32_16x16x32_bf16(a, b, at, 0, 0, 0); } \
            _Pragma("unroll") for (int r = 0; r < 4; ++r) at[r] = (4 * q + r > c16) ? 0.f : at[r]; \
            _Pragma("unroll") for (int kb = 0; kb < 8; ++kb) { const s16x4 a = *(const s16x4*)(set + OFF_QH + c16 * QROW + (16 * kb + 4 * q) * 2); \
                o = __builtin_amdgcn_mfma_f32_16x16x16bf16_1k(a, pack4(S[kb]), o, 0, 0, 0); } \
            o = __builtin_amdgcn_mfma_f32_16x16x16bf16_1k(pack4(at), vb, o, 0, 0, 0); \
        } \
        _Pragma("unroll") for (int kb = 0; kb < 8; ++kb) { const s16x4 a = *(const s16x4*)(set + OFF_KDT + (16 * kb + c16) * TROW + 8 * q); \
            if constexpr (OUT) { const f32x4 dv = *(const f32x4*)(set + OFF_DV + (16 * kb + 4 * q) * 4); S[kb] = __builtin_amdgcn_mfma_f32_16x16x16bf16_1k(a, vb, S[kb] * dv, 0, 0, 0); } \
            else S[kb] = __builtin_amdgcn_mfma_f32_16x16x16bf16_1k(a, vb, S[kb], 0, 0, 0); } \
        if constexpr (OUT) { \
            _Pragma("unroll") for (int r = 0; r < 4; ++r) { const float s = row16_sum(o[r] * o[r]); \
                if (c16 == 0) part[(((i) & 1) * 8 + w) * 16 + 4 * q + r] = s; } \
        } \
        float sgn[4] = {0.f, 0.f, 0.f, 0.f}; \
        if ((i) + 1 < NSUB) dsum += stage<OUT>(rawb + (((i) + 1) % 3) * RAW_SLOT, setn, ch, q, dsum, sgn); \
        __syncthreads(); \
        if constexpr (OUT) { \
            _Pragma("unroll") for (int r = 0; r < 4; ++r) { float tot = 0.f; \
                _Pragma("unroll") for (int ww = 0; ww < 8; ++ww) tot += part[(((i) & 1) * 8 + ww) * 16 + 4 * q + r]; \
                const float rstd = __builtin_amdgcn_rsqf(tot * (1.f / 128.f) + NORM_EPS); \
                *(unsigned short*)(obuf + ((((i) & 3) * 16) + 4 * q + r) * QROW + ch * 2) = (unsigned short)(cvtpk(o[r] * rstd * gv * sgc[r], 0.f) & 0xffffu); } \
            _Pragma("unroll") for (int j = 0; j < 4; ++j) sgc[j] = sgn[j]; \
            if (((i) & 3) == 3) { __syncthreads();            \
                _Pragma("unroll") for (int k2 = 0; k2 < 2; ++k2) { const int id = tid + 512 * k2, row = id >> 4, c8 = id & 15; \
                    *(u32x4*)(OUTQ + (m0 + 16 * ((i) - 3) + row) * 2048 + hcol + 8 * c8) = *(const u32x4*)(obuf + row * QROW + 16 * c8); } } \
        } } while (0)
#pragma unroll 1
    for (int i = 0; i < NSUB; i += 2) { HG_STEP(i, RA); HG_STEP(i + 1, RB); }
#undef HG_STEP
#undef HG_ROW
    if constexpr (!OUT) {
#pragma unroll
        for (int kb = 0; kb < 8; ++kb) *(f32x4*)(LST + ((size_t)(item * 8 + w) * 8 + kb) * 256 + lane * 4) = S[kb];
        if (q == 0) DST[(size_t)item * 128 + ch] = dsum;
    }
    __syncthreads();
}
}


#ifndef H2_DEFER
#define H2_DEFER 1
#endif
namespace hg2 {
typedef short s16x4 __attribute__((ext_vector_type(4)));
typedef short bf16x8 __attribute__((ext_vector_type(8)));
typedef float f32x4 __attribute__((ext_vector_type(4)));
typedef unsigned u32x2 __attribute__((ext_vector_type(2)));
typedef unsigned u32x4 __attribute__((ext_vector_type(4)));
constexpr int C = 32, NCH = 16;
constexpr int QROW = 272, TROW = 80;
constexpr int OFF_QH = 0, OFF_KH = C * QROW, OFF_KDT = 2 * C * QROW, OFF_VT = OFF_KDT + 128 * TROW, OFF_DV = OFF_VT + 128 * TROW, OFF_ER = OFF_DV + 512, SET_BYTES = OFF_ER + 512;
constexpr int RAW_T = 16 * QROW, RAW_SLOT = 5 * RAW_T;
constexpr int OFF_RAW = SET_BYTES, OFF_PART = OFF_RAW + 3 * RAW_SLOT, OFF_OBUF = OFF_PART + 2 * 4 * C * 4, OFF_SG = OFF_OBUF + 64 * QROW  , LDS_BYTES = OFF_SG + 2 * C * QROW;
static_assert(SET_BYTES % 16 == 0 && OFF_KDT % 16 == 0 && OFF_VT % 16 == 0 && OFF_DV % 16 == 0 && OFF_RAW % 16 == 0 && OFF_PART % 16 == 0 && OFF_OBUF % 16 == 0 && LDS_BYTES <= 143360, "hg2 LDS map");
typedef float f32x2_t __attribute__((ext_vector_type(2))); typedef __bf16 bf16x2_t __attribute__((ext_vector_type(2)));
__device__ __forceinline__ unsigned cvtpk(float lo, float hi) { f32x2_t v = {lo, hi}; bf16x2_t b = __builtin_convertvector(v, bf16x2_t); return __builtin_bit_cast(unsigned, b); }
__device__ __forceinline__ float bf2f(unsigned short b) { return __uint_as_float((unsigned)b << 16); }
__device__ __forceinline__ s16x4 pack4(f32x4 v) { u32x2 w; w.x = cvtpk(v[0], v[1]); w.y = cvtpk(v[2], v[3]); return __builtin_bit_cast(s16x4, w); }
template <int CTRL> __device__ __forceinline__ float dpp_mov(float v) { return __int_as_float(__builtin_amdgcn_update_dpp(0, __float_as_int(v), CTRL, 0xf, 0xf, true)); }
__device__ __forceinline__ float row16_sum(float s) { s += dpp_mov<0xB1>(s); s += dpp_mov<0x4E>(s); s += dpp_mov<0x141>(s); s += dpp_mov<0x140>(s); return s; }

struct Ptrs { const unsigned short* QQ; const unsigned short* HK; const unsigned short* HV; const unsigned short* HLF; const unsigned short* HSG; };
#define U4(x) __builtin_bit_cast(u32x4, (x))
#define F4(x) __builtin_bit_cast(f32x4, (x))
template <bool OUT> __device__ __forceinline__ void g_load(f32x4* R, const Ptrs& P, size_t row0, int hcol, int sw, int lane) {
    const size_t r = row0 + 4 * sw + (lane >> 4); const int c = hcol + 8 * (lane & 15);
    R[0] = *(const f32x4*)(P.HLF + r * 1024 + c); R[1] = *(const f32x4*)(P.HK + r * 1024 + c); R[2] = *(const f32x4*)(P.HV + r * 1024 + c);
    if constexpr (OUT) { R[3] = *(const f32x4*)(P.QQ + r * 2048 + c); R[4] = *(const f32x4*)(P.HSG + r * 1024 + c); }
}
template <bool OUT> __device__ __forceinline__ void raw_write(const f32x4* R, char* slot, int sw, int lane) {
    const int d = (4 * sw + (lane >> 4)) * QROW + 16 * (lane & 15);
    *(f32x4*)(slot + d) = R[0]; *(f32x4*)(slot + RAW_T + d) = R[1]; *(f32x4*)(slot + 2 * RAW_T + d) = R[2];
    if constexpr (OUT) { *(f32x4*)(slot + 3 * RAW_T + d) = R[3]; *(f32x4*)(slot + 4 * RAW_T + d) = R[4]; }
}
template <bool OUT>
__device__ __forceinline__ float stage_compute(f32x4* Zr, float& zdv, float& zer, const char* raw, int ch, int hf, float run) {
    const char* rp = raw + ch * 2;
    float c[16];
    float tot, pre = 0.f, bref = 0.f, post = 0.f;
    if constexpr (OUT) {
        c[0] = (float)__builtin_bit_cast(_Float16, *(const unsigned short*)rp);
#pragma unroll
        for (int j = 1; j < 16; ++j) c[j] = c[j - 1] + (float)__builtin_bit_cast(_Float16, *(const unsigned short*)(rp + j * QROW));
        auto rr = __builtin_amdgcn_permlane32_swap(__float_as_uint(c[15]), __float_as_uint(c[15]), false, false);
        const float t0 = __uint_as_float(rr[0]), t1 = __uint_as_float(rr[1]);
        tot = t0 + t1; bref = t0; pre = hf ? t0 : 0.f;
        zdv = __builtin_amdgcn_exp2f(tot); zer = __builtin_amdgcn_exp2f(bref);
    } else {
        c[15] = 0.f;
#pragma unroll
        for (int j = 14; j >= 0; --j) c[j] = c[j + 1] + (float)__builtin_bit_cast(_Float16, *(const unsigned short*)(rp + (j + 1) * QROW));
        const float T = c[0] + (float)__builtin_bit_cast(_Float16, *(const unsigned short*)rp);
        auto rr = __builtin_amdgcn_permlane32_swap(__float_as_uint(T), __float_as_uint(T), false, false);
        const float t0 = __uint_as_float(rr[0]), t1 = __uint_as_float(rr[1]);
        tot = t0 + t1; post = (hf ? 0.f : t1) + run;
        zdv = 0.f; zer = 0.f;
    }
#pragma unroll
    for (int hh = 0; hh < 2; ++hh) {
        u32x4 qh, kh, sg, kd, vv;
#pragma unroll
        for (int jj = 0; jj < 4; ++jj) { const int j = 4 * hh + jj; const char* r0 = rp + 2 * j * QROW; const char* r1 = r0 + QROW;
            const float k0 = bf2f(*(const unsigned short*)(r0 + RAW_T)), k1 = bf2f(*(const unsigned short*)(r1 + RAW_T));
            vv[jj] = (unsigned)*(const unsigned short*)(r0 + 2 * RAW_T) | ((unsigned)*(const unsigned short*)(r1 + 2 * RAW_T) << 16);
            if constexpr (OUT) {
                const float q0 = bf2f(*(const unsigned short*)(r0 + 3 * RAW_T)), q1 = bf2f(*(const unsigned short*)(r1 + 3 * RAW_T));
                sg[jj] = (unsigned)*(const unsigned short*)(r0 + 4 * RAW_T) | ((unsigned)*(const unsigned short*)(r1 + 4 * RAW_T) << 16);
                const float b0 = pre + c[2 * j], b1 = pre + c[2 * j + 1];
                kd[jj] = cvtpk(k0 * __builtin_amdgcn_exp2f(tot - b0), k1 * __builtin_amdgcn_exp2f(tot - b1));
                qh[jj] = cvtpk(q0 * __builtin_amdgcn_exp2f(fminf(b0 - bref, 100.f)), q1 * __builtin_amdgcn_exp2f(fminf(b1 - bref, 100.f)));
                kh[jj] = cvtpk(k0 * __builtin_amdgcn_exp2f(fminf(bref - b0, 100.f)), k1 * __builtin_amdgcn_exp2f(fminf(bref - b1, 100.f)));
            } else {
                kd[jj] = cvtpk(k0 * __builtin_amdgcn_exp2f(c[2 * j] + post), k1 * __builtin_amdgcn_exp2f(c[2 * j + 1] + post));
            } }
        if constexpr (OUT) { Zr[hh] = F4(qh); Zr[2 + hh] = F4(kh); Zr[4 + hh] = F4(sg); }
        Zr[6 + hh] = F4(kd); Zr[8 + hh] = F4(vv);
        __builtin_amdgcn_sched_barrier(0);
    }
    return tot;
}
template <bool OUT>
__device__ __forceinline__ void stage_write(const f32x4* Zr, float zdv, float zer, char* set, char* sgb, int ch, int hf) {
    *(f32x4*)(set + OFF_KDT + ch * TROW + 32 * hf) = Zr[6]; *(f32x4*)(set + OFF_KDT + ch * TROW + 32 * hf + 16) = Zr[7];
    *(f32x4*)(set + OFF_VT + ch * TROW + 32 * hf) = Zr[8]; *(f32x4*)(set + OFF_VT + ch * TROW + 32 * hf + 16) = Zr[9];
    if constexpr (OUT) {
#pragma unroll
        for (int j = 0; j < 8; ++j) { const int o = (16 * hf + 2 * j) * QROW + ch * 2;
            const unsigned qw = U4(Zr[j >> 2])[j & 3], kw = U4(Zr[2 + (j >> 2)])[j & 3], sw_ = U4(Zr[4 + (j >> 2)])[j & 3];
            *(unsigned short*)(set + OFF_QH + o) = (unsigned short)(qw & 0xffffu); *(unsigned short*)(set + OFF_QH + o + QROW) = (unsigned short)(qw >> 16);
            *(unsigned short*)(set + OFF_KH + o) = (unsigned short)(kw & 0xffffu); *(unsigned short*)(set + OFF_KH + o + QROW) = (unsigned short)(kw >> 16);
            *(unsigned short*)(sgb + o) = (unsigned short)(sw_ & 0xffffu); *(unsigned short*)(sgb + o + QROW) = (unsigned short)(sw_ >> 16); }
        if (hf == 0) { *(float*)(set + OFF_DV + ch * 4) = zdv; *(float*)(set + OFF_ER + ch * 4) = zer; }
    }
}

template <bool OUT>
__device__ __forceinline__ void run_item(char* lds, const Ptrs& P, unsigned short* OUTQ, const float* gout, float* LST, float* DST, int item, int g, size_t m0, int h) {
    int tid = threadIdx.x; asm volatile("" : "+v"(tid));
    const int w = __builtin_amdgcn_readfirstlane(tid >> 6), lane = tid & 63, c16 = lane & 15, q = lane >> 4;
    const bool stager = w >= 4; const int cw = w & 3;
    const int hcol = h * 128;
    char* set = lds; char* rawb = lds + OFF_RAW; float* part = (float*)(lds + OFF_PART); char* obuf = lds + OFF_OBUF;
    const int ch = 32 * cw + (lane & 31), hf = lane >> 5;
#define H2_ROW(vh) (m0 + 16 * (OUT ? (vh) : (2 * (NCH - 1 - ((vh) >> 1)) + ((vh) & 1))))
    f32x4 U[20];
#pragma unroll
    for (int k = 0; k < 20; ++k) U[k] = (f32x4){0.f, 0.f, 0.f, 0.f};
#define S_(vt, kb) U[8 * (vt) + (kb)]
#define O_(vt, tt) U[16 + 2 * (vt) + (tt)]
    float gv[2] = {0.f, 0.f};
    if constexpr (OUT) {
        if (!stager) {
            gv[0] = gout[32 * cw + c16]; gv[1] = gout[32 * cw + 16 + c16];
            for (int gp = 0; gp < g; ++gp) { const int itp = item - g + gp;
#pragma unroll
                for (int kb = 0; kb < 8; ++kb) { const f32x4 dl = *(const f32x4*)(DST + (size_t)itp * 128 + 16 * kb + 4 * q);
                    f32x4 e4; e4[0] = __builtin_amdgcn_exp2f(dl[0]); e4[1] = __builtin_amdgcn_exp2f(dl[1]); e4[2] = __builtin_amdgcn_exp2f(dl[2]); e4[3] = __builtin_amdgcn_exp2f(dl[3]);
#pragma unroll
                    for (int vt = 0; vt < 2; ++vt) { const f32x4 l4 = *(const f32x4*)(LST + ((size_t)((itp * 4 + cw) * 2 + vt) * 8 + kb) * 256 + lane * 4);
                        S_(vt, kb) = e4 * S_(vt, kb) + l4; } } }
        }
    }
    f32x4* const GA = U; f32x4* const GB = U + 5; f32x4* const Z = U + 10;
    float dsum = 0.f, zdv = 0.f, zer = 0.f;
    if (stager) { g_load<OUT>(GA, P, H2_ROW(0), hcol, cw, lane); g_load<OUT>(GB, P, H2_ROW(1), hcol, cw, lane);
        raw_write<OUT>(GA, rawb, cw, lane); raw_write<OUT>(GB, rawb + RAW_SLOT, cw, lane);
        g_load<OUT>(GA, P, H2_ROW(2), hcol, cw, lane); g_load<OUT>(GB, P, H2_ROW(3), hcol, cw, lane); }
    __syncthreads();
    if (stager) { dsum += stage_compute<OUT>(Z, zdv, zer, rawb + hf * RAW_SLOT, ch, hf, dsum);
        raw_write<OUT>(GA, rawb + 2 * RAW_SLOT, cw, lane); g_load<OUT>(GA, P, H2_ROW(4), hcol, cw, lane); }
    __syncthreads();
    if (stager) { stage_write<OUT>(Z, zdv, zer, set, lds + OFF_SG, ch, hf);
        raw_write<OUT>(GB, rawb, cw, lane); g_load<OUT>(GB, P, H2_ROW(5), hcol, cw, lane); }
    __syncthreads();
#pragma unroll 1
    for (int i = 0; i < NCH; ++i) {
        if (stager) {
            if (2 * i + 4 < 2 * NCH) { raw_write<OUT>(GA, rawb + ((2 * i + 4) % 3) * RAW_SLOT, cw, lane); if (2 * i + 6 < 2 * NCH) g_load<OUT>(GA, P, H2_ROW(2 * i + 6), hcol, cw, lane); }
            if (i + 1 < NCH) dsum += stage_compute<OUT>(Z, zdv, zer, rawb + ((2 * i + 2 + hf) % 3) * RAW_SLOT, ch, hf, dsum);
        } else {
            if constexpr (OUT) {
                f32x4 a00 = (f32x4){0.f, 0.f, 0.f, 0.f}, a01 = a00, a11 = a00;
#pragma unroll
                for (int ks = 0; ks < 4; ++ks) { const int ko = (32 * ks + 8 * q) * 2;
                    const bf16x8 k0 = *(const bf16x8*)(set + OFF_KH + c16 * QROW + ko), k1 = *(const bf16x8*)(set + OFF_KH + (16 + c16) * QROW + ko);
                    const bf16x8 q0 = *(const bf16x8*)(set + OFF_QH + c16 * QROW + ko), q1 = *(const bf16x8*)(set + OFF_QH + (16 + c16) * QROW + ko);
                    a00 = __builtin_amdgcn_mfma_f32_16x16x32_bf16(k0, q0, a00, 0, 0, 0); a01 = __builtin_amdgcn_mfma_f32_16x16x32_bf16(k0, q1, a01, 0, 0, 0); a11 = __builtin_amdgcn_mfma_f32_16x16x32_bf16(k1, q1, a11, 0, 0, 0); }
#pragma unroll
                for (int r = 0; r < 4; ++r) { const bool drop = 4 * q + r > c16; a00[r] = drop ? 0.f : a00[r]; a11[r] = drop ? 0.f : a11[r]; }
                const s16x4 p00 = pack4(a00), p01 = pack4(a01), p11 = pack4(a11);
#pragma unroll
                for (int vt = 0; vt < 2; ++vt) { O_(vt, 0) = (f32x4){0.f, 0.f, 0.f, 0.f}; O_(vt, 1) = (f32x4){0.f, 0.f, 0.f, 0.f}; }
#pragma unroll
                for (int kb = 0; kb < 8; ++kb) { const f32x4 er = *(const f32x4*)(set + OFF_ER + (16 * kb + 4 * q) * 4);
                    const s16x4 qa0 = *(const s16x4*)(set + OFF_QH + c16 * QROW + (16 * kb + 4 * q) * 2), qa1 = *(const s16x4*)(set + OFF_QH + (16 + c16) * QROW + (16 * kb + 4 * q) * 2);
#pragma unroll
                    for (int vt = 0; vt < 2; ++vt) {
#if defined(DBG_NO_ER)
                        const s16x4 sb = pack4(S_(vt, kb));
#elif defined(DBG_ZERO_S)
                        const s16x4 sb = pack4(S_(vt, kb) * 0.f + er * 1e-3f);
#else
                        const s16x4 sb = pack4(S_(vt, kb) * er);
#endif

#ifndef DBG_NO_INTER
                        O_(vt, 0) = __builtin_amdgcn_mfma_f32_16x16x16bf16_1k(qa0, sb, O_(vt, 0), 0, 0, 0); O_(vt, 1) = __builtin_amdgcn_mfma_f32_16x16x16bf16_1k(qa1, sb, O_(vt, 1), 0, 0, 0);
#endif
                    } }
#pragma unroll
                for (int vt = 0; vt < 2; ++vt) { const char* vr = set + OFF_VT + (32 * cw + 16 * vt + c16) * TROW + 8 * q;
                    const s16x4 va = *(const s16x4*)vr, vbh = *(const s16x4*)(vr + 32);
#ifndef DBG_NO_INTRA
                    O_(vt, 0) = __builtin_amdgcn_mfma_f32_16x16x16bf16_1k(p00, va, O_(vt, 0), 0, 0, 0);
                    O_(vt, 1) = __builtin_amdgcn_mfma_f32_16x16x16bf16_1k(p01, va, O_(vt, 1), 0, 0, 0);
                    O_(vt, 1) = __builtin_amdgcn_mfma_f32_16x16x16bf16_1k(p11, vbh, O_(vt, 1), 0, 0, 0);
#endif
                }
            }
            __builtin_amdgcn_sched_barrier(0);
            const bf16x8 vb0 = *(const bf16x8*)(set + OFF_VT + (32 * cw + c16) * TROW + 16 * q), vb1 = *(const bf16x8*)(set + OFF_VT + (32 * cw + 16 + c16) * TROW + 16 * q);
#pragma unroll
            for (int kb = 0; kb < 8; ++kb) { const bf16x8 a = *(const bf16x8*)(set + OFF_KDT + (16 * kb + c16) * TROW + 16 * q);
                if constexpr (OUT) { const f32x4 dv = *(const f32x4*)(set + OFF_DV + (16 * kb + 4 * q) * 4);
                    S_(0, kb) = __builtin_amdgcn_mfma_f32_16x16x32_bf16(a, vb0, S_(0, kb) * dv, 0, 0, 0); S_(1, kb) = __builtin_amdgcn_mfma_f32_16x16x32_bf16(a, vb1, S_(1, kb) * dv, 0, 0, 0); }
                else { S_(0, kb) = __builtin_amdgcn_mfma_f32_16x16x32_bf16(a, vb0, S_(0, kb), 0, 0, 0); S_(1, kb) = __builtin_amdgcn_mfma_f32_16x16x32_bf16(a, vb1, S_(1, kb), 0, 0, 0); } }
#ifdef DBG_CHECK_S
            if constexpr (OUT) { bool bad = false;
#pragma unroll
                for (int vt = 0; vt < 2; ++vt)
#pragma unroll
                    for (int kb = 0; kb < 8; ++kb)
#pragma unroll
                        for (int r = 0; r < 4; ++r) bad |= !(fabsf(S_(vt, kb)[r]) < 1e30f);
                if (bad) { O_(0, 0)[0] = __builtin_nanf(""); } }
#endif
            if constexpr (OUT) {
#pragma unroll
                for (int tt = 0; tt < 2; ++tt)
#pragma unroll
                    for (int r = 0; r < 4; ++r) { const float s = row16_sum(O_(0, tt)[r] * O_(0, tt)[r] + O_(1, tt)[r] * O_(1, tt)[r]);
                        if (c16 == 0) part[((i & 1) * 4 + cw) * C + 16 * tt + 4 * q + r] = s;
#if H2_DEFER
#pragma unroll
                        for (int vt = 0; vt < 2; ++vt) *(unsigned short*)(obuf + ((i & 1) * C + 16 * tt + 4 * q + r) * QROW + (32 * cw + 16 * vt + c16) * 2) = (unsigned short)(cvtpk(O_(vt, tt)[r] * gv[vt], 0.f) & 0xffffu);
#endif
                    }
            }
        }
        __syncthreads();
        if (stager) {
            if (i + 1 < NCH) stage_write<OUT>(Z, zdv, zer, set, lds + OFF_SG + ((i + 1) & 1) * C * QROW, ch, hf);
            if (2 * i + 5 < 2 * NCH) { raw_write<OUT>(GB, rawb + ((2 * i + 5) % 3) * RAW_SLOT, cw, lane); if (2 * i + 7 < 2 * NCH) g_load<OUT>(GB, P, H2_ROW(2 * i + 7), hcol, cw, lane); }
        }
#if H2_DEFER
        if constexpr (OUT) {
            const int row = tid >> 4, c8 = tid & 15;
            const float tot = (part[((i & 1) * 4 + 0) * C + row] + part[((i & 1) * 4 + 1) * C + row]) + (part[((i & 1) * 4 + 2) * C + row] + part[((i & 1) * 4 + 3) * C + row]);
            const float rstd = __builtin_amdgcn_rsqf(tot * (1.f / 128.f) + NORM_EPS);
            const u32x4 o8 = *(const u32x4*)(obuf + ((i & 1) * C + row) * QROW + 16 * c8), s8 = *(const u32x4*)(lds + OFF_SG + (i & 1) * C * QROW + row * QROW + 16 * c8);
            u32x4 w;
#pragma unroll
            for (int j = 0; j < 4; ++j) w[j] = cvtpk(__uint_as_float(o8[j] << 16) * rstd * __uint_as_float(s8[j] << 16), __uint_as_float(o8[j] & 0xffff0000u) * rstd * __uint_as_float(s8[j] & 0xffff0000u));
            *(u32x4*)(OUTQ + (m0 + 32 * i + row) * 2048 + hcol + 8 * c8) = w;
        }
#else
        else if constexpr (OUT) {
#pragma unroll
            for (int tt = 0; tt < 2; ++tt)
#pragma unroll
                for (int r = 0; r < 4; ++r) { const int t = 16 * tt + 4 * q + r;
                    const float tot = (part[((i & 1) * 4 + 0) * C + t] + part[((i & 1) * 4 + 1) * C + t]) + (part[((i & 1) * 4 + 2) * C + t] + part[((i & 1) * 4 + 3) * C + t]);
                    const float rstd = __builtin_amdgcn_rsqf(tot * (1.f / 128.f) + NORM_EPS);
#pragma unroll
                    for (int vt = 0; vt < 2; ++vt) { const float sgx = bf2f(*(const unsigned short*)(lds + OFF_SG + (i & 1) * C * QROW + t * QROW + (32 * cw + 16 * vt + c16) * 2));
                        *(unsigned short*)(obuf + ((i & 1) * C + t) * QROW + (32 * cw + 16 * vt + c16) * 2) = (unsigned short)(cvtpk(O_(vt, tt)[r] * rstd * gv[vt] * sgx, 0.f) & 0xffffu); } }
        }
#endif
        __syncthreads();
#if !H2_DEFER
        if constexpr (OUT) {
            if (i & 1) {
#pragma unroll
                for (int k2 = 0; k2 < 2; ++k2) { const int id = tid + 512 * k2, row = id >> 4, c8 = id & 15;
                    *(u32x4*)(OUTQ + (m0 + 32 * (i - 1) + row) * 2048 + hcol + 8 * c8) = *(const u32x4*)(obuf + row * QROW + 16 * c8); } }
        }
#endif
    }
#undef H2_ROW
    if constexpr (!OUT) {
        if (!stager) {
#pragma unroll
            for (int vt = 0; vt < 2; ++vt)
#pragma unroll
                for (int kb = 0; kb < 8; ++kb) *(f32x4*)(LST + ((size_t)((item * 4 + cw) * 2 + vt) * 8 + kb) * 256 + lane * 4) = S_(vt, kb);
        } else if (hf == 0) DST[(size_t)item * 128 + ch] = dsum;
    }
    __syncthreads();
#undef S_
#undef O_
}
#undef U4
#undef F4
}


struct Frame {
    LAS unsigned char* lds;
    volatile LAS unsigned* MISC;
    gu32* ctl;
    int tid, lane, wave;
    int vcu, G;
};

__device__ __forceinline__ float wave_sum(float v) { return pg8::rows4_sum(pg8::row16_sum(v)); }
__device__ __forceinline__ void p0_transpose64(const float* W, int ldw, int k0, int ncol0, bf16* WT, int ldt, int drow, int dk0, LAS unsigned char* scr, int lane, const float* ksc = nullptr) {
    const int n4 = lane & 15, qk = lane >> 4;
    const GAS f32x4* src = (const GAS f32x4*)(W + (size_t)(k0 + 2 * qk) * ldw + ncol0 + 4 * n4);
    f32x4 v[16];
#pragma unroll
    for (int p = 0; p < 8; ++p) { v[2 * p] = src[(size_t)(8 * p) * ldw / 4]; v[2 * p + 1] = src[(size_t)(8 * p + 1) * ldw / 4]; }
    if (ksc) {
#pragma unroll
        for (int p = 0; p < 8; ++p) { const float s0 = ksc[k0 + 2 * qk + 8 * p], s1 = ksc[k0 + 2 * qk + 8 * p + 1]; v[2 * p] = v[2 * p] * s0; v[2 * p + 1] = v[2 * p + 1] * s1; } }
#pragma unroll
    for (int p = 0; p < 8; ++p)
#pragma unroll
        for (int j = 0; j < 4; ++j) *(LAS unsigned*)(scr + (4 * n4 + j) * 132 + 16 * p + 4 * qk) = pk2(v[2 * p][j], v[2 * p + 1][j]);
    LDS_WAIT(); asm volatile("" ::: "memory");
    const int c = lane & 7;
#pragma unroll
    for (int j = 0; j < 8; ++j) { const int n = (lane >> 3) + 8 * j; const LAS unsigned* s = (const LAS unsigned*)(scr + n * 132 + 16 * c);
        v4u o; o.x = s[0]; o.y = s[1]; o.z = s[2]; o.w = s[3];
        *(GAS v4u*)(WT + (size_t)(drow + n) * ldt + dk0 + k0 + 8 * c) = o; }
    LDS_WAIT(); asm volatile("" ::: "memory");
}
__device__ __forceinline__ void rms_row_to_bf16(const float* xrow, const float* g, bf16* orow, int lane) {
    const GAS f32x4* xr = (const GAS f32x4*)xrow + lane; const GAS f32x4* gr = (const GAS f32x4*)g + lane;
    f32x4 v[4]; float s = 0.f;
#pragma unroll
    for (int j = 0; j < 4; ++j) { v[j] = xr[64 * j]; s += (v[j].x * v[j].x + v[j].y * v[j].y) + (v[j].z * v[j].z + v[j].w * v[j].w); }
    const float rstd = 1.f / sqrtf(wave_sum(s) * (1.f / DM) + NORM_EPS);
    GAS unsigned long long* o8 = (GAS unsigned long long*)orow + lane;
#pragma unroll
    for (int j = 0; j < 4; ++j) { const f32x4 gg = gr[64 * j];
        o8[64 * j] = (unsigned long long)pk2(v[j].x * rstd * gg.x, v[j].y * rstd * gg.y) | ((unsigned long long)pk2(v[j].z * rstd * gg.z, v[j].w * rstd * gg.w) << 32); }
}

__host__ __device__ __forceinline__ int win_row(int c) { if (c >= 4096 && c < 7168) return c - 4096; if (c < 4096) return 3072 + c; const int gi = c - 7168, hi = gi >= 1024, g2 = gi & 1023; return 7168 + 256 * (g2 >> 7) + 128 * hi + (g2 & 127); }
struct TrDesc { const float* W; int ldw, k0, ncol0; bf16* WT; int ldt, drow, dk0; };
__device__ __forceinline__ void tr_load(f32x4 (&v)[16], const TrDesc& d, int lane) {
    const int n4 = lane & 15, qk = lane >> 4;
    const GAS f32x4* src = (const GAS f32x4*)(d.W + (size_t)(d.k0 + 2 * qk) * d.ldw + d.ncol0 + 4 * n4);
#pragma unroll
    for (int p = 0; p < 8; ++p) { v[2 * p] = src[(size_t)(8 * p) * d.ldw / 4]; v[2 * p + 1] = src[(size_t)(8 * p + 1) * d.ldw / 4]; }
}
__device__ __forceinline__ void tr_store(const f32x4 (&v)[16], const TrDesc& d, LAS unsigned char* scr, int lane) {
    const int n4 = lane & 15, qk = lane >> 4;
#pragma unroll
    for (int p = 0; p < 8; ++p)
#pragma unroll
        for (int j = 0; j < 4; ++j) *(LAS unsigned*)(scr + (4 * n4 + j) * 132 + 16 * p + 4 * qk) = pk2(v[2 * p][j], v[2 * p + 1][j]);
    LDS_WAIT(); asm volatile("" ::: "memory");
    const int c = lane & 7;
#pragma unroll
    for (int j = 0; j < 8; ++j) { const int n = (lane >> 3) + 8 * j; const LAS unsigned* s = (const LAS unsigned*)(scr + n * 132 + 16 * c);
        v4u o; o.x = s[0]; o.y = s[1]; o.z = s[2]; o.w = s[3];
        *(GAS v4u*)(d.WT + (size_t)(d.drow + n) * d.ldt + d.dk0 + d.k0 + 8 * c) = o; }
    LDS_WAIT(); asm volatile("" ::: "memory");
}
__device__ __forceinline__ void h2_load(f32x4 (&v)[16], const float* x, int row, int lane) {
    const GAS f32x4* xr = (const GAS f32x4*)(x + (size_t)row * DM) + lane;
#pragma unroll
    for (int j = 0; j < 4; ++j) { v[j] = xr[64 * j]; v[4 + j] = xr[256 + 64 * j]; }
}
__device__ __forceinline__ void h2_store(const f32x4 (&v)[16], const float* g, bf16* HBp, int row, int lane) {
    const GAS f32x4* gr = (const GAS f32x4*)g + lane;
#pragma unroll
    for (int rr = 0; rr < 2; ++rr) { float s = 0.f;
#pragma unroll
        for (int j = 0; j < 4; ++j) { const f32x4 t = v[4 * rr + j]; s += (t.x * t.x + t.y * t.y) + (t.z * t.z + t.w * t.w); }
        const float rstd = 1.f / sqrtf(wave_sum(s) * (1.f / DM) + NORM_EPS);
        GAS unsigned long long* o8 = (GAS unsigned long long*)(HBp + (size_t)(row + rr) * DM) + lane;
#pragma unroll
        for (int j = 0; j < 4; ++j) { const f32x4 gg = gr[64 * j]; const f32x4 t = v[4 * rr + j];
            o8[64 * j] = (unsigned long long)pk2(t.x * rstd * gg.x, t.y * rstd * gg.y) | ((unsigned long long)pk2(t.z * rstd * gg.z, t.w * rstd * gg.w) << 32); } }
}


__device__ __forceinline__ int t5_bucket(int n) {
    if (n < 16) return n;
    int b = 15;
    b += n >= 16; b += n >= 19; b += n >= 21; b += n >= 24; b += n >= 27; b += n >= 31; b += n >= 35; b += n >= 40;
    b += n >= 46; b += n >= 52; b += n >= 59; b += n >= 67; b += n >= 77; b += n >= 87; b += n >= 99; b += n >= 113;
    return b;
}
__device__ __forceinline__ void naive_attn_row(int r, bool active, int tid, LAS float* sm, const bf16* AK, const bf16* AV, bf16* QQ, const float* KMEAN, const float* table) {
    LAS float* qs = sm; LAS float* gate = sm + 128; LAS int* sel = (LAS int*)(sm + 144); LAS float* bias_s = sm + 160; LAS float* lg = sm + 192; LAS float* red = sm + 192 + 1024;
    const int t = r % SEQ, bh = r / SEQ, h = bh % NH, b = bh / NH;
    const size_t m = (size_t)b * SEQ + t; const int c = t >> 8;
    if (tid < 128) qs[tid] = bf2f(QQ[m * 2048 + 1024 + h * 128 + tid]);
    if (tid < 32) bias_s[tid] = table[tid * 8 + h];
    __syncthreads();
    if (tid < 16) { float g = -INFINITY; if (tid < c) { g = 0.f; const float* km = KMEAN + ((size_t)bh * NBLK + tid) * HD; for (int d = 0; d < 128; ++d) g += qs[d] * km[d]; } gate[tid] = g; }
    __syncthreads();
    if (tid == 0) { unsigned used = 0u;
        for (int s = 0; s < 3; ++s) { int best = -1; float bv = 0.f; for (int n = 0; n < 16; ++n) if (!((used >> n) & 1u)) { const float gv = gate[n]; if (best < 0 || gv > bv) { best = n; bv = gv; } } used |= 1u << best; sel[s] = best; } }
    __syncthreads();
    for (int s = 0; s < 4; ++s) {
        int blk; bool valid;
        if (s == 0) { blk = c; valid = tid <= (t & 255); } else { blk = sel[s - 1]; valid = blk < c; }
        float logit = -INFINITY;
        if (valid) { const int pos = blk * 256 + tid; const bf16* kr = AK + ((size_t)b * SEQ + pos) * 1024 + h * 128; float dot = 0.f;
            for (int d = 0; d < 128; d += 8) { const v4u w = *(const GAS v4u*)(kr + d);
                dot += qs[d] * __uint_as_float(w.x << 16) + qs[d + 1] * __uint_as_float(w.x & 0xffff0000u) + qs[d + 2] * __uint_as_float(w.y << 16) + qs[d + 3] * __uint_as_float(w.y & 0xffff0000u)
                     + qs[d + 4] * __uint_as_float(w.z << 16) + qs[d + 5] * __uint_as_float(w.z & 0xffff0000u) + qs[d + 6] * __uint_as_float(w.w << 16) + qs[d + 7] * __uint_as_float(w.w & 0xffff0000u); }
            logit = dot * ATT_SCALE + bias_s[t5_bucket(t - pos)]; }
        lg[s * 256 + tid] = logit;
    }
    __syncthreads();
    float mx = fmaxf(fmaxf(lg[tid], lg[256 + tid]), fmaxf(lg[512 + tid], lg[768 + tid]));
    red[tid] = mx; __syncthreads();
    for (int o = 128; o > 0; o >>= 1) { if (tid < o) red[tid] = fmaxf(red[tid], red[tid + o]); __syncthreads(); }
    mx = red[0]; __syncthreads();
    float ps = 0.f;
    for (int s = 0; s < 4; ++s) { const float p = __expf(lg[s * 256 + tid] - mx); lg[s * 256 + tid] = p; ps += p; }
    red[tid] = ps; __syncthreads();
    for (int o = 128; o > 0; o >>= 1) { if (tid < o) red[tid] += red[tid + o]; __syncthreads(); }
    const float tot = red[0];
    if (tid < 128) { float acc = 0.f;
        for (int s = 0; s < 4; ++s) { const int blk = (s == 0) ? c : sel[s - 1]; if (s > 0 && blk >= c) continue;
            const bf16* vr = AV + ((size_t)b * SEQ + blk * 256) * 1024 + h * 128 + tid;
            for (int j = 0; j < 256; ++j) { const float p = lg[s * 256 + j]; if (p != 0.f) acc += p * bf2f(vr[(size_t)j * 1024]); } }
        if (active) QQ[m * 2048 + 1024 + h * 128 + tid] = (bf16)f2bf(acc / tot); }
    __syncthreads();
}

#ifndef MK_NAIVE_ATTN
#define MK_NAIVE_ATTN 0
#endif
#ifndef MK_NAIVE_HGRN
#define MK_NAIVE_HGRN 0
#endif
#ifndef PROBE_DUP
#define PROBE_DUP 0
#endif
#ifndef PROBE_T
#define PROBE_T -1
#endif
#ifndef PROBE_BLK
#define PROBE_BLK 0
#endif
#ifndef MK_P0_PIPE
#define MK_P0_PIPE 0
#endif
#ifndef PROBE_P0
#define PROBE_P0 0
#endif
#ifndef MK_ALIGN_P1A
#define MK_ALIGN_P1A true
#endif
#ifndef MK_ALIGN_P8
#define MK_ALIGN_P8 true
#endif
#ifndef MK_ALIGN_1U
#define MK_ALIGN_1U true
#endif
#ifndef MK_SP2
#define MK_SP2 true
#endif
#ifndef MK_WGM_P1B
#define MK_WGM_P1B 4
#endif
#ifndef MK_WGM_P1A
#define MK_WGM_P1A 4
#endif
#ifndef MK_WGM_P8
#define MK_WGM_P8 4
#endif
#ifndef MK_WGM_1U
#define MK_WGM_1U 4
#endif
#ifndef MK_HG2
#define MK_HG2 1
#endif
#ifndef MK_HG2A
#define MK_HG2A MK_HG2
#endif
#ifndef MK_HG2B
#define MK_HG2B MK_HG2
#endif
#ifndef MK_ATT2
#define MK_ATT2 1
#endif
#ifndef MK_ATT3
#define MK_ATT3 1
#endif
#ifndef MK_ATT4
#define MK_ATT4 0
#endif
#ifndef MK_ATT_HEAVY_FIRST
#define MK_ATT_HEAVY_FIRST 0
#endif
#ifndef MK_ONE_LAUNCH
#define MK_ONE_LAUNCH 1
#endif
struct Args { const float* in[15]; float* out; unsigned char* ws; int ph_lo, ph_hi; };
static_assert(sizeof(Args) == 15 * 8 + 8 + 8 + 8, "Args has no padding");

__global__ void __launch_bounds__(NWAVES * 64, 2) mk_fwd(Args args) {
    extern __shared__ __attribute__((aligned(16))) unsigned char lds[];
    Frame F;
    F.lds = (LAS unsigned char*)lds;
    F.MISC = (volatile LAS unsigned*)(F.lds + MISC_OFF);
    F.tid = threadIdx.x; F.lane = F.tid & 63; F.wave = __builtin_amdgcn_readfirstlane(F.tid >> 6);
    F.G = gridDim.x; { const int bx = blockIdx.x; F.vcu = (F.G % 8 == 0) ? (bx % 8) * (F.G / 8) + bx / 8 : bx; }
    unsigned char* ws = args.ws;
    F.ctl = (gu32*)(ws + WS_CTL);
    const float* x = args.in[0]; const float* attn_g = args.in[1]; const float* w_in = args.in[2]; const float* lb_gamma = args.in[3];
    const float* hg_out_g = args.in[4]; const float* q_g = args.in[5]; const float* k_g = args.in[6]; const float* rel_tab = args.in[7];
    const float* w_bh = args.in[8]; const float* w_ba = args.in[9]; const float* w_out = args.in[10]; const float* ffn_g = args.in[11];
    const float* w_gate = args.in[12]; const float* w_up = args.in[13]; const float* w_down = args.in[14];
    (void)hg_out_g; (void)rel_tab;
    bf16* WT_IN = (bf16*)(ws + WS_WT_IN); bf16* WT_CAT = (bf16*)(ws + WS_WT_CAT); bf16* WT_OUT = (bf16*)(ws + WS_WT_OUT);
    bf16* WT_FIN = (bf16*)(ws + WS_WT_FIN); bf16* WT_DOWN = (bf16*)(ws + WS_WT_DOWN); bf16* HB = (bf16*)(ws + WS_H);
    bf16* QQ = (bf16*)(ws + WS_QQ); bf16* AK = (bf16*)(ws + WS_AK); bf16* AV = (bf16*)(ws + WS_AV);
    unsigned short* HLF = (unsigned short*)(ws + WS_HLF); bf16* HSG = (bf16*)(ws + WS_HSG);
    float* KMEAN = (float*)(ws + WS_KMEAN); bf16* KMEANB = (bf16*)(ws + WS_KMEANB); float* LB = (float*)(ws + WS_LB); float* SSQ = (float*)(ws + WS_SSQ);
    bf16* MERGED = (bf16*)(ws + WS_MERGED); bf16* X1B = (bf16*)(ws + WS_A2); bf16* ACT = (bf16*)(ws + WS_ACT);
    float* LST = (float*)(ws + WS_LST); float* DST = (float*)(ws + WS_DST);
    bf16* GATES = (bf16*)args.out;

    for (int u = F.tid; u < (LDS_BYTES - LDSCTL_OFF) / 4; u += NWAVES * 64) ((LAS unsigned*)(F.lds + LDSCTL_OFF))[u] = 0u;
    __syncthreads();
    const int lo = args.ph_lo, hi = args.ph_hi;
    XcdBarrier bar; bar.bar = (unsigned*)(F.ctl + CW_BAR); bar.x = 0; bar.st = nullptr;
    if (hi - lo > 1) bar = xcd_barrier_post((unsigned*)(F.ctl + CW_BAR), F.MISC + 8);
#ifndef PHMASK
#define PHMASK 0x3ff
#endif
#define IN(k) (((PHMASK >> (k)) & 1) && lo <= (k) && (k) < hi)
#define BOTH(k) (IN(k) && IN((k) + 1))
#define GRID_BAR() xcd_barrier(bar)
    const int gw = F.vcu * NWAVES + F.wave, NGW = F.G * NWAVES;
    unsigned long long pt0 = 0ull, pt1 = 0ull; (void)pt0; (void)pt1;
#define TSTART(k) do { if (PROBE_T == (k) || PROBE_T == (k) + 20) pt0 = __builtin_amdgcn_s_memrealtime(); } while (0)
#define TEND(k) do { if (PROBE_T == (k)) pt1 = __builtin_amdgcn_s_memrealtime(); } while (0)
    LAS unsigned char* scrb = F.lds + RING_OFF + F.wave * 16384;

#if (PROBE_DUP >> 0) & 1
    for (int rep_0 = 0; rep_0 < 2; ++rep_0) {
#endif
    if (IN(0)) { TSTART(0);
        constexpr int I_IN = 16 * 144, I_B = 16 * 16, I_T = I_IN + 3 * I_B, I_H = MTOK / 2;
        if (MK_P0_PIPE && NGW == 2048) {
            const int nit = gw < 1024 ? 5 : 6;
#define P0_DEC(k) const int k_ = (k); const bool isT = k_ == 0 || (gw < 1024 && k_ == 1); \
            const int idx = isT ? (k_ == 0 ? gw : 2048 + gw) : (gw < 1024 ? 3 * gw + k_ - 2 : 3072 + 5 * (gw - 1024) + k_ - 1); \
            TrDesc td; { int r = idx; if (r < I_IN) { const int c = 64 * (r % 144); td = TrDesc{w_in, INCOLS, 64 * (r / 144), c, WT_IN, 1024, win_row(c), 0}; } \
                else { r -= I_IN; const int wsel = r / I_B; r %= I_B; td = TrDesc{wsel == 0 ? w_bh : (wsel == 1 ? w_ba : w_out), 1024, 64 * (r / 16), 64 * (r % 16), wsel == 2 ? WT_OUT : WT_CAT, wsel == 2 ? 1024 : 2048, 64 * (r % 16), wsel == 1 ? 1024 : 0}; } }
#define P0_LOAD(v, k) do { P0_DEC(k); if (isT) tr_load(v, td, F.lane); else h2_load(v, x, 2 * idx, F.lane); } while (0)
#define P0_PROC(v, k) do { P0_DEC(k); if (isT) tr_store(v, td, scrb, F.lane); else h2_store(v, attn_g, HB, 2 * idx, F.lane); } while (0)
            f32x4 va[16], vb[16];
#pragma unroll
            for (int j = 0; j < 16; ++j) { va[j] = (f32x4){0.f, 0.f, 0.f, 0.f}; vb[j] = (f32x4){0.f, 0.f, 0.f, 0.f}; }
            P0_LOAD(va, 0);
#pragma unroll 1
            for (int k = 0; k < nit; k += 2) {
                if (k + 1 < nit) P0_LOAD(vb, k + 1);
                P0_PROC(va, k);
                if (k + 2 < nit) P0_LOAD(va, k + 2);
                if (k + 1 < nit) P0_PROC(vb, k + 1);
            }
#undef P0_DEC
#undef P0_LOAD
#undef P0_PROC
        } else
        for (int it = gw; it < I_T + I_H; it += NGW) {
            int r = it;
            if (r < I_IN) { const int kb = r / 144, c = 64 * (r % 144); const int d = win_row(c);
                p0_transpose64(w_in, INCOLS, 64 * kb, c, WT_IN, 1024, d, 0, scrb, F.lane); continue; } r -= I_IN;
            if (r < I_B) { p0_transpose64(w_bh, 1024, 64 * (r / 16), 64 * (r % 16), WT_CAT, 2048, 64 * (r % 16), 0, scrb, F.lane); continue; } r -= I_B;
            if (r < I_B) { p0_transpose64(w_ba, 1024, 64 * (r / 16), 64 * (r % 16), WT_CAT, 2048, 64 * (r % 16), 1024, scrb, F.lane); continue; } r -= I_B;
            if (r < I_B) { p0_transpose64(w_out, 1024, 64 * (r / 16), 64 * (r % 16), WT_OUT, 1024, 64 * (r % 16), 0, scrb, F.lane); continue; } r -= I_B;
            rms_row_to_bf16(x + (size_t)(2 * r) * DM, attn_g, HB + (size_t)(2 * r) * DM, F.lane);
            rms_row_to_bf16(x + (size_t)(2 * r + 1) * DM, attn_g, HB + (size_t)(2 * r + 1) * DM, F.lane);
        }
#if PROBE_P0 & 1
        for (int m = gw; m < MTOK; m += NGW) rms_row_to_bf16(x + (size_t)m * DM, attn_g, HB + (size_t)m * DM, F.lane);
#endif
#if PROBE_P0 & 2
        for (int it = gw; it < I_IN; it += NGW) { const int r = it, kb = r / 144, c = 64 * (r % 144); const int d = win_row(c);
            p0_transpose64(w_in, INCOLS, 64 * kb, c, WT_IN, 1024, d, 0, scrb, F.lane); }
#endif
        { const int gt = blockIdx.x * (NWAVES * 64) + F.tid; if (gt < 1024) LB[gt] = 1.f / (1.f + __expf(lb_gamma[1024 + gt] - lb_gamma[gt])); }
        if (BOTH(0)) GRID_BAR();
        TEND(0);
    }
#if (PROBE_DUP >> 0) & 1
    }
#endif
#if (PROBE_DUP >> 2) & 1
    for (int rep_2 = 0; rep_2 < 2; ++rep_2) {
#endif
#if (PROBE_DUP >> 1) & 1
    for (int rep_1 = 0; rep_1 < 2; ++rep_1) {
#endif
    if (IN(1)) { TSTART(1);
        pg8::Gemm g{HB, WT_IN, MTOK, 3072, 1024}; pg8::StaticOrder S; S.init(MTOK, 3072, F.G, (int)blockIdx.x, MK_WGM_P1B);
        pg8::EpiProj E{0, QQ, AK, AV, HLF, HSG, GATES, KMEAN, KMEANB, LB, q_g, k_g, (PG8_LAS unsigned char*)(F.lds + EPI_SCR_OFF)};
        pg8::gemm_phase<pg8::EpiProj, pg8::StaticOrder, true, MK_SP2>(F.lds + RING_OFF, g, S, E);
        if (BOTH(1)) GRID_BAR();
        TEND(1);
    }
#if (PROBE_DUP >> 1) & 1
    }
#endif
#if (PROBE_DUP >> 11) & 1
    {
        pg8::Gemm g{HB, WT_IN, MTOK, 2048, 1024}; pg8::StaticOrder S; S.init(MTOK, 2048, F.G, (int)blockIdx.x);
        pg8::EpiPlain E{(bf16*)(ws + WS_HLF), 2048};
        pg8::gemm_phase<pg8::EpiPlain, pg8::StaticOrder, true, MK_SP2>(F.lds + RING_OFF, g, S, E);
        GRID_BAR();
    }
#endif
#if (PROBE_DUP >> 12) & 1
    {
        pg8::Gemm g{HB, WT_IN, MTOK, 1024, 1024}; pg8::StaticOrder S; S.init(MTOK, 1024, F.G, (int)blockIdx.x);
        pg8::EpiPlain E{(bf16*)(ws + WS_HLF), 2048};
        pg8::gemm_phase<pg8::EpiPlain, pg8::StaticOrder, true, MK_SP2>(F.lds + RING_OFF, g, S, E);
        GRID_BAR();
    }
#endif
#if (PROBE_DUP >> 13) & 1
    {
        pg8::Gemm g{HB, WT_IN, MTOK, 1024, 1024}; pg8::StaticOrder S; S.init(MTOK, 1024, F.G, (int)blockIdx.x);
        pg8::EpiProj E{0, QQ, AK, AV, HLF, HSG, GATES, KMEAN, KMEANB, LB, q_g, k_g, (PG8_LAS unsigned char*)(F.lds + EPI_SCR_OFF)};
        pg8::gemm_phase<pg8::EpiProj, pg8::StaticOrder, true, MK_SP2>(F.lds + RING_OFF, g, S, E);
        GRID_BAR();
    }
#endif
#if (PROBE_DUP >> 14) & 1
    {
        pg8::Gemm g{HB, WT_IN, MTOK, 3072, 1024}; pg8::StaticOrder S; S.init(MTOK, 3072, F.G, (int)blockIdx.x);
        pg8::EpiProj E{0, QQ, AK, AV, HLF, HSG, GATES, KMEAN, KMEANB, LB, q_g, k_g, (PG8_LAS unsigned char*)(F.lds + EPI_SCR_OFF)};
        pg8::gemm_phase<pg8::EpiProj, pg8::StaticOrder, true, MK_SP2>(F.lds + RING_OFF, g, S, E);
        GRID_BAR();
    }
#endif
#if (PROBE_DUP >> 15) & 1
    {
        pg8::Gemm g{HB, WT_IN, MTOK, 3072, 1024}; pg8::StaticOrder S; S.init(MTOK, 3072, F.G, (int)blockIdx.x);
        pg8::EpiPlain E{(bf16*)(ws + WS_HLF), 4096};
        pg8::gemm_phase<pg8::EpiPlain, pg8::StaticOrder, true, MK_SP2>(F.lds + RING_OFF, g, S, E);
        GRID_BAR();
    }
#endif
#ifdef MK_ABL
    if (IN(2)) { pt0 = __builtin_amdgcn_s_memrealtime();
            moba::Seam S; S.vs = 0;
            for (int L = F.vcu; L < BATCH * NH * 8; L += F.G) {
                const int bh = L >> 3, xq = L & 7, bb = bh / NH, hh = bh % NH;
                const bf16* kbase = AK + (size_t)bb * SEQ * 1024 + hh * 128; const bf16* vbase = AV + (size_t)bb * SEQ * 1024 + hh * 128;
                bf16* q0 = QQ + ((size_t)bb * SEQ + xq * 256) * 2048 + 1024 + hh * 128; bf16* q1 = QQ + ((size_t)bb * SEQ + (15 - xq) * 256) * 2048 + 1024 + hh * 128;
                bf16* d0 = (bf16*)(ws + WS_HLF) + (q0 - QQ); bf16* d1 = (bf16*)(ws + WS_HLF) + (q1 - QQ);
                const moba::BlockRef c0{q0, kbase, vbase, d0, KMEANB + (size_t)bh * NBLK * HD, rel_tab + hh, q_g, k_g, xq * 256};
                const moba::BlockRef c1{q1, kbase, vbase, d1, KMEANB + (size_t)bh * NBLK * HD, rel_tab + hh, q_g, k_g, (15 - xq) * 256};
#if MK_ATT4
                moba::moba_prime4(c0, F.lds + RING_OFF, S);
#pragma unroll 1
                for (int pass = 0; pass < 2; ++pass) { const moba::BlockRef cu = pass ? c1 : c0; moba::moba_block4<MK_ABL>(cu, c1, F.lds + RING_OFF, S); }
#elif MK_ATT3
                moba::moba_prime3(c0, F.lds + RING_OFF, S);
#pragma unroll 1
                for (int pass = 0; pass < 2; ++pass) { const moba::BlockRef cu = pass ? c1 : c0; moba::moba_block3<MK_ABL>(cu, c1, F.lds + RING_OFF, S); }
#else
                moba::moba_prime(c0, (char*)lds + RING_OFF, S);
#pragma unroll 1
                for (int pass = 0; pass < 2; ++pass) { const moba::BlockRef cu = pass ? c1 : c0; moba::moba_block2<MK_ABL>(cu, c1, (char*)lds + RING_OFF, S); }
#endif
            }
        GRID_BAR();
        pt1 = __builtin_amdgcn_s_memrealtime();
    }
#endif
    if (IN(2)) { TSTART(2);
#if MK_NAIVE_ATTN
        { const int half = F.tid >> 8, ht = F.tid & 255; LAS float* sm = (LAS float*)(F.lds + RING_OFF) + half * 2048;
          const int total = BATCH * NH * SEQ, iters = (total + 2 * F.G - 1) / (2 * F.G);
          for (int i = 0; i < iters; ++i) { int r = i * 2 * F.G + blockIdx.x * 2 + half; const bool act = r < total; if (!act) r = total - 1;
              naive_attn_row(r, act, ht, sm, AK, AV, QQ, KMEAN, rel_tab); } }
#else
        {
            moba::Seam S; S.vs = 0;
            for (int L = F.vcu; L < BATCH * NH * 8; L += F.G) {
                const int bh = L >> 3, xq = L & 7, bb = bh / NH, hh = bh % NH;
                const bf16* kbase = AK + (size_t)bb * SEQ * 1024 + hh * 128; const bf16* vbase = AV + (size_t)bb * SEQ * 1024 + hh * 128;
                bf16* q0 = QQ + ((size_t)bb * SEQ + xq * 256) * 2048 + 1024 + hh * 128; bf16* q1 = QQ + ((size_t)bb * SEQ + (15 - xq) * 256) * 2048 + 1024 + hh * 128;
                const moba::BlockRef c0{q0, kbase, vbase, q0, KMEANB + (size_t)bh * NBLK * HD, rel_tab + hh, q_g, k_g, xq * 256};
                const moba::BlockRef c1{q1, kbase, vbase, q1, KMEANB + (size_t)bh * NBLK * HD, rel_tab + hh, q_g, k_g, (15 - xq) * 256};
#if MK_ATT4
                moba::moba_prime4(c0, F.lds + RING_OFF, S);
#elif MK_ATT3
                moba::moba_prime3(c0, F.lds + RING_OFF, S);
#else
                moba::moba_prime(MK_ATT_HEAVY_FIRST ? c1 : c0, (char*)lds + RING_OFF, S);
#endif
#pragma unroll 1

#if MK_ATT_HEAVY_FIRST
                for (int pass = 0; pass < 2; ++pass) { const moba::BlockRef cu = pass ? c0 : c1; moba::moba_block(cu, c0, (char*)lds + RING_OFF, S); }
#else
                for (int pass = 0; pass < 2; ++pass) { const moba::BlockRef cu = pass ? c1 : c0;
#if MK_ATT4
                    moba::moba_block4<0>(cu, c1, F.lds + RING_OFF, S);
#elif MK_ATT3
                    moba::moba_block3<0>(cu, c1, F.lds + RING_OFF, S);
#elif MK_ATT2
                    moba::moba_block2<0>(cu, c1, (char*)lds + RING_OFF, S);
#else
                    moba::moba_block(cu, c1, (char*)lds + RING_OFF, S);
#endif
                }
#endif
            }
        }
#endif
        if (BOTH(2)) GRID_BAR();
        TEND(2);
    }
#if (PROBE_DUP >> 2) & 1
    }
#endif
#if (PROBE_DUP >> 3) & 1
    for (int rep_3 = 0; rep_3 < 2; ++rep_3) {
#endif
    if (IN(3)) { TSTART(3);
        pg8::Gemm g{HB, WT_IN + (size_t)3072 * 1024, MTOK, 6144, 1024}; pg8::StaticOrder S; S.init(MTOK, 6144, F.G, (int)blockIdx.x, MK_WGM_P1A);
        pg8::EpiProj E{1, QQ, AK, AV, HLF, HSG, GATES, KMEAN, KMEANB, LB, q_g, k_g, (PG8_LAS unsigned char*)(F.lds + EPI_SCR_OFF)};
        pg8::gemm_phase<pg8::EpiProj, pg8::StaticOrder, MK_ALIGN_P1A, MK_SP2>(F.lds + RING_OFF, g, S, E);
        if (BOTH(3)) GRID_BAR();
        TEND(3);
    }
#if (PROBE_DUP >> 3) & 1
    }
#endif
#if (PROBE_DUP >> 4) & 1
    for (int rep_4 = 0; rep_4 < 2; ++rep_4) {
#endif
    if (IN(4)) { TSTART(4);
        constexpr int I_G = 16 * 44, I_D = 44 * 16;
        const bool down_later = (F.G == 256);
        for (int it = gw; it < 2 * I_G + (down_later ? 0 : I_D); it += NGW) {
            int r = it;
            if (r < 2 * I_G) { const int up = r >= I_G; if (up) r -= I_G; const int kb = r / 44, c = 64 * (r % 44);
                p0_transpose64(up ? w_up : w_gate, DFF, 64 * kb, c, WT_FIN, 1024, 256 * (c / 128) + (c % 128) + (up ? 128 : 0), 0, scrb, F.lane, ffn_g); continue; } r -= 2 * I_G;
            p0_transpose64(w_down, 1024, 64 * (r / 16), 64 * (r % 16), WT_DOWN, DFF, 64 * (r % 16), 0, scrb, F.lane);
        }
#if !MK_NAIVE_HGRN
        __syncthreads();
        {
#if MK_HG2A
          namespace hga = hg2;
#else
          namespace hga = hgrn;
#endif
          const hga::Ptrs HP{QQ, AK, AV, HLF, HSG};
          for (int L = F.vcu; L < BATCH * NH * 8; L += F.G) { const int bh = L >> 3, gg = L & 7;
        if (PROBE_T == 34) pt0 = __builtin_amdgcn_s_memrealtime();
              hga::run_item<false>((char*)lds + RING_OFF, HP, QQ, hg_out_g, LST, DST, L, gg, (size_t)(bh / NH) * SEQ + gg * 512, bh % NH); } }
        if (PROBE_T == 24 || PROBE_T == 34) pt1 = __builtin_amdgcn_s_memrealtime();
#endif
        if (BOTH(4)) GRID_BAR();
        TEND(4);
    }
#if (PROBE_DUP >> 4) & 1
    }
#endif
    if (IN(5)) { TSTART(5);
#if MK_NAIVE_HGRN
        if (blockIdx.x < 8) {
            const int grp = F.tid >> 7, v = F.tid & 127, bh = blockIdx.x * 4 + grp, h = bh % NH, b = bh / NH; const float g = hg_out_g[v];
            LAS float* qs = (LAS float*)(F.lds + RING_OFF) + grp * 512; LAS float* ks = qs + 128; LAS float* fs = qs + 256; LAS float* red = qs + 384;
            float S[128];
#pragma unroll
            for (int k = 0; k < 128; ++k) S[k] = 0.f;
            for (int t = 0; t < SEQ; ++t) { const size_t m = (size_t)b * SEQ + t;
                qs[v] = bf2f(QQ[m * 2048 + h * 128 + v]); ks[v] = bf2f(AK[m * 1024 + h * 128 + v]);
                { const unsigned short hb = HLF[m * 1024 + h * 128 + v]; _Float16 hf = __builtin_bit_cast(_Float16, hb); fs[v] = exp2f((float)hf); }
                const float vv = bf2f(AV[m * 1024 + h * 128 + v]), sg = bf2f(HSG[m * 1024 + h * 128 + v]);
                __syncthreads();
                float o = 0.f;
#pragma unroll
                for (int k = 0; k < 128; ++k) { S[k] = fs[k] * S[k] + ks[k] * vv; o += qs[k] * S[k]; }
                const float ss = wave_sum(o * o); if ((v & 63) == 0) red[v >> 6] = ss;
                __syncthreads();
                const float rstd = 1.f / sqrtf((red[0] + red[1]) * (1.f / 128.f) + NORM_EPS);
                QQ[m * 2048 + h * 128 + v] = (bf16)f2bf(o * rstd * g * sg);
            }
        }
#else
        {
#if MK_HG2B
          namespace hgb = hg2;
#else
          namespace hgb = hgrn;
#endif
          const hgb::Ptrs HP{QQ, AK, AV, HLF, HSG};
          for (int L = F.vcu; L < BATCH * NH * 8; L += F.G) { const int bh = L >> 3, gg = L & 7;
#if defined(DBG_MIX)
              if (!(DBG_MIX)) { const hgrn::Ptrs HP1{QQ, AK, AV, HLF, HSG}; hgrn::run_item<true>((char*)lds + RING_OFF, HP1, QQ, hg_out_g, LST, DST, L, gg, (size_t)(bh / NH) * SEQ + gg * 512, bh % NH); } else
#endif
              hgb::run_item<true>((char*)lds + RING_OFF, HP, QQ, hg_out_g, LST, DST, L, gg, (size_t)(bh / NH) * SEQ + gg * 512, bh % NH); } }
        if (PROBE_T == 25) pt1 = __builtin_amdgcn_s_memrealtime();
#endif
        if (BOTH(5)) GRID_BAR();
        TEND(5);
    }
#if (PROBE_DUP >> 6) & 1
    for (int rep_6 = 0; rep_6 < 2; ++rep_6) {
#endif
    if (IN(6)) { TSTART(6);
        pg8::Gemm g{QQ, WT_CAT, MTOK, 1024, 2048}; pg8::StaticOrder S; S.init(MTOK, 1024, F.G, (int)blockIdx.x, MK_WGM_1U);
        pg8::EpiMerge E{GATES, MERGED};
        pg8::gemm_phase<pg8::EpiMerge, pg8::StaticOrder, MK_ALIGN_1U, MK_SP2>(F.lds + RING_OFF, g, S, E);
        if (BOTH(6)) GRID_BAR();
        TEND(6);
    }
#if (PROBE_DUP >> 6) & 1
    }
#endif
#if (PROBE_DUP >> 7) & 1
    for (int rep_7 = 0; rep_7 < 2; ++rep_7) {
#endif
    if (IN(7)) { TSTART(7);
        pg8::Gemm g{MERGED, WT_OUT, MTOK, 1024, 1024}; pg8::StaticOrder S; S.init(MTOK, 1024, F.G, (int)blockIdx.x, MK_WGM_1U);
        pg8::EpiOut E{x, X1B, SSQ};
        pg8::gemm_phase<pg8::EpiOut, pg8::StaticOrder, MK_ALIGN_1U, MK_SP2>(F.lds + RING_OFF, g, S, E);
        if (BOTH(7)) GRID_BAR();
        TEND(7);
    }
#if (PROBE_DUP >> 7) & 1
    }
#endif
#if (PROBE_DUP >> 8) & 1
    for (int rep_8 = 0; rep_8 < 2; ++rep_8) {
#endif
    if (IN(8)) { TSTART(8);
        pg8::Gemm g{X1B, WT_FIN, MTOK, 2 * DFF, 1024}; pg8::StaticOrder S; S.init(MTOK, 2 * DFF, F.G, (int)blockIdx.x, MK_WGM_P8);
        pg8::EpiFfnIn E{SSQ, ACT};
        pg8::gemm_phase<pg8::EpiFfnIn, pg8::StaticOrder, MK_ALIGN_P8, MK_SP2>(F.lds + RING_OFF, g, S, E);
        if (F.G == 256 && blockIdx.x >= 128) {
            for (int it = ((int)blockIdx.x - 128) * NWAVES + F.wave; it < 44 * 16; it += 128 * NWAVES)
                p0_transpose64(w_down, 1024, 64 * (it / 16), 64 * (it % 16), WT_DOWN, DFF, 64 * (it % 16), 0, scrb, F.lane);
        }
        if (BOTH(8)) GRID_BAR();
        TEND(8);
    }
#if (PROBE_DUP >> 8) & 1
    }
#endif
#if (PROBE_DUP >> 9) & 1
    for (int rep_9 = 0; rep_9 < 2; ++rep_9) {
#endif
    if (IN(9)) { TSTART(9);
        pg8::Gemm g{ACT, WT_DOWN, MTOK, 1024, DFF}; pg8::StaticOrder S; S.init(MTOK, 1024, F.G, (int)blockIdx.x, MK_WGM_1U);
        pg8::EpiDown E{X1B, args.out};
        pg8::gemm_phase<pg8::EpiDown, pg8::StaticOrder, MK_ALIGN_1U, MK_SP2>(F.lds + RING_OFF, g, S, E);
        TEND(9);
    }
#if (PROBE_DUP >> 9) & 1
    }
#endif
    if ((PROBE_DUP >> 10) & 1) { for (int e = 0; e < 10; ++e) GRID_BAR(); }
    if (PROBE_T >= 0 && blockIdx.x == PROBE_BLK && F.tid == 0) { const unsigned long long tgt = __builtin_amdgcn_s_memrealtime() + 4ull * (pt1 - pt0); while (__builtin_amdgcn_s_memrealtime() < tgt) __builtin_amdgcn_s_sleep(16); }
#undef IN
#undef BOTH
#undef GRID_BAR
}

extern "C" void kernel_launch(void* const* d_in, const int* in_sizes, int n_in, void* d_out, int out_size, void* d_ws, size_t ws_size, hipStream_t stream) {
    static int grid = 0;
    if (grid == 0) {
        if (n_in != 15 || in_sizes[0] != MTOK * DM || out_size != MTOK * DM || ws_size < WS_END) {
            fprintf(stderr, "kernel_launch: shape/workspace mismatch (n_in %d, in0 %d, out %d, ws %zu); nothing launched\n", n_in, n_in > 0 ? in_sizes[0] : -1, out_size, ws_size); grid = -1; return; }
        int dev = 0, cus = 0, per_cu = 0;
        if (hipGetDevice(&dev) != hipSuccess || hipDeviceGetAttribute(&cus, hipDeviceAttributeMultiprocessorCount, dev) != hipSuccess) { grid = -1; return; }
        if (hipFuncSetAttribute((const void*)mk_fwd, hipFuncAttributeMaxDynamicSharedMemorySize, LDS_BYTES) != hipSuccess) { fprintf(stderr, "kernel_launch: hipFuncSetAttribute failed\n"); grid = -1; return; }
        if (hipOccupancyMaxActiveBlocksPerMultiprocessor(&per_cu, (const void*)mk_fwd, NWAVES * 64, LDS_BYTES) != hipSuccess || per_cu < 1) { fprintf(stderr, "kernel_launch: occupancy query says %d\n", per_cu); per_cu = 1; }
        (void)hipGetLastError();
        grid = cus;
    }
    if (grid < 0) return;
    (void)hipMemsetAsync((char*)d_ws + WS_CTL, 0, CTL_ZERO_BYTES, stream);
    Args a{};
    for (int i = 0; i < 15; ++i) a.in[i] = (const float*)d_in[i];
    a.out = (float*)d_out; a.ws = (unsigned char*)d_ws;
    unsigned char* ws = (unsigned char*)d_ws;
#define FRAME(lo_, hi_) do { a.ph_lo = (lo_); a.ph_hi = (hi_); hipLaunchKernelGGL(mk_fwd, dim3(grid), dim3(NWAVES * 64), LDS_BYTES, stream, a); } while (0)
    FRAME(0, 10);
#undef FRAME
    const hipError_t le = hipPeekAtLastError();
    if (le != hipSuccess) fprintf(stderr, "kernel_launch: launch failed: %s\n", hipGetErrorName(le));
}
```
